# Optimizing an MI355X kernel written in HIP

```python
import math
import jax
import jax.numpy as jnp
from jax import lax
import numpy as np

D_MODEL = 1024
BATCH = 4
SEQ = 8192
DEPTH = 2

GRID_W = 64
CTX_LEN = 256
SSM_WIDTH = D_MODEL // 4
SSM_GROUP = 16
SSM_GROUPS = SSM_WIDTH // SSM_GROUP
SSM_STATE = 64
SSM_DT_MIN = 1e-3
SSM_DT_MAX = 1e-1
SSM_RE_MAX = -1e-4
DIFF_HEADS = D_MODEL // 256
DIFF_DH = 64
DIFF_WIDTH = DIFF_HEADS * 2 * DIFF_DH
NA_HEADS = D_MODEL // 256
NA_DH = 64
NA_WIDTH = NA_HEADS * NA_DH
NA_WIN_H = 8
NA_WIN_W = 16
ATTN_BLOCK = 128
ROPE_THETA = 10000.0
ROPE_FREQS = DIFF_DH // 4
IN_SPLITS = (SSM_WIDTH, DIFF_WIDTH, DIFF_WIDTH, DIFF_WIDTH, NA_WIDTH, NA_WIDTH, NA_WIDTH, D_MODEL, D_MODEL, D_MODEL)
IN_WIDTH = sum(IN_SPLITS)
PEER_HEADS = 8
PEER_NKEYS = 128
PEER_EXPERTS = PEER_NKEYS ** 2
PEER_DHALF = 128
PEER_TOPK = 16
PEER_CHUNK = 128
RMS_EPS = 1e-6
NEG_INF = -1e30

kernel_name = 'hybrid_s5_diffattn_natten_peer'


def rmsnorm(x, g):
    xf = x.astype(jnp.float32)
    y = xf * lax.rsqrt(jnp.mean(xf * xf, axis=-1, keepdims=True) + RMS_EPS)
    return (y * g.astype(jnp.float32)).astype(x.dtype)


def rope_half(x, ang):
    f = ang.shape[-1]
    cos = jnp.cos(ang).astype(x.dtype)
    sin = jnp.sin(ang).astype(x.dtype)
    x1, x2 = x[..., :f], x[..., f:]
    return jnp.concatenate([x1 * cos - x2 * sin, x2 * cos + x1 * sin], axis=-1)


def rope_2d(x, ang_r, ang_c):
    half = x.shape[-1] // 2
    return jnp.concatenate([rope_half(x[..., :half], ang_r), rope_half(x[..., half:], ang_c)], axis=-1)


def _lin_combine(e1, e2):
    a1, b1 = e1
    a2, b2 = e2
    return a1 * a2, a2 * b1 + b2


def ssm_discretise(lam_re, lam_im, log_step, b_re, b_im):
    lam = lax.complex(jnp.minimum(lam_re.astype(jnp.float32), SSM_RE_MAX), lam_im.astype(jnp.float32))
    lam_dt = lam * jnp.exp(log_step.astype(jnp.float32))[:, None]
    lam_bar = jnp.exp(lam_dt)
    b = lax.complex(b_re.astype(jnp.float32), b_im.astype(jnp.float32))
    b_bar = ((lam_bar - 1.0) / lam)[..., None] * b
    return lam_dt, lam_bar, b_bar


def ssm_scan(u, lam_bar, b_bar, reverse):
    bu = jnp.einsum('blgp,gnp->blgn', u.astype(jnp.complex64), b_bar)
    a = jnp.broadcast_to(lam_bar, (1, u.shape[1]) + lam_bar.shape)
    _, s = lax.associative_scan(_lin_combine, (a, bu), reverse=reverse, axis=1)
    return s


def ssm_glu(y, glu_w, dtype):
    bn, length = y.shape[:2]
    z = jax.nn.gelu(y.reshape(bn, length, SSM_WIDTH)).astype(dtype) @ glu_w
    val, gate = jnp.split(z, 2, axis=-1)
    return val * jax.nn.sigmoid(gate)


def ssm_mixer(u_lat, u_ctx, lam_re, lam_im, log_step, b_re, b_im, c_re, c_im, d, glu_w, with_ctx):
    bn, length, _ = u_lat.shape
    ul = u_lat.astype(jnp.float32).reshape(bn, length, SSM_GROUPS, SSM_GROUP)
    uc = u_ctx.astype(jnp.float32).reshape(bn, u_ctx.shape[1], SSM_GROUPS, SSM_GROUP)
    dd = d.astype(jnp.float32).reshape(SSM_GROUPS, SSM_GROUP)
    y_lat = dd * ul
    y_ctx = dd * uc if with_ctx else None
    for direction, reverse in ((0, False), (1, True)):
        lam_dt, lam_bar, b_bar = ssm_discretise(lam_re[direction], lam_im[direction], log_step[direction],
                                                b_re[direction], b_im[direction])
        cm = lax.complex(c_re[direction].astype(jnp.float32), c_im[direction].astype(jnp.float32))
        s_ctx = ssm_scan(uc, lam_bar, b_bar, reverse)
        s0 = s_ctx[:, 0] if reverse else s_ctx[:, -1]
        steps = (jnp.arange(length, 0, -1) if reverse else jnp.arange(1, length + 1)).astype(jnp.float32)
        carry = jnp.exp(lam_dt[None] * steps[:, None, None])
        s_lat = ssm_scan(ul, lam_bar, b_bar, reverse) + carry[None] * s0[:, None]
        y_lat = y_lat + jnp.einsum('blgn,gpn->blgp', s_lat, cm).real
        if with_ctx:
            y_ctx = y_ctx + jnp.einsum('blgn,gpn->blgp', s_ctx, cm).real
    out_lat = ssm_glu(y_lat, glu_w, u_lat.dtype)
    out_ctx = ssm_glu(y_ctx, glu_w, u_lat.dtype) if with_ctx else None
    return out_lat, out_ctx


def diff_attend(q, k, v, lam):
    bn, nh, _, lq, dh = q.shape
    nb = lq // ATTN_BLOCK
    qb = jnp.moveaxis(q.reshape(bn, nh, 2, nb, ATTN_BLOCK, dh), 3, 0)
    scale = dh ** -0.5

    def block(qi):
        s = jnp.einsum('bhmqd,bhmkd->bhmqk', qi, k).astype(jnp.float32) * scale
        p = jax.nn.softmax(s, axis=-1)
        a = (p[:, :, 0] - lam * p[:, :, 1]).astype(v.dtype)
        return jnp.einsum('bhqk,bhkd->bhqd', a, v)

    o = lax.map(block, qb)
    return jnp.moveaxis(o, 0, 2).reshape(bn, nh, lq, v.shape[-1])


def diff_mixer(q_lat, k_lat, v_lat, q_ctx, k_ctx, v_ctx, lam_qk, subln_g, lam_init, ang_r, ang_c, with_ctx):
    def qk_heads(t):
        return t.reshape(t.shape[0], t.shape[1], DIFF_HEADS, 2, DIFF_DH).transpose(0, 2, 3, 1, 4)

    def v_heads(t):
        return t.reshape(t.shape[0], t.shape[1], DIFF_HEADS, 2 * DIFF_DH).transpose(0, 2, 1, 3)

    def finish(o):
        o = rmsnorm(o, subln_g) * (1.0 - lam_init)
        return o.transpose(0, 2, 1, 3).reshape(o.shape[0], o.shape[2], DIFF_WIDTH)

    lq = lam_qk.astype(jnp.float32)
    lam = jnp.exp(jnp.sum(lq[0] * lq[1])) - jnp.exp(jnp.sum(lq[2] * lq[3])) + lam_init
    ql = rope_2d(qk_heads(q_lat), ang_r, ang_c)
    kl = rope_2d(qk_heads(k_lat), ang_r, ang_c)
    kc = qk_heads(k_ctx)
    vc = v_heads(v_ctx)
    k_all = jnp.concatenate([kc, kl], axis=3)
    v_all = jnp.concatenate([vc, v_heads(v_lat)], axis=2)
    out_lat = finish(diff_attend(ql, k_all, v_all, lam))
    out_ctx = finish(diff_attend(qk_heads(q_ctx), kc, vc, lam)) if with_ctx else None
    return out_lat, out_ctx


def dense_attend(q, k, v):
    s = jnp.einsum('bhqd,bhkd->bhqk', q, k).astype(jnp.float32) * q.shape[-1] ** -0.5
    p = jax.nn.softmax(s, axis=-1).astype(v.dtype)
    return jnp.einsum('bhqk,bhkd->bhqd', p, v)


def na_mixer(q_lat, k_lat, v_lat, q_ctx, k_ctx, v_ctx, rpb, with_ctx):
    bn, length, _ = q_lat.shape
    rows = length // GRID_W
    kh = min(NA_WIN_H, rows)

    def grid_heads(t):
        return t.reshape(bn, rows, GRID_W, NA_HEADS, NA_DH).transpose(0, 3, 1, 2, 4)

    def seq_heads(t):
        return t.reshape(bn, t.shape[1], NA_HEADS, NA_DH).transpose(0, 2, 1, 3)

    qg, kg, vg = grid_heads(q_lat), grid_heads(k_lat), grid_heads(v_lat)
    kc, vc = seq_heads(k_ctx), seq_heads(v_ctx)
    row_idx = np.clip(np.arange(rows) - kh // 2, 0, rows - kh)[:, None] + np.arange(kh)[None, :]
    kw = kg[:, :, row_idx].reshape(bn, NA_HEADS, rows, kh * GRID_W, NA_DH)
    vw = vg[:, :, row_idx].reshape(bn, NA_HEADS, rows, kh * GRID_W, NA_DH)
    cols = np.arange(GRID_W)
    col_start = np.clip(cols - NA_WIN_W // 2, 0, GRID_W - NA_WIN_W)
    col_ok = (cols[None, :] >= col_start[:, None]) & (cols[None, :] < col_start[:, None] + NA_WIN_W)
    mask = np.broadcast_to(col_ok[:, None, :], (GRID_W, kh, GRID_W)).reshape(GRID_W, kh * GRID_W)
    dr_idx = row_idx - np.arange(rows)[:, None] + NA_WIN_H - 1
    dc_idx = np.clip(cols[None, :] - cols[:, None] + NA_WIN_W - 1, 0, 2 * NA_WIN_W - 2)
    bias = rpb[:, dr_idx[:, None, :, None], dc_idx[None, :, None, :]].reshape(NA_HEADS, rows, GRID_W, kh * GRID_W)
    scale = NA_DH ** -0.5
    s_loc = jnp.einsum('bhrqd,bhrkd->bhrqk', qg, kw).astype(jnp.float32) * scale + bias.astype(jnp.float32)
    s_loc = jnp.where(mask, s_loc, NEG_INF)
    s_ctx = jnp.einsum('bhrqd,bhkd->bhrqk', qg, kc).astype(jnp.float32) * scale
    p = jax.nn.softmax(jnp.concatenate([s_loc, s_ctx], axis=-1), axis=-1).astype(vg.dtype)
    nloc = kh * GRID_W
    o = (jnp.einsum('bhrqk,bhrkd->bhrqd', p[..., :nloc], vw)
         + jnp.einsum('bhrqk,bhkd->bhrqd', p[..., nloc:], vc))
    out_lat = o.transpose(0, 2, 3, 1, 4).reshape(bn, length, NA_WIDTH)
    out_ctx = None
    if with_ctx:
        oc = dense_attend(seq_heads(q_ctx), kc, vc)
        out_ctx = oc.transpose(0, 2, 1, 3).reshape(bn, q_ctx.shape[1], NA_WIDTH)
    return out_lat, out_ctx


def merge_branches(y_ssm, y_diff, y_na, g_ssm, g_diff, g_na, w_br_ssm, w_br_diff, w_br_na, w_out):
    m = (jax.nn.sigmoid(g_ssm) * (y_ssm @ w_br_ssm)
         + jax.nn.sigmoid(g_diff) * (y_diff @ w_br_diff)
         + jax.nn.sigmoid(g_na) * (y_na @ w_br_na))
    return m @ w_out


def peer_ffn(h, wq, subkeys, u_tab, v_tab):
    bn, length, dm = h.shape
    nc = length // PEER_CHUNK
    hc = h.reshape(bn, nc, PEER_CHUNK, dm).transpose(1, 0, 2, 3)

    def chunk(hb):
        q = (hb @ wq).reshape(bn, PEER_CHUNK, PEER_HEADS, 2, PEER_DHALF)
        s = jnp.einsum('bchxd,hxnd->bchxn', q, subkeys).astype(jnp.float32)
        sv, si = lax.top_k(s, PEER_TOPK)
        cand = (sv[..., 0, :, None] + sv[..., 1, None, :]).reshape(bn, PEER_CHUNK, PEER_HEADS, PEER_TOPK * PEER_TOPK)
        cidx = (si[..., 0, :, None] * PEER_NKEYS + si[..., 1, None, :]).reshape(bn, PEER_CHUNK, PEER_HEADS, PEER_TOPK * PEER_TOPK)
        best, pos = lax.top_k(cand, PEER_TOPK)
        eidx = jnp.take_along_axis(cidx, pos, axis=-1)
        g = jax.nn.softmax(best, axis=-1).astype(hb.dtype)
        act = jax.nn.gelu(jnp.einsum('bchkd,bcd->bchk', u_tab[eidx], hb))
        return jnp.einsum('bchk,bchkd->bcd', g * act, v_tab[eidx])

    out = lax.map(chunk, hc)
    return out.transpose(1, 0, 2, 3).reshape(bn, length, dm)


def setup_inputs(seed: int = 0) -> dict:
    key = jax.random.key(seed)
    ks = jax.random.split(key, 32)
    f32 = jnp.float32

    def nrm(k, shape, scale):
        return jax.random.normal(k, shape, f32) * scale

    G, N, P = SSM_GROUPS, SSM_STATE, SSM_GROUP
    n_idx = jnp.arange(N, dtype=f32)
    return {
        'x': nrm(ks[0], (BATCH, SEQ, D_MODEL), 1.0),
        'c': nrm(ks[1], (BATCH, D_MODEL), 1.0),
        'ctx': nrm(ks[2], (BATCH, CTX_LEN, D_MODEL), 1.0),
        'c_ctx': nrm(ks[3], (D_MODEL,), 1.0),
        'ada_w': nrm(ks[4], (DEPTH, D_MODEL, 6 * D_MODEL), 0.5 * D_MODEL ** -0.5),
        'ada_b': nrm(ks[5], (DEPTH, 6 * D_MODEL), 0.01),
        'norm1_g': 1.0 + nrm(ks[6], (DEPTH, D_MODEL), 0.01),
        'norm2_g': 1.0 + nrm(ks[7], (DEPTH, D_MODEL), 0.01),
        'w_in': nrm(ks[8], (DEPTH, D_MODEL, IN_WIDTH), D_MODEL ** -0.5),
        'ssm_lambda_re': -0.5 + nrm(ks[9], (DEPTH, 2, G, N), 0.01),
        'ssm_lambda_im': math.pi * n_idx + nrm(ks[10], (DEPTH, 2, G, N), 0.01),
        'ssm_log_step': jax.random.uniform(ks[11], (DEPTH, 2, G), f32, math.log(SSM_DT_MIN), math.log(SSM_DT_MAX)),
        'ssm_b_re': nrm(ks[12], (DEPTH, 2, G, N, P), (2 * P) ** -0.5),
        'ssm_b_im': nrm(ks[13], (DEPTH, 2, G, N, P), (2 * P) ** -0.5),
        'ssm_c_re': nrm(ks[14], (DEPTH, 2, G, P, N), (2 * N) ** -0.5),
        'ssm_c_im': nrm(ks[15], (DEPTH, 2, G, P, N), (2 * N) ** -0.5),
        'ssm_d': nrm(ks[16], (DEPTH, SSM_WIDTH), 1.0),
        'ssm_glu_w': nrm(ks[17], (DEPTH, SSM_WIDTH, 2 * SSM_WIDTH), SSM_WIDTH ** -0.5),
        'diff_lambda': nrm(ks[18], (DEPTH, 4, DIFF_DH), 0.1),
        'diff_subln_g': 1.0 + nrm(ks[19], (DEPTH, 2 * DIFF_DH), 0.01),
        'na_rpb': nrm(ks[20], (DEPTH, NA_HEADS, 2 * NA_WIN_H - 1, 2 * NA_WIN_W - 1), 0.02),
        'w_br_ssm': nrm(ks[21], (DEPTH, SSM_WIDTH, D_MODEL), SSM_WIDTH ** -0.5),
        'w_br_diff': nrm(ks[22], (DEPTH, DIFF_WIDTH, D_MODEL), DIFF_WIDTH ** -0.5),
        'w_br_na': nrm(ks[23], (DEPTH, NA_WIDTH, D_MODEL), NA_WIDTH ** -0.5),
        'w_out': nrm(ks[24], (DEPTH, D_MODEL, D_MODEL), D_MODEL ** -0.5),
        'peer_wq': nrm(ks[25], (DEPTH, D_MODEL, PEER_HEADS * 2 * PEER_DHALF), D_MODEL ** -0.5),
        'peer_subkeys': nrm(ks[26], (DEPTH, PEER_HEADS, 2, PEER_NKEYS, PEER_DHALF), PEER_DHALF ** -0.5),
        'peer_u': nrm(ks[27], (DEPTH, PEER_EXPERTS, D_MODEL), D_MODEL ** -0.5),
        'peer_v': nrm(ks[28], (DEPTH, PEER_EXPERTS, D_MODEL), 0.5),
        'final_norm_g': 1.0 + nrm(ks[29], (D_MODEL,), 0.01),
    }


def reference(x, c, ctx, c_ctx, ada_w, ada_b, norm1_g, norm2_g, w_in, ssm_lambda_re, ssm_lambda_im,
              ssm_log_step, ssm_b_re, ssm_b_im, ssm_c_re, ssm_c_im, ssm_d, ssm_glu_w, diff_lambda,
              diff_subln_g, na_rpb, w_br_ssm, w_br_diff, w_br_na, w_out, peer_wq, peer_subkeys, peer_u,
              peer_v, final_norm_g):
    length = x.shape[1]
    t = jnp.arange(length)
    freqs = ROPE_THETA ** (-jnp.arange(ROPE_FREQS, dtype=jnp.float32) / ROPE_FREQS)
    ang_r = (t // GRID_W).astype(jnp.float32)[:, None] * freqs
    ang_c = (t % GRID_W).astype(jnp.float32)[:, None] * freqs
    split_idx = [int(i) for i in np.cumsum(IN_SPLITS)[:-1]]
    x_lat, x_ctx = x, ctx
    for l in range(DEPTH):
        with_ctx = l < DEPTH - 1
        lam_init = 0.8 - 0.6 * math.exp(-0.3 * l)
        m_lat = (jax.nn.silu(c) @ ada_w[l] + ada_b[l])[:, None, :]
        m_ctx = jax.nn.silu(c_ctx) @ ada_w[l] + ada_b[l]
        sh1, sc1, g1, sh2, sc2, g2 = jnp.split(m_lat, 6, axis=-1)
        csh1, csc1, cg1, csh2, csc2, cg2 = jnp.split(m_ctx, 6, axis=-1)
        h_lat = rmsnorm(x_lat, norm1_g[l]) * (1.0 + sc1) + sh1
        h_ctx = rmsnorm(x_ctx, norm1_g[l]) * (1.0 + csc1) + csh1
        pl = jnp.split(h_lat @ w_in[l], split_idx, axis=-1)
        pc = jnp.split(h_ctx @ w_in[l], split_idx, axis=-1)
        ys_l, ys_c = ssm_mixer(pl[0], pc[0], ssm_lambda_re[l], ssm_lambda_im[l], ssm_log_step[l],
                               ssm_b_re[l], ssm_b_im[l], ssm_c_re[l], ssm_c_im[l], ssm_d[l], ssm_glu_w[l], with_ctx)
        yd_l, yd_c = diff_mixer(pl[1], pl[2], pl[3], pc[1], pc[2], pc[3], diff_lambda[l], diff_subln_g[l],
                                lam_init, ang_r, ang_c, with_ctx)
        yn_l, yn_c = na_mixer(pl[4], pl[5], pl[6], pc[4], pc[5], pc[6], na_rpb[l], with_ctx)
        mix_l = merge_branches(ys_l, yd_l, yn_l, pl[7], pl[8], pl[9],
                               w_br_ssm[l], w_br_diff[l], w_br_na[l], w_out[l])
        x_lat = x_lat + g1 * mix_l
        h2 = rmsnorm(x_lat, norm2_g[l]) * (1.0 + sc2) + sh2
        x_lat = x_lat + g2 * peer_ffn(h2, peer_wq[l], peer_subkeys[l], peer_u[l], peer_v[l])
        if with_ctx:
            mix_c = merge_branches(ys_c, yd_c, yn_c, pc[7], pc[8], pc[9],
                                   w_br_ssm[l], w_br_diff[l], w_br_na[l], w_out[l])
            x_ctx = x_ctx + cg1 * mix_c
            h2c = rmsnorm(x_ctx, norm2_g[l]) * (1.0 + csc2) + csh2
            x_ctx = x_ctx + cg2 * peer_ffn(h2c, peer_wq[l], peer_subkeys[l], peer_u[l], peer_v[l])
    return rmsnorm(x_lat, final_norm_g)
```

```cpp
#ifndef HOST_EMU
#include <hip/hip_runtime.h>
#define HD __host__ __device__ __forceinline__
#else
#include <cmath>
#include <cstring>
#include <cstdio>
#include <cstdlib>
#define HD inline
#endif
#include <cstdint>
#include <cstddef>
#ifndef HOST_EMU
#define UNROLL _Pragma("unroll")
#else
#define UNROLL
#endif

#ifndef BATCH
#define BATCH 4
#endif
#ifndef SEQ
#define SEQ 8192
#endif
#ifndef CTX_LEN
#define CTX_LEN 256
#endif
constexpr int B_ = BATCH, L_ = SEQ, C_ = CTX_LEN, DM = 1024, DEPTH = 2;
constexpr int NRL = B_ * L_, NRC = B_ * C_, NR = NRL + NRC;
constexpr int GRW = 64, GRR = L_ / GRW;
constexpr int TCH = 32, NCH = NR / TCH;
constexpr int NCHP = ((NCH + 255) / 256) * 256;
constexpr int LCH = L_ / TCH, CCH = C_ / TCH;
constexpr int INW = 5632, KSS = 768;
constexpr float RMS_EPS = 1e-6f;
constexpr float LOG2E = 1.4426950408889634f;

typedef unsigned short bf16_t;

HD float u2f(unsigned u) { float f; memcpy(&f, &u, 4); return f; }
HD unsigned f2u(float f) { unsigned u; memcpy(&u, &f, 4); return u; }
HD float bf2f(bf16_t v) { return u2f((unsigned)v << 16); }
HD bf16_t f2bf(float f) { unsigned u = f2u(f); return (bf16_t)((u + 0x7fffu + ((u >> 16) & 1u)) >> 16); }
#if defined(__HIP_DEVICE_COMPILE__)
HD float fexp2_(float x) { return __builtin_amdgcn_exp2f(x); }
HD float frcp_(float x) { return __builtin_amdgcn_rcpf(x); }
#else
HD float fexp2_(float x) { return exp2f(x); }
HD float frcp_(float x) { return 1.f / x; }
#endif
HD float sigmoidf_(float x) { return frcp_(1.f + fexp2_(-1.4426950408889634f * x)); }
HD float gelu_tanh(float x) { const float z = 0.7978845608028654f * (x + 0.044715f * x * x * x); return x * (1.f - frcp_(fexp2_(2.885390081777927f * z) + 1.f)); }
HD float siluf_(float x) { return x * sigmoidf_(x); }
struct alignas(16) bf8 { bf16_t v[8]; };
struct alignas(8) bf4 { bf16_t v[4]; };
struct alignas(16) fl4 { float v[4]; };

constexpr size_t al256(size_t x) { return (x + 255) & ~(size_t)255; }
constexpr size_t WS_CTL = 0;
constexpr size_t CTL_BYTES = 65536;
constexpr size_t WS_MOD = WS_CTL + CTL_BYTES;
constexpr size_t WS_ROPE = al256(WS_MOD + (size_t)DEPTH * (B_ + 1) * 6144 * 4);
constexpr size_t WS_LAMD = al256(WS_ROPE + 128 * 16 * 8);
constexpr size_t WS_POW = al256(WS_LAMD + 256);
constexpr size_t WS_BBAR = al256(WS_POW + (size_t)2 * 16 * 64 * 33 * 8);
constexpr size_t WS_KK = al256(WS_BBAR + (size_t)2 * 16 * 64 * 16 * 8);
constexpr size_t WS_XRC = al256(WS_KK + (size_t)2 * 16 * 32 * 256 * 4);
constexpr size_t WS_WIN = al256(WS_XRC + (size_t)NRC * DM * 4);
constexpr size_t WS_WGLU = al256(WS_WIN + (size_t)INW * DM * 2);
constexpr size_t WS_WBS = al256(WS_WGLU + (size_t)512 * 256 * 2);
constexpr size_t WS_WBD = al256(WS_WBS + (size_t)1024 * 256 * 2);
constexpr size_t WS_WBN = al256(WS_WBD + (size_t)1024 * 512 * 2);
constexpr size_t WS_WOUT = al256(WS_WBN + (size_t)1024 * 256 * 2);
constexpr size_t WS_WSC = al256(WS_WOUT + (size_t)1024 * 1024 * 2);
constexpr size_t WS_BT1 = al256(WS_WSC + (size_t)2048 * 1024 * 2);
constexpr size_t WS_BT2 = al256(WS_BT1 + (size_t)16 * 256 * 512 * 2);
constexpr size_t WS_H = al256(WS_BT2 + (size_t)16 * 512 * 768 * 2);
constexpr size_t WS_YD = WS_H;
constexpr size_t WS_YN = WS_YD + (size_t)NR * 512 * 2;
constexpr size_t WS_YS = WS_YN + (size_t)NR * 256 * 2;
constexpr size_t WS_ASSM = al256(WS_H + (size_t)NR * DM * 2);
constexpr size_t WS_EIDX = WS_ASSM;
constexpr size_t WS_SLOC = al256(WS_ASSM + ((size_t)16 * NCH + 256) * KSS * 2);
constexpr size_t WS_WQB = WS_SLOC;
constexpr size_t WS_SKA = WS_WQB + (size_t)1024 * 2048 * 2;
constexpr size_t WS_QD = al256(WS_SLOC + (size_t)16 * NCH * 256 * 4);
constexpr size_t WS_KD = WS_QD + (size_t)NR * 512 * 2;
constexpr size_t WS_VD = WS_KD + (size_t)NR * 512 * 2;
constexpr size_t WS_QN = WS_VD + (size_t)NR * 512 * 2;
constexpr size_t WS_KN = WS_QN + (size_t)NR * 256 * 2;
constexpr size_t WS_VN = WS_KN + (size_t)NR * 256 * 2;
constexpr size_t WS_SGS = WS_VN + (size_t)NR * 256 * 2;
constexpr size_t WS_SGD = WS_SGS + (size_t)NR * DM * 2;
constexpr size_t WS_SGN = WS_SGD + (size_t)NR * DM * 2;
constexpr size_t WS_END1 = WS_SGN + (size_t)NR * DM * 2;
constexpr size_t WS_H8 = WS_H;
constexpr size_t WS_WG8 = WS_WIN;
constexpr size_t WS_VT8 = WS_VD;
constexpr int KVP = C_ + L_;
constexpr size_t WS_GW8 = WS_H;
constexpr size_t WS_MB8 = WS_ASSM;
constexpr size_t WS_MB = WS_QD;
constexpr size_t WS_YG = WS_QN;
constexpr size_t WS_SC = WS_QD;
#ifdef HOST_EMU
constexpr size_t TBL_BYTES = (size_t)16384 * 1024 * 2;
#else
constexpr size_t TBL_BYTES = (size_t)16384 * 1024;
#endif
constexpr size_t WS_UT = al256(WS_SC + (size_t)NR * 2048 * 4);
constexpr size_t WS_VT = WS_UT + TBL_BYTES;
constexpr size_t WS_GW = WS_VT + TBL_BYTES;
constexpr size_t WS_H8B = al256(WS_GW + (size_t)NR * 128 * 4);
constexpr size_t WS_END2 = WS_H8B + (size_t)NR * DM;
constexpr size_t WS_TOTAL = WS_END1 > WS_END2 ? WS_END1 : WS_END2;
#if BATCH == 4 && SEQ == 8192 && CTX_LEN == 256
static_assert(WS_TOTAL <= (size_t)512 * 1024 * 1024, "workspace map exceeds 512 MiB");
#endif

#if defined(__HIP_DEVICE_COMPILE__)
#define GPTR __attribute__((address_space(1)))
#else
#define GPTR
#endif
struct ParamsH { const float* in[30]; float* out; unsigned char* ws; };
struct Params {
    const float GPTR* in[30];
    float GPTR* out;
    unsigned char GPTR* ws;
};
enum { I_X = 0, I_C, I_CTX, I_CCTX, I_ADAW, I_ADAB, I_N1G, I_N2G, I_WIN, I_LRE, I_LIM, I_LSTEP, I_BRE, I_BIM, I_CRE, I_CIM, I_SSMD, I_GLUW,
       I_DLAM, I_SUBLN, I_RPB, I_WBS, I_WBD, I_WBN, I_WOUT, I_WQ, I_SUBK, I_PU, I_PV, I_FNG };

#define WSP(T, off) ((T*)(p.ws + (off)))
HD float* xr_row(const Params& p, int row) { return row < NRL ? (float*)(p.out + (size_t)row * DM) : WSP(float, WS_XRC) + (size_t)(row - NRL) * DM; }
HD int row_bb(int row) { return row < NRL ? row / L_ : B_; }
HD const float* mod_ptr(const Params& p, int l, int bb, int seg) { return WSP(const float, WS_MOD) + ((size_t)(l * (B_ + 1) + bb) * 6 + seg) * DM; }

template <class F>
HD void naive_gemm(const bf16_t* A, size_t lda, const bf16_t* Bt, size_t ldb, int M, int N, int K, const F& f, long tid, long nthr) {
    const long per_row = N / 8, items = (long)M * per_row;
    for (long it = tid; it < items; it += nthr) {
        const int row = (int)(it / per_row), cg = (int)(it % per_row), c0 = (cg >> 2) * 32 + (cg & 3) * 4;
        float a[4] = {0.f, 0.f, 0.f, 0.f}, b[4] = {0.f, 0.f, 0.f, 0.f};
        const bf16_t* ar = A + (size_t)row * lda;
        for (int k = 0; k < K; k += 8) {
            const bf8 av = *(const bf8*)(ar + k);
            float af[8];
            for (int e = 0; e < 8; ++e) af[e] = bf2f(av.v[e]);
            for (int j = 0; j < 4; ++j) {
                const bf8 b0 = *(const bf8*)(Bt + (size_t)(c0 + j) * ldb + k), b1 = *(const bf8*)(Bt + (size_t)(c0 + 16 + j) * ldb + k);
                for (int e = 0; e < 8; ++e) { a[j] += af[e] * bf2f(b0.v[e]); b[j] += af[e] * bf2f(b1.v[e]); }
            }
        }
        f(row, c0, a, b);
    }
}

HD void st_bf4(bf16_t* dst, const float* v) { bf4 o; for (int j = 0; j < 4; ++j) o.v[j] = f2bf(v[j]); *(bf4*)dst = o; }

struct EpiWin {
    Params p;
    HD void set_group(int) {}
    template <int R = -1> HD void one(int row, int col, const float* v, const float* partner, bool first) const {
#if defined(__HIP_DEVICE_COMPILE__)
        Params p = this->p; { unsigned char GPTR* w_ = p.ws; asm volatile("" : "+s"(w_)); p.ws = w_; }
#endif
        if (R == 0 || (R < 0 && col < 256)) {
            const int g = col >> 4, ch = col & 15, chunk = row / TCH, tk = row % TCH;
            st_bf4(WSP(bf16_t, WS_ASSM) + ((size_t)(g * NCH + chunk)) * KSS + tk * 16 + ch, v);
        } else if (R == 1 || (R < 0 && col < 1280)) {
            const bool isq = col < 768; const int cc = col - (isq ? 256 : 768);
            float o[4];
            if (row < NRL) {
                const int t = row % L_, grp = (cc >> 5) & 1, pos = grp ? (t % GRW) : (t / GRW), i0 = cc & 15;
                const float* cs = WSP(const float, WS_ROPE) + ((size_t)pos * 16 + i0) * 2;
                for (int j = 0; j < 4; ++j) { const float c = cs[2 * j], s = cs[2 * j + 1]; o[j] = first ? (v[j] * c - partner[j] * s) : (v[j] * c + partner[j] * s); }
            } else for (int j = 0; j < 4; ++j) o[j] = v[j];
            if (isq) for (int j = 0; j < 4; ++j) o[j] *= 0.125f * LOG2E;
#ifdef HOST_EMU
            st_bf4(WSP(bf16_t, isq ? WS_QD : WS_KD) + (size_t)row * 512 + cc, o);
#else
            { int pk = 0;
              pk = __builtin_amdgcn_cvt_pk_fp8_f32(fminf(fmaxf(o[0] * 8.f, -448.f), 448.f), fminf(fmaxf(o[1] * 8.f, -448.f), 448.f), pk, false);
              pk = __builtin_amdgcn_cvt_pk_fp8_f32(fminf(fmaxf(o[2] * 8.f, -448.f), 448.f), fminf(fmaxf(o[3] * 8.f, -448.f), 448.f), pk, true);
              *(unsigned GPTR*)(p.ws + (isq ? WS_QD : WS_KD) + (size_t)row * 512 + cc) = (unsigned)pk; }
#endif
        } else if (R == 2 || (R < 0 && col < 1792)) {
#ifdef HOST_EMU
            st_bf4(WSP(bf16_t, WS_VD) + (size_t)row * 512 + (col - 1280), v);
#else
            const int cc = col - 1280, bb = row < NRL ? row / L_ : (row - NRL) / C_, kp = row < NRL ? C_ + row % L_ : (row - NRL) % C_;
            unsigned char GPTR* vt = (unsigned char GPTR*)(p.ws + WS_VT8); const unsigned off = (unsigned)((bb * 512 + cc) * KVP + kp);
            int pk = 0;
            pk = __builtin_amdgcn_cvt_pk_fp8_f32(fminf(fmaxf(v[0], -448.f), 448.f), fminf(fmaxf(v[1], -448.f), 448.f), pk, false);
            pk = __builtin_amdgcn_cvt_pk_fp8_f32(fminf(fmaxf(v[2], -448.f), 448.f), fminf(fmaxf(v[3], -448.f), 448.f), pk, true);
            vt[off] = (unsigned char)(pk & 255); vt[off + KVP] = (unsigned char)((pk >> 8) & 255); vt[off + 2 * KVP] = (unsigned char)((pk >> 16) & 255); vt[off + 3 * KVP] = (unsigned char)((unsigned)pk >> 24);
#endif
        } else if ((R == 3 || R < 0) && col < 2048) { float o[4]; for (int j = 0; j < 4; ++j) o[j] = v[j] * (0.125f * LOG2E); st_bf4(WSP(bf16_t, WS_QN) + (size_t)row * 256 + (col - 1792), o);
        } else if ((R == 3 || R < 0) && col < 2304) { st_bf4(WSP(bf16_t, WS_KN) + (size_t)row * 256 + (col - 2048), v);
        } else if (R == 3 || (R < 0 && col < 2560)) { st_bf4(WSP(bf16_t, WS_VN) + (size_t)row * 256 + (col - 2304), v);
        } else {
            const int gc = col - 2560, which = gc >> 10, c = gc & 1023;
            float o[4]; for (int j = 0; j < 4; ++j) o[j] = sigmoidf_(v[j]);
            st_bf4(WSP(bf16_t, which == 0 ? WS_SGS : which == 1 ? WS_SGD : WS_SGN) + (size_t)row * DM + c, o);
        }
    }
    HD void operator()(int row, int c0, const float* a, const float* b) const { one(row, c0, a, b, true); one(row, c0 + 16, b, a, false); }
};
struct EpiWinG { Params p;
    HD void set_group(int) {}
    HD void operator()(int row, int c0, const float* a, const float* b) const { EpiWin e{p}; e.one(row, c0, a, b, true); e.one(row, c0 + 16, b, a, false); }
    template <int R> HD void tile(int row, int c0, const float* a, const float* b) const { EpiWin e{p}; e.template one<R>(row, c0, a, b, true); e.template one<R>(row, c0 + 16, b, a, false); } };
struct EpiSsm1 { Params p; int g;
    HD void set_group(int g_) { g = g_; }
    HD void operator()(int row, int c0, const float* a, const float* b) const {
        if (row >= NCH) return;
        float* d = WSP(float, WS_SLOC) + ((size_t)(g * NCH + row)) * 256 + c0;
        for (int j = 0; j < 4; ++j) { d[j] = a[j]; d[16 + j] = b[j]; }
    } };
struct EpiSsm2 { Params p; int g;
    HD void set_group(int g_) { g = g_; }
    HD void one(int chunk, int col, const float* v) const {
        const int tk = col >> 4, ch = col & 15; float o[4]; for (int j = 0; j < 4; ++j) o[j] = gelu_tanh(v[j]);
        st_bf4(WSP(bf16_t, WS_YG) + ((size_t)chunk * TCH + tk) * 256 + g * 16 + ch, o);
    }
    HD void operator()(int row, int c0, const float* a, const float* b) const { if (row >= NCH) return; one(row, c0, a); one(row, c0 + 16, b); } };
struct EpiGlu { Params p;
    HD void set_group(int) {}
    HD void one(int row, int col, const float* v) const {
        bf16_t* d = WSP(bf16_t, WS_YS) + (size_t)row * 256 + (col >> 1);
        const unsigned pk = (unsigned)f2bf(v[0] * sigmoidf_(v[1])) | ((unsigned)f2bf(v[2] * sigmoidf_(v[3])) << 16); *(unsigned*)d = pk;
    }
    HD void operator()(int row, int c0, const float* a, const float* b) const { one(row, c0, a); one(row, c0 + 16, b); } };
struct EpiMerge { Params p; size_t sg_off; bool accum; bool last = false;
    HD void set_group(int) {}
    HD void one(int row, int col, const float* v) const {
        const bf16_t* sg = WSP(const bf16_t, sg_off) + (size_t)row * DM + col; bf16_t* m = WSP(bf16_t, WS_MB) + (size_t)row * DM + col;
        float o[4]; for (int j = 0; j < 4; ++j) o[j] = bf2f(sg[j]) * v[j] + (accum ? bf2f(m[j]) : 0.f);
#ifndef HOST_EMU
        if (last) { int pk = 0;
            pk = __builtin_amdgcn_cvt_pk_fp8_f32(fminf(fmaxf(o[0], -448.f), 448.f), fminf(fmaxf(o[1], -448.f), 448.f), pk, false);
            pk = __builtin_amdgcn_cvt_pk_fp8_f32(fminf(fmaxf(o[2], -448.f), 448.f), fminf(fmaxf(o[3], -448.f), 448.f), pk, true);
            *(unsigned GPTR*)(p.ws + WS_MB8 + (size_t)row * DM + col) = (unsigned)pk; return; }
#endif
        st_bf4(m, o);
    }
    HD void operator()(int row, int c0, const float* a, const float* b) const { one(row, c0, a); one(row, c0 + 16, b); } };
struct EpiWout { Params p; int l;
    HD void set_group(int) {}
    HD void one(int row, int col, const float* v) const {
        float* x = xr_row(p, row) + col; const float* g1 = mod_ptr(p, l, row_bb(row), 2) + col;
        for (int j = 0; j < 4; ++j) x[j] += g1[j] * v[j];
    }
    HD void operator()(int row, int c0, const float* a, const float* b) const { one(row, c0, a); one(row, c0 + 16, b); } };
struct EpiWsc { Params p;
    HD void set_group(int) {}
    HD void operator()(int row, int c0, const float* a, const float* b) const { st_bf4(WSP(bf16_t, WS_WSC) + (size_t)row * 1024 + c0, a); st_bf4(WSP(bf16_t, WS_WSC) + (size_t)row * 1024 + c0 + 16, b); } };
struct EpiScore { Params p;
    HD void set_group(int) {}
    HD void operator()(int row, int c0, const float* a, const float* b) const {
        bf16_t* d = WSP(bf16_t, WS_SC) + ((size_t)(row >> 6) * 2048 + c0) * 64 + (row & 63);
        for (int j = 0; j < 4; ++j) { d[j * 64] = f2bf(a[j]); d[(16 + j) * 64] = f2bf(b[j]); }
    } };

HD void ph_copy_x(const Params& p, long tid, long nthr) {
    const long n4 = (long)NR * DM / 4;
    for (long i = tid; i < n4; i += nthr) {
        const int row = (int)(i / (DM / 4)), c = (int)(i % (DM / 4)) * 4;
        const float* src = row < NRL ? p.in[I_X] + (size_t)row * DM + c : p.in[I_CTX] + (size_t)(row - NRL) * DM + c;
        *(fl4*)(xr_row(p, row) + c) = *(const fl4*)src;
    }
}
HD void ph_mod_small(const Params& p, long tid, long nthr) {
    for (long it = tid; it < 128 * 16; it += nthr) {
        const int pos = (int)(it / 16), i = (int)(it % 16);
        const float fr = exp2f(-(float)i * (13.287712379549449f / 16.0f)), ang = (float)pos * fr;
        WSP(float, WS_ROPE)[it * 2] = cosf(ang); WSP(float, WS_ROPE)[it * 2 + 1] = sinf(ang);
    }
    for (long it = tid; it < DEPTH; it += nthr) {
        const float* lq = p.in[I_DLAM] + it * 4 * 64; float s01 = 0.f, s23 = 0.f;
        for (int d = 0; d < 64; ++d) { s01 += lq[d] * lq[64 + d]; s23 += lq[128 + d] * lq[192 + d]; }
        const float lam_init = 0.8f - 0.6f * expf(-0.3f * (float)it);
        WSP(float, WS_LAMD)[it] = expf(s01) - expf(s23) + lam_init; WSP(float, WS_LAMD)[2 + it] = 1.f - lam_init;
    }
}
HD void ph_mod(const Params& p, long tid, long nthr) {
    const long items = (long)DEPTH * 6144;
    for (long it = tid; it < items; it += nthr) {
        const int l = (int)(it / 6144), col = (int)(it % 6144);
        float acc[B_ + 1]; for (int b = 0; b <= B_; ++b) acc[b] = 0.f;
        const float* w = p.in[I_ADAW] + (size_t)l * DM * 6144 + col;
        for (int d = 0; d < DM; ++d) { const float wv = w[(size_t)d * 6144];
            for (int b = 0; b < B_; ++b) acc[b] += siluf_(p.in[I_C][b * DM + d]) * wv;
            acc[B_] += siluf_(p.in[I_CCTX][d]) * wv; }
        const float bias = p.in[I_ADAB][l * 6144 + col];
        for (int b = 0; b <= B_; ++b) WSP(float, WS_MOD)[((size_t)(l * (B_ + 1) + b)) * 6144 + col] = acc[b] + bias;
    }
    for (long it = tid; it < 128 * 16; it += nthr) {
        const int pos = (int)(it / 16), i = (int)(it % 16);
        const float fr = exp2f(-(float)i * (13.287712379549449f / 16.0f)), ang = (float)pos * fr;
        WSP(float, WS_ROPE)[it * 2] = cosf(ang); WSP(float, WS_ROPE)[it * 2 + 1] = sinf(ang);
    }
    for (long it = tid; it < DEPTH; it += nthr) {
        const float* lq = p.in[I_DLAM] + it * 4 * 64; float s01 = 0.f, s23 = 0.f;
        for (int d = 0; d < 64; ++d) { s01 += lq[d] * lq[64 + d]; s23 += lq[128 + d] * lq[192 + d]; }
        const float lam_init = 0.8f - 0.6f * expf(-0.3f * (float)it);
        WSP(float, WS_LAMD)[it] = expf(s01) - expf(s23) + lam_init;
    }
}
HD void tr_item(const float* W, int K, int N, bf16_t* WT, long it) {
    const int n = (int)(it % N), k0 = (int)(it / N) * 8; bf8 o;
    for (int e = 0; e < 8; ++e) o.v[e] = f2bf(W[(size_t)(k0 + e) * N + n]);
    *(bf8*)(WT + (size_t)n * K + k0) = o;
}
HD void ph_prep_a(const Params& p, int l, long tid, long nthr) {
#ifdef HOST_EMU
    for (long it = tid; it < (long)INW * DM / 8; it += nthr) tr_item(p.in[I_WIN] + (size_t)l * DM * INW, DM, INW, WSP(bf16_t, WS_WIN), it);
#else
    for (long it = tid; it < (long)INW * DM / 8; it += nthr) {
        const int n = (int)(it % INW), k0 = (int)(it / INW) * 8; const float* W = p.in[I_WIN] + (size_t)l * DM * INW;
        float v[8]; for (int e = 0; e < 8; ++e) v[e] = fminf(fmaxf(W[(size_t)(k0 + e) * INW + n] * 256.f, -448.f), 448.f);
        int lo = 0, hi = 0; lo = __builtin_amdgcn_cvt_pk_fp8_f32(v[0], v[1], lo, false); lo = __builtin_amdgcn_cvt_pk_fp8_f32(v[2], v[3], lo, true);
        hi = __builtin_amdgcn_cvt_pk_fp8_f32(v[4], v[5], hi, false); hi = __builtin_amdgcn_cvt_pk_fp8_f32(v[6], v[7], hi, true);
        *(uint2*)(p.ws + WS_WG8 + (size_t)n * DM + k0) = make_uint2((unsigned)lo, (unsigned)hi);
    }
#endif
    for (long it = tid; it < (long)512 * 256 / 8; it += nthr) {
        const int n = (int)(it % 512), k0 = (int)(it / 512) * 8, src = (n & 1) ? 256 + (n >> 1) : (n >> 1); bf8 o;
        for (int e = 0; e < 8; ++e) o.v[e] = f2bf(p.in[I_GLUW][(size_t)l * 256 * 512 + (size_t)(k0 + e) * 512 + src]);
        *(bf8*)(WSP(bf16_t, WS_WGLU) + (size_t)n * 256 + k0) = o;
    }
    for (long it = tid; it < (long)1024 * 256 / 8; it += nthr) tr_item(p.in[I_WBS] + (size_t)l * 256 * 1024, 256, 1024, WSP(bf16_t, WS_WBS), it);
    for (long it = tid; it < (long)1024 * 512 / 8; it += nthr) tr_item(p.in[I_WBD] + (size_t)l * 512 * 1024, 512, 1024, WSP(bf16_t, WS_WBD), it);
    for (long it = tid; it < (long)1024 * 256 / 8; it += nthr) tr_item(p.in[I_WBN] + (size_t)l * 256 * 1024, 256, 1024, WSP(bf16_t, WS_WBN), it);
#ifdef HOST_EMU
    for (long it = tid; it < (long)1024 * 1024 / 8; it += nthr) tr_item(p.in[I_WOUT] + (size_t)l * 1024 * 1024, 1024, 1024, WSP(bf16_t, WS_WOUT), it);
#else
    for (long it = tid; it < (long)1024 * 1024 / 8; it += nthr) {
        const int n = (int)(it % 1024), k0 = (int)(it / 1024) * 8; const float* W = p.in[I_WOUT] + (size_t)l * 1024 * 1024;
        float v[8]; for (int e = 0; e < 8; ++e) v[e] = fminf(fmaxf(W[(size_t)(k0 + e) * 1024 + n] * 256.f, -448.f), 448.f);
        int lo = 0, hi = 0; lo = __builtin_amdgcn_cvt_pk_fp8_f32(v[0], v[1], lo, false); lo = __builtin_amdgcn_cvt_pk_fp8_f32(v[2], v[3], lo, true);
        hi = __builtin_amdgcn_cvt_pk_fp8_f32(v[4], v[5], hi, false); hi = __builtin_amdgcn_cvt_pk_fp8_f32(v[6], v[7], hi, true);
        *(uint2*)(p.ws + WS_WOUT + (size_t)n * 1024 + k0) = make_uint2((unsigned)lo, (unsigned)hi);
    }
#endif
#ifdef HOST_EMU
    for (long it = tid; it < (long)2048 * 1024; it += nthr) {
        const int d = (int)(it % 1024), hxn = (int)(it / 1024), hx = hxn >> 7;
        const float* wq = p.in[I_WQ] + (size_t)l * 1024 * 2048 + (size_t)d * 2048 + hx * 128;
        const float* sk = p.in[I_SUBK] + (size_t)l * 2048 * 128 + (size_t)hxn * 128;
        float s = 0.f; for (int j = 0; j < 128; ++j) s += wq[j] * sk[j];
        WSP(bf16_t, WS_WSC)[(size_t)hxn * 1024 + d] = f2bf(s);
    }
#else
    for (long it = tid; it < (long)1024 * 2048 / 8; it += nthr) { const float* src = p.in[I_WQ] + (size_t)l * 1024 * 2048 + it * 8; bf8 o;
        for (int e = 0; e < 8; ++e) o.v[e] = f2bf(src[e]);
        *(bf8*)(WSP(bf16_t, WS_WQB) + it * 8) = o; }
    for (long it = tid; it < (long)2048 * 256 / 8; it += nthr) { const int r = (int)(it >> 5), c0 = (int)(it & 31) * 8, hx = r >> 7, cl = c0 >> 7, j0 = c0 & 127; bf8 o;
        const float* src = p.in[I_SUBK] + (size_t)l * 2048 * 128 + (size_t)r * 128 + j0;
        for (int e = 0; e < 8; ++e) o.v[e] = (cl == (hx & 1)) ? f2bf(src[e]) : (bf16_t)0;
        *(bf8*)(WSP(bf16_t, WS_SKA) + (size_t)r * 256 + c0) = o; }
#endif
    for (long it = tid; it < 2 * 16 * 64; it += nthr) {
        const int dir = (int)(it / 1024), g = (int)(it / 64) % 16;
        const size_t li = (size_t)l * 2048 + it;
        double lre = p.in[I_LRE][li]; if (lre > -1e-4) lre = -1e-4; const double lim = p.in[I_LIM][li];
        const double dt = (double)expf(p.in[I_LSTEP][(size_t)l * 32 + dir * 16 + g]);
        const double are = lre * dt, aim = lim * dt;
        float* pw = WSP(float, WS_POW) + it * 33 * 2;
        for (int k = 0; k <= 32; ++k) { const double x = aim * k, nrev = rint(x * 0.15915494309189535), r = x - nrev * 6.283185307179586; const float m = expf((float)(are * k));
            pw[2 * k] = m * cosf((float)r); pw[2 * k + 1] = m * sinf((float)r); }
        const double bre_ = (double)pw[2] - 1.0, bim_ = (double)pw[3];
        const double den = lre * lre + lim * lim, fre = (bre_ * lre + bim_ * lim) / den, fim = (bim_ * lre - bre_ * lim) / den;
        for (int q = 0; q < 16; ++q) {
            const size_t bi = ((size_t)l * 2048 + it) * 16 + q; const double br = p.in[I_BRE][bi], bm = p.in[I_BIM][bi];
            float* bb = WSP(float, WS_BBAR) + (it * 16 + q) * 2;
            bb[0] = (float)(fre * br - fim * bm); bb[1] = (float)(fre * bm + fim * br);
        }
    }
}
HD void ph_prep_b(const Params& p, int l, long tid, long nthr) {
    const float* POW = WSP(const float, WS_POW); const float* BB = WSP(const float, WS_BBAR);
    for (long it = tid; it < (long)2 * 16 * 32 * 256; it += nthr) {
        const int q = (int)(it & 15), pp = (int)(it >> 4) & 15, lag = (int)(it >> 8) & 31, g = (int)(it >> 13) & 15, dir = (int)(it >> 17);
        float s = 0.f;
        for (int n = 0; n < 64; ++n) {
            const size_t sn = (size_t)(dir * 16 + g) * 64 + n;
            const size_t ci = (((size_t)l * 2 + dir) * 16 + g) * 1024 + (size_t)pp * 64 + n;
            const float cr = p.in[I_CRE][ci], cim = p.in[I_CIM][ci];
            const float pr = POW[(sn * 33 + lag) * 2], pi = POW[(sn * 33 + lag) * 2 + 1];
            const float br = BB[(sn * 16 + q) * 2], bi = BB[(sn * 16 + q) * 2 + 1];
            const float tr = pr * br - pi * bi, ti = pr * bi + pi * br;
            s += cr * tr - cim * ti;
        }
        WSP(float, WS_KK)[it] = s;
    }
    for (long it = tid; it < (long)16 * 256 * 512; it += nthr) {
        const int col = (int)(it % 512), r1 = (int)(it / 512) % 256, g = (int)(it / (512 * 256));
        const int i = col >> 4, q = col & 15, dir = r1 >> 7, n = (r1 >> 1) & 63, reim = r1 & 1, k = dir ? i : (TCH - 1 - i);
        const size_t sn = (size_t)(dir * 16 + g) * 64 + n;
        const float pr = POW[(sn * 33 + k) * 2], pi = POW[(sn * 33 + k) * 2 + 1], br = BB[(sn * 16 + q) * 2], bi = BB[(sn * 16 + q) * 2 + 1];
        WSP(bf16_t, WS_BT1)[it] = f2bf(reim ? (pr * bi + pi * br) : (pr * br - pi * bi));
    }
    for (long it = tid; it < (long)16 * 512 * 256; it += nthr) {
        const int kc = (int)(it % 256), rr = (int)(it / 256) % 512, g = (int)(it / (256 * 512));
        const int j = rr >> 4, pp = rr & 15, dir = kc >> 7, n = (kc >> 1) & 63, reim = kc & 1, k = dir ? (TCH - j) : (j + 1);
        const size_t sn = (size_t)(dir * 16 + g) * 64 + n;
        const size_t ci = (((size_t)l * 2 + dir) * 16 + g) * 1024 + (size_t)pp * 64 + n;
        const float cr = p.in[I_CRE][ci], cim = p.in[I_CIM][ci], pr = POW[(sn * 33 + k) * 2], pi = POW[(sn * 33 + k) * 2 + 1];
        WSP(bf16_t, WS_BT2)[((size_t)g * 512 + rr) * KSS + 512 + kc] = f2bf(reim ? -(cr * pi + cim * pr) : (cr * pr - cim * pi));
    }
}
HD void ph_prep_c(const Params& p, int l, long tid, long nthr) {
    const float* KK = WSP(const float, WS_KK);
    for (long it = tid; it < (long)16 * 512 * 512; it += nthr) {
        const int cc = (int)(it % 512), rr = (int)(it / 512) % 512, g = (int)(it / (512 * 512));
        const int j = rr >> 4, pp = rr & 15, i = cc >> 4, q = cc & 15;
        float v = 0.f;
        if (j >= i) v += KK[((((size_t)0 * 16 + g) * 32 + (j - i)) * 16 + pp) * 16 + q];
        if (i >= j) v += KK[((((size_t)1 * 16 + g) * 32 + (i - j)) * 16 + pp) * 16 + q];
        if (i == j && pp == q) v += p.in[I_SSMD][(size_t)l * 256 + g * 16 + pp];
        WSP(bf16_t, WS_BT2)[((size_t)g * 512 + rr) * KSS + cc] = f2bf(v);
    }
}
HD void norm_row(const Params& p, int l, int row, const float* gain, int seg_sh, int seg_sc) {
    const float* x = xr_row(p, row); float ss = 0.f;
    for (int c = 0; c < DM; ++c) ss += x[c] * x[c];
    const float rinv = 1.f / sqrtf(ss / DM + RMS_EPS);
    const int bb = row_bb(row); const float* sh = mod_ptr(p, l, bb, seg_sh); const float* sc = mod_ptr(p, l, bb, seg_sc);
    bf16_t* h = WSP(bf16_t, WS_H) + (size_t)row * DM;
    for (int c = 0; c < DM; ++c) h[c] = f2bf(x[c] * rinv * gain[c] * (1.f + sc[c]) + sh[c]);
}
HD void ph_norm(const Params& p, int l, int which, int nrows, long tid, long nthr) {
    const float* gain = p.in[which == 1 ? I_N1G : I_N2G] + (size_t)l * DM;
    for (long r = tid; r < nrows; r += nthr) norm_row(p, l, (int)r, gain, which == 1 ? 0 : 3, which == 1 ? 1 : 4);
}
#if defined(HOST_EMU)
HD float q8e_(float x, float sc) { float v = x * sc, ax = fabsf(v); if (ax > 448.f) ax = 448.f; int ex; frexpf(ax, &ex); ex -= 1; if (ex < -6) ex = -6; const float q = ldexpf(1.f, ex - 3); ax = nearbyintf(ax / q) * q; return copysignf(ax, v) / sc; }
#endif
HD void diff_attn_sub(const Params& p, int row, int hh, int ds, int m, int b, int nk, float* o, float& lsum) {
    const bf16_t* Q = WSP(const bf16_t, WS_QD) + (size_t)row * 512 + hh * 128 + m * 64;
    const bf16_t* K = WSP(const bf16_t, WS_KD) + hh * 128 + m * 64; const bf16_t* V = WSP(const bf16_t, WS_VD) + hh * 128 + ds * 16;
    float q[64];
    UNROLL for (int d8 = 0; d8 < 8; ++d8) { const bf8 t = *(const bf8*)(Q + d8 * 8); UNROLL for (int e = 0; e < 8; ++e) q[d8 * 8 + e] = bf2f(t.v[e]); }
#if defined(HOST_EMU) && defined(EMU_FP8QK)
    for (int d = 0; d < 64; ++d) q[d] = q8e_(q[d], 16.f);
#endif
    float mx = -1e30f, ls = 0.f;
    UNROLL for (int j = 0; j < 16; ++j) o[j] = 0.f;
    for (int k = 0; k < nk; ++k) {
        const int kr = k < C_ ? NRL + b * C_ + k : b * L_ + (k - C_);
        const bf16_t* kp = K + (size_t)kr * 512; const bf16_t* vp = V + (size_t)kr * 512;
        float s = 0.f;
        UNROLL for (int d8 = 0; d8 < 8; ++d8) { const bf8 t = *(const bf8*)(kp + d8 * 8); UNROLL for (int e = 0; e < 8; ++e) {
#if defined(HOST_EMU) && defined(EMU_FP8QK)
            s += q[d8 * 8 + e] * q8e_(bf2f(t.v[e]), 4.f);
#else
            s += q[d8 * 8 + e] * bf2f(t.v[e]);
#endif
            } }
        if (s > mx) { const float sc = exp2f(mx - s); ls *= sc; UNROLL for (int j = 0; j < 16; ++j) o[j] *= sc; mx = s; }
        float pr = exp2f(s - mx); ls += pr;
#if defined(HOST_EMU) && defined(EMU_FP8PV)
        pr = q8e_(pr, 256.f);
        UNROLL for (int h8 = 0; h8 < 2; ++h8) { const bf8 t = *(const bf8*)(vp + h8 * 8); UNROLL for (int e = 0; e < 8; ++e) o[h8 * 8 + e] += pr * q8e_(bf2f(t.v[e]), 1.f); }
#else
        UNROLL for (int h8 = 0; h8 < 2; ++h8) { const bf8 t = *(const bf8*)(vp + h8 * 8); UNROLL for (int e = 0; e < 8; ++e) o[h8 * 8 + e] += pr * bf2f(t.v[e]); }
#endif
    }
    lsum = ls;
}
HD void diff_attn_item(const Params& p, int l, int row, int hh, int ds) {
    const bool isctx = row >= NRL; const int b = isctx ? (row - NRL) / C_ : row / L_;
    const int nk = isctx ? C_ : C_ + L_;
    float o0[16], o1[16], l0, l1;
    diff_attn_sub(p, row, hh, ds, 0, b, nk, o0, l0);
    diff_attn_sub(p, row, hh, ds, 1, b, nk, o1, l1);
    const float lam = WSP(const float, WS_LAMD)[l];
    bf16_t* y = WSP(bf16_t, WS_YD) + (size_t)row * 512 + hh * 128 + ds * 16;
    bf8 r0, r1;
    UNROLL for (int j = 0; j < 8; ++j) { r0.v[j] = f2bf(o0[j] / l0 - lam * o1[j] / l1); r1.v[j] = f2bf(o0[8 + j] / l0 - lam * o1[8 + j] / l1); }
    *(bf8*)y = r0; *(bf8*)(y + 8) = r1;
}
HD void diff_norm_item(const Params& p, int l, int row, int hh) {
    bf16_t* y = WSP(bf16_t, WS_YD) + (size_t)row * 512 + hh * 128; float ss = 0.f;
    for (int d = 0; d < 128; ++d) { const float v = bf2f(y[d]); ss += v * v; }
    const float lam_init = 0.8f - 0.6f * expf(-0.3f * (float)l);
    const float rinv = 1.f / sqrtf(ss / 128.f + RMS_EPS) * (1.f - lam_init);
    const float* sg = p.in[I_SUBLN] + (size_t)l * 128;
    for (int d = 0; d < 128; ++d) y[d] = f2bf(bf2f(y[d]) * rinv * sg[d]);
}
HD void na_attn_item(const Params& p, int l, int row, int hh, int ds) {
    const bool isctx = row >= NRL; const int b = isctx ? (row - NRL) / C_ : row / L_;
    const bf16_t* Q = WSP(const bf16_t, WS_QN) + (size_t)row * 256 + hh * 64;
    const bf16_t* K = WSP(const bf16_t, WS_KN); const bf16_t* V = WSP(const bf16_t, WS_VN);
    float q[64];
    UNROLL for (int d8 = 0; d8 < 8; ++d8) { const bf8 t = *(const bf8*)(Q + d8 * 8); UNROLL for (int e = 0; e < 8; ++e) q[d8 * 8 + e] = bf2f(t.v[e]); }
    const int nloc = isctx ? 0 : 128; const int nk = nloc + C_;
    int r = 0, c = 0, rs = 0, cs = 0;
    if (!isctx) { const int t = row % L_; r = t / GRW; c = t % GRW; const int kh = GRR < 8 ? GRR : 8; rs = r - kh / 2; if (rs < 0) rs = 0; if (rs > GRR - kh) rs = GRR - kh; cs = c - 8; if (cs < 0) cs = 0; if (cs > GRW - 16) cs = GRW - 16; }
    const float* rpb = p.in[I_RPB] + ((size_t)l * 4 + hh) * 15 * 31;
    float o[16], mx = -1e30f, ls = 0.f;
    UNROLL for (int j = 0; j < 16; ++j) o[j] = 0.f;
    for (int k = 0; k < nk; ++k) {
        int kr; float bias = 0.f;
        if (k < nloc) { const int krr = rs + (k >> 4), kc = cs + (k & 15); kr = b * L_ + krr * GRW + kc;
            int dc = kc - c + 15; if (dc < 0) dc = 0; if (dc > 30) dc = 30; bias = rpb[(krr - r + 7) * 31 + dc] * LOG2E; }
        else kr = NRL + b * C_ + (k - nloc);
        const bf16_t* kp = K + (size_t)kr * 256 + hh * 64; const bf16_t* vp = V + (size_t)kr * 256 + hh * 64 + ds * 16;
        float s = bias;
        UNROLL for (int d8 = 0; d8 < 8; ++d8) { const bf8 t = *(const bf8*)(kp + d8 * 8); UNROLL for (int e = 0; e < 8; ++e) {
#if defined(HOST_EMU) && defined(EMU_FP8QK)
            s += q[d8 * 8 + e] * q8e_(bf2f(t.v[e]), 4.f);
#else
            s += q[d8 * 8 + e] * bf2f(t.v[e]);
#endif
            } }
        if (s > mx) { const float sc = exp2f(mx - s); ls *= sc; UNROLL for (int j = 0; j < 16; ++j) o[j] *= sc; mx = s; }
        float pr = exp2f(s - mx); ls += pr;
#if defined(HOST_EMU) && defined(EMU_FP8PV)
        pr = q8e_(pr, 256.f);
        UNROLL for (int h8 = 0; h8 < 2; ++h8) { const bf8 t = *(const bf8*)(vp + h8 * 8); UNROLL for (int e = 0; e < 8; ++e) o[h8 * 8 + e] += pr * q8e_(bf2f(t.v[e]), 1.f); }
#else
        UNROLL for (int h8 = 0; h8 < 2; ++h8) { const bf8 t = *(const bf8*)(vp + h8 * 8); UNROLL for (int e = 0; e < 8; ++e) o[h8 * 8 + e] += pr * bf2f(t.v[e]); }
#endif
    }
    bf16_t* y = WSP(bf16_t, WS_YN) + (size_t)row * 256 + hh * 64 + ds * 16;
    bf8 o0, o1;
    UNROLL for (int j = 0; j < 8; ++j) { o0.v[j] = f2bf(o[j] / ls); o1.v[j] = f2bf(o[8 + j] / ls); }
    *(bf8*)y = o0; *(bf8*)(y + 8) = o1;
}
HD void ph_diff_naive(const Params& p, int l, long tid, long nthr) {
    const int nrows = (l == 0) ? NR : NRL;
    for (long it = tid; it < (long)nrows * 32; it += nthr) diff_attn_item(p, l, (int)(it >> 5), (int)(it >> 3) & 3, (int)(it & 7));
}
HD void ph_na_naive(const Params& p, int l, long tid, long nthr) {
    const int nrows = (l == 0) ? NR : NRL;
    for (long it = tid; it < (long)nrows * 16; it += nthr) na_attn_item(p, l, (int)(it >> 4), (int)(it >> 2) & 3, (int)(it & 3));
}
HD void ph_attn_naive(const Params& p, int l, long tid, long nthr) { ph_diff_naive(p, l, tid, nthr); ph_na_naive(p, l, tid, nthr); }
HD void ph_diff_norm(const Params& p, int l, long tid, long nthr) {
    const int nrows = (l == 0) ? NR : NRL;
    for (long it = tid; it < (long)nrows * 4; it += nthr) diff_norm_item(p, l, (int)(it >> 2), (int)(it & 3));
}
HD void ph_ssm1_naive(const Params& p, long tid, long nthr) {
    for (int g = 0; g < 16; ++g) { EpiSsm1 e{p, g};
        naive_gemm(WSP(const bf16_t, WS_ASSM) + (size_t)g * NCH * KSS, KSS, WSP(const bf16_t, WS_BT1) + (size_t)g * 256 * 512, 512, NCH, 256, 512, e, tid, nthr); }
}
HD void ph_ssm_carry(const Params& p, long tid, long nthr) {
    for (long it = tid; it < (long)B_ * 16 * 2 * 64; it += nthr) {
        const int n = (int)(it & 63), dir = (int)(it >> 6) & 1, g = (int)(it >> 7) & 15, b = (int)(it >> 11);
        const size_t sn = (size_t)(dir * 16 + g) * 64 + n;
        const float lr = WSP(const float, WS_POW)[(sn * 33 + 32) * 2], li = WSP(const float, WS_POW)[(sn * 33 + 32) * 2 + 1];
        float sr = 0.f, si = 0.f;
        const int nsteps = CCH + LCH;
        for (int s = 0; s < nsteps; ++s) {
            int chunk;
            if (dir == 0) chunk = s < CCH ? NRL / TCH + b * CCH + s : b * LCH + (s - CCH);
            else chunk = s < CCH ? NRL / TCH + b * CCH + (CCH - 1 - s) : b * LCH + (LCH - 1 - (s - CCH));
            bf16_t* d = WSP(bf16_t, WS_ASSM) + ((size_t)(g * NCH + chunk)) * KSS + 512 + dir * 128 + n * 2;
            d[0] = f2bf(sr); d[1] = f2bf(si);
            const float* sl = WSP(const float, WS_SLOC) + ((size_t)(g * NCH + chunk)) * 256 + dir * 128 + n * 2;
            const float nr = lr * sr - li * si + sl[0], ni = lr * si + li * sr + sl[1];
            sr = nr; si = ni;
        }
    }
}
HD void ph_ssm2_naive(const Params& p, long tid, long nthr) {
    for (int g = 0; g < 16; ++g) { EpiSsm2 e{p, g};
        naive_gemm(WSP(const bf16_t, WS_ASSM) + (size_t)g * NCH * KSS, KSS, WSP(const bf16_t, WS_BT2) + (size_t)g * 512 * KSS, KSS, NCH, 512, KSS, e, tid, nthr); }
}
HD unsigned ord_key(float v) { const unsigned u = f2u(v); return (u & 0x80000000u) ? ~u : (u | 0x80000000u); }
HD float ord_val(unsigned k) { const unsigned u = (k & 0x80000000u) ? (k & 0x7fffffffu) : ~k; return u2f(u); }
#define TK_INSERT(L, x) do { unsigned x_ = (x); UNROLL for (int j_ = 0; j_ < 16; ++j_) { const unsigned hi_ = L[j_] > x_ ? L[j_] : x_; x_ = L[j_] > x_ ? x_ : L[j_]; L[j_] = hi_; } } while (0)
template <int K, int J> HD void bitonic_stage16(unsigned* v) {
    UNROLL for (int i = 0; i < 16; ++i) { const int l = i ^ J; if (l > i) { const bool desc = ((i & K) == 0); const unsigned a = v[i], b = v[l]; const unsigned hi = a > b ? a : b, lo = a > b ? b : a; v[i] = desc ? hi : lo; v[l] = desc ? lo : hi; } }
}
HD void bitonic_sort16(unsigned* v) {
    bitonic_stage16<2, 1>(v);
    bitonic_stage16<4, 2>(v); bitonic_stage16<4, 1>(v);
    bitonic_stage16<8, 4>(v); bitonic_stage16<8, 2>(v); bitonic_stage16<8, 1>(v);
    bitonic_stage16<16, 8>(v); bitonic_stage16<16, 4>(v); bitonic_stage16<16, 2>(v); bitonic_stage16<16, 1>(v);
}
HD void top16_merge(unsigned* R, const unsigned* G) {
    UNROLL for (int i = 0; i < 16; ++i) { const unsigned g = G[15 - i]; R[i] = R[i] > g ? R[i] : g; }
    bitonic_stage16<16, 8>(R); bitonic_stage16<16, 4>(R); bitonic_stage16<16, 2>(R); bitonic_stage16<16, 1>(R);
}
HD void topk_item(const Params& p, int row, int h) {
    float sv[2][16]; unsigned long long ilo[2], ihi[2];
    {
        unsigned L0[16], L1[16];
        const bf16_t* s0 = WSP(const bf16_t, WS_SC) + ((size_t)(row >> 6) * 2048 + (h * 2) * 128) * 64 + (row & 63); const bf16_t* s1 = s0 + 128 * 64;
        float c0_[16], c1_[16], n0_[16], n1_[16];
        UNROLL for (int k = 0; k < 16; ++k) { c0_[k] = bf2f(s0[k * 64]); c1_[k] = bf2f(s1[k * 64]); }
        for (int n0 = 0; n0 < 128; n0 += 16) { unsigned G0[16], G1[16];
            if (n0 + 16 < 128) { UNROLL for (int k = 0; k < 16; ++k) { n0_[k] = bf2f(s0[(n0 + 16 + k) * 64]); n1_[k] = bf2f(s1[(n0 + 16 + k) * 64]); } }
            UNROLL for (int k = 0; k < 16; ++k) { G0[k] = (ord_key(c0_[k]) & ~127u) | (unsigned)(127 - (n0 + k)); G1[k] = (ord_key(c1_[k]) & ~127u) | (unsigned)(127 - (n0 + k)); }
            bitonic_sort16(G0); bitonic_sort16(G1);
            if (n0 == 0) { UNROLL for (int k = 0; k < 16; ++k) { L0[k] = G0[k]; L1[k] = G1[k]; } } else { top16_merge(L0, G0); top16_merge(L1, G1); }
            UNROLL for (int k = 0; k < 16; ++k) { c0_[k] = n0_[k]; c1_[k] = n1_[k]; } }
        unsigned long long lo = 0ull, hi = 0ull;
        UNROLL for (int j = 0; j < 16; ++j) { const unsigned long long id = (unsigned long long)(127u - (L0[j] & 127u)); if (j < 8) lo |= id << (8 * j); else hi |= id << (8 * (j - 8)); sv[0][j] = ord_val(L0[j] & ~127u); }
        ilo[0] = lo; ihi[0] = hi; lo = 0ull; hi = 0ull;
        UNROLL for (int j = 0; j < 16; ++j) { const unsigned long long id = (unsigned long long)(127u - (L1[j] & 127u)); if (j < 8) lo |= id << (8 * j); else hi |= id << (8 * (j - 8)); sv[1][j] = ord_val(L1[j] & ~127u); }
        ilo[1] = lo; ihi[1] = hi;
    }
    unsigned Lc[16]; UNROLL for (int j = 0; j < 16; ++j) Lc[j] = 0u;
    UNROLL for (int a = 0; a < 16; ++a) UNROLL for (int b = 0; b < 16; ++b) if ((a + 1) * (b + 1) <= 16) {
        const unsigned key = (ord_key(sv[0][a] + sv[1][b]) & ~255u) | (unsigned)(255 - (a * 16 + b)); TK_INSERT(Lc, key); }
    float best[16], mx = -1e30f; unsigned e[16];
    UNROLL for (int j = 0; j < 16; ++j) { best[j] = ord_val(Lc[j] & ~255u); if (best[j] > mx) mx = best[j]; const unsigned pos = 255u - (Lc[j] & 255u), a = pos >> 4, b = pos & 15u;
        const unsigned ia = (unsigned)(((a & 8u) ? ihi[0] : ilo[0]) >> (8u * (a & 7u))) & 0xffu, ib = (unsigned)(((b & 8u) ? ihi[1] : ilo[1]) >> (8u * (b & 7u))) & 0xffu;
        e[j] = ia * 128u + ib; }
    float sum = 0.f; UNROLL for (int j = 0; j < 16; ++j) { best[j] = expf(best[j] - mx); sum += best[j]; }
    UNROLL for (int j = 0; j < 16; ++j) { const int hk = h * 16 + j, pos = (hk & 7) * 16 + (hk >> 3); WSP(unsigned short, WS_EIDX)[(size_t)row * 128 + pos] = (unsigned short)e[j]; WSP(float, WS_GW)[(size_t)row * 128 + pos] = best[j] / sum; }
}
HD void ph_topk(const Params& p, int nrows, long tid, long nthr) { for (long it = tid; it < (long)nrows * 8; it += nthr) topk_item(p, (int)(it % nrows), (int)(it / nrows)); }
HD void ph_tables(const Params& p, int l, long tid, long nthr) {
    const long n8 = (long)16384 * 1024 / 8;
    for (long it = tid; it < 2 * n8; it += nthr) {
        const int w = it >= n8; const long i = it - (w ? n8 : 0);
        const float* src = p.in[w ? I_PV : I_PU] + (size_t)l * 16384 * 1024 + i * 8; bf8 o;
#ifdef EMU_FP8
        for (int e = 0; e < 8; ++e) { const float sc = w ? 16.f : 256.f; float x = src[e] * sc, ax = fabsf(x); if (ax > 448.f) ax = 448.f;
            int ex; frexpf(ax, &ex); ex -= 1; if (ex < -6) ex = -6; const float q = ldexpf(1.f, ex - 3); ax = nearbyintf(ax / q) * q; o.v[e] = f2bf(copysignf(ax, x) / sc); }
#else
        for (int e = 0; e < 8; ++e) o.v[e] = f2bf(src[e]);
#endif
        *(bf8*)(WSP(bf16_t, w ? WS_VT : WS_UT) + i * 8) = o;
    }
}
HD void ph_peer_act_naive(const Params& p, int nrows, long tid, long nthr) {
    for (long it = tid; it < (long)nrows * 128; it += nthr) {
        const int row = (int)(it >> 7); const int e = WSP(const unsigned short, WS_EIDX)[it];
        const bf16_t* u = WSP(const bf16_t, WS_UT) + (size_t)e * 1024; const bf16_t* h = WSP(const bf16_t, WS_H) + (size_t)row * DM;
        float s = 0.f; for (int d = 0; d < DM; ++d) s += bf2f(u[d]) * bf2f(h[d]);
        WSP(float, WS_GW)[it] *= gelu_tanh(s);
    }
}
HD void ph_peer_out_naive(const Params& p, int l, int nrows, long tid, long nthr) {
    for (long it = tid; it < (long)nrows * 256; it += nthr) {
        const int row = (int)(it >> 8), c = (int)(it & 255) * 4; float o[4] = {0.f, 0.f, 0.f, 0.f};
        for (int hk = 0; hk < 128; ++hk) { const int e = WSP(const unsigned short, WS_EIDX)[(size_t)row * 128 + hk]; const float w = WSP(const float, WS_GW)[(size_t)row * 128 + hk];
            const bf16_t* v = WSP(const bf16_t, WS_VT) + (size_t)e * 1024 + c; for (int j = 0; j < 4; ++j) o[j] += w * bf2f(v[j]); }
        float* x = xr_row(p, row) + c; const float* g2 = mod_ptr(p, l, row_bb(row), 5) + c;
        for (int j = 0; j < 4; ++j) x[j] += g2[j] * o[j];
    }
}
HD void ph_final_norm(const Params& p, long tid, long nthr) {
    for (long r = tid; r < NRL; r += nthr) { float* x = p.out + (size_t)r * DM; float ss = 0.f; for (int c = 0; c < DM; ++c) ss += x[c] * x[c];
        const float rinv = 1.f / sqrtf(ss / DM + RMS_EPS); for (int c = 0; c < DM; ++c) x[c] = x[c] * rinv * p.in[I_FNG][c]; }
}


#if defined(HOST_EMU) && defined(EMU_FP8G)
HD float q8_(float x, float sc) { float v = x * sc, ax = fabsf(v); if (ax > 448.f) ax = 448.f; int ex; frexpf(ax, &ex); ex -= 1; if (ex < -6) ex = -6; const float q = ldexpf(1.f, ex - 3); ax = nearbyintf(ax / q) * q; return copysignf(ax, v) / sc; }
#ifndef EMU_QCOL
#define EMU_QCOL(c) ((c) >= 2560)
#endif
struct EpiWinGE { Params p; const bf16_t* Hq;
    HD void operator()(int row, int c0, const float* a, const float* b) const { EpiWin e{p}; if (EMU_QCOL(c0)) e.one(row, c0, a, b, true); if (EMU_QCOL(c0 + 16)) e.one(row, c0 + 16, b, a, false); } };
static bf16_t* g_emu_tmp = nullptr;
#define EMU_FP8G_STEP
#define EMU_FP8G_AFTER(BAR) { bf16_t* Hq = g_emu_tmp; bf16_t* Wq = g_emu_tmp + (size_t)NR * DM; \
        for (long i = tid; i < (long)NR * DM; i += nthr) Hq[i] = f2bf(q8_(bf2f(WSP(const bf16_t, WS_H)[i]), 1.f)); \
        for (long i = tid; i < (long)INW * DM; i += nthr) Wq[i] = f2bf(q8_(bf2f(WSP(const bf16_t, WS_WIN)[i]), 256.f)); \
        BAR(); \
        { EpiWinGE e{p, Hq}; naive_gemm(Hq, DM, Wq, DM, NR, INW, DM, e, tid, nthr); } BAR(); }
#else
#define EMU_FP8G_STEP
#define EMU_FP8G_AFTER(BAR)
#endif
#if defined(HOST_EMU) && defined(EMU_FP8WO)
#define EMU_FP8WO_STEP(BAR) { for (long i = tid; i < (long)nact * DM; i += nthr) WSP(bf16_t, WS_MB)[i] = f2bf(q8e_(bf2f(WSP(const bf16_t, WS_MB)[i]), 4.f)); \
        for (long i = tid; i < (long)DM * DM; i += nthr) WSP(bf16_t, WS_WOUT)[i] = f2bf(q8e_(bf2f(WSP(const bf16_t, WS_WOUT)[i]), 256.f)); BAR(); }
#else
#define EMU_FP8WO_STEP(BAR)
#endif
#define NAIVE_PROGRAM(BAR) \
    ph_copy_x(p, tid, nthr); ph_mod(p, tid, nthr); BAR(); \
    for (int l = 0; l < DEPTH; ++l) { \
        const int nact = (l == 0) ? NR : NRL; \
        ph_prep_a(p, l, tid, nthr); ph_norm(p, l, 1, NR, tid, nthr); BAR(); \
        ph_prep_b(p, l, tid, nthr); BAR(); \
        ph_prep_c(p, l, tid, nthr); \
        EMU_FP8G_STEP \
        { EpiWin e{p}; naive_gemm(WSP(const bf16_t, WS_H), DM, WSP(const bf16_t, WS_WIN), DM, NR, INW, DM, e, tid, nthr); } BAR(); \
        EMU_FP8G_AFTER(BAR) \
        ph_ssm1_naive(p, tid, nthr); ph_attn_naive(p, l, tid, nthr); BAR(); \
        ph_ssm_carry(p, tid, nthr); ph_diff_norm(p, l, tid, nthr); BAR(); \
        ph_ssm2_naive(p, tid, nthr); BAR(); \
        { EpiGlu e{p}; naive_gemm(WSP(const bf16_t, WS_YG), 256, WSP(const bf16_t, WS_WGLU), 256, nact, 512, 256, e, tid, nthr); } BAR(); \
        { EpiMerge e{p, WS_SGS, false}; naive_gemm(WSP(const bf16_t, WS_YS), 256, WSP(const bf16_t, WS_WBS), 256, nact, DM, 256, e, tid, nthr); } BAR(); \
        { EpiMerge e{p, WS_SGD, true}; naive_gemm(WSP(const bf16_t, WS_YD), 512, WSP(const bf16_t, WS_WBD), 512, nact, DM, 512, e, tid, nthr); } BAR(); \
        { EpiMerge e{p, WS_SGN, true}; naive_gemm(WSP(const bf16_t, WS_YN), 256, WSP(const bf16_t, WS_WBN), 256, nact, DM, 256, e, tid, nthr); } BAR(); \
        EMU_FP8WO_STEP(BAR) \
        { EpiWout e{p, l}; naive_gemm(WSP(const bf16_t, WS_MB), DM, WSP(const bf16_t, WS_WOUT), DM, nact, DM, DM, e, tid, nthr); } BAR(); \
        ph_norm(p, l, 2, nact, tid, nthr); ph_tables(p, l, tid, nthr); BAR(); \
        { EpiScore e{p}; naive_gemm(WSP(const bf16_t, WS_H), DM, WSP(const bf16_t, WS_WSC), DM, nact, 2048, DM, e, tid, nthr); } BAR(); \
        ph_topk(p, nact, tid, nthr); BAR(); \
        ph_peer_act_naive(p, nact, tid, nthr); BAR(); \
        ph_peer_out_naive(p, l, nact, tid, nthr); BAR(); \
    } \
    ph_final_norm(p, tid, nthr);

#ifndef HOST_EMU
#define XB_TMO      128
#define XB_XCNT(j)  (256  + 64 * (j))
#define XB_XSUB(j)  (1280 + 64 * (j))
#define XB_XGEN(j)  (2304 + 64 * (j))
#define XB_TOP      3328
#define XB_TOPGEN   3392
#define XCD_BAR_WORDS 3456
#define XB_SPIN_CAP (1u << 26)
#define LAS __attribute__((address_space(3)))
__device__ __forceinline__ unsigned xb_ld(unsigned* p)              { return __hip_atomic_load(p, __ATOMIC_RELAXED, __HIP_MEMORY_SCOPE_AGENT); }
__device__ __forceinline__ unsigned xb_add(unsigned* p, unsigned v) { return __hip_atomic_fetch_add(p, v, __ATOMIC_RELAXED, __HIP_MEMORY_SCOPE_AGENT); }
__device__ __forceinline__ unsigned xb_xcc_id() { return (unsigned)__builtin_amdgcn_s_getreg((3 << 11) | 20) & 0xFu; }
#define XB_SPIN(cond, bar) do { unsigned _sp = 0; while (cond) { __builtin_amdgcn_s_sleep(1); \
    if ((++_sp & 255u) == 0u) { if (xb_ld(&(bar)[XB_TMO])) break; if (_sp > XB_SPIN_CAP) { atomicAdd(&(bar)[XB_TMO], 1u); break; } } } } while (0)
struct XcdBarrier { unsigned* bar; unsigned x; volatile LAS unsigned* st; };
__device__ __forceinline__ float shx(float v, int mask, int lane) { return __int_as_float(__builtin_amdgcn_ds_bpermute((lane ^ mask) << 2, __float_as_int(v))); }
__device__ __forceinline__ int tid_of(int wave_s) { int l_; asm volatile("v_mbcnt_lo_u32_b32 %0, -1, 0\n\tv_mbcnt_hi_u32_b32 %0, -1, %0" : "=v"(l_)); return wave_s * 64 + l_; }
__device__ __forceinline__ XcdBarrier xcd_barrier_post(unsigned* bar, volatile LAS unsigned* st, int tid0) {
    XcdBarrier b; b.bar = bar; b.x = xb_xcc_id(); b.st = st;
    if (tid0 == 0) (void)xb_add(&bar[XB_XCNT(b.x)], 1u);
    return b;
}
__device__ __forceinline__ void xcd_barrier_complete(unsigned* bar, unsigned x, unsigned& nloc, unsigned& nx) {
    const unsigned G = gridDim.x * gridDim.y * gridDim.z;
    unsigned sum, cnt, mine, sp = 0u;
    for (;;) {
        sum = 0u; cnt = 0u; mine = 0u;
#pragma unroll
        for (unsigned j = 0; j < 16; ++j) { const unsigned c = xb_ld(&bar[XB_XCNT(j)]); sum += c; cnt += (c > 0u) ? 1u : 0u; mine = (j == x) ? c : mine; }
        if (sum == G) break;
        __builtin_amdgcn_s_sleep(1);
        if ((++sp & 255u) == 0u) { if (xb_ld(&bar[XB_TMO])) break; if (sp > XB_SPIN_CAP) { atomicAdd(&bar[XB_TMO], 1u); break; } }
    }
    nloc = mine > 0u ? mine : 1u; nx = cnt > 0u ? cnt : 1u;
}
__device__ __forceinline__ void xcd_barrier(const XcdBarrier& b, int tid0) {
    asm volatile("s_waitcnt vmcnt(0)" ::: "memory");
    __syncthreads();
    if (tid0 == 0) {
        unsigned* bar = b.bar;
        __builtin_amdgcn_s_waitcnt(0);
        unsigned nloc = b.st[0], nx = b.st[1];
        if (nloc == 0u) { xcd_barrier_complete(bar, b.x, nloc, nx); b.st[0] = nloc; b.st[1] = nx; }
        const unsigned old = xb_add(&bar[XB_XSUB(b.x)], 1u);
        const unsigned gen = old / nloc;
        if (old + 1u == (gen + 1u) * nloc) {
            __builtin_amdgcn_fence(__ATOMIC_RELEASE, "agent");
            asm volatile("s_waitcnt vmcnt(0)" ::: "memory");
            const unsigned og = xb_add(&bar[XB_TOP], 1u);
            const unsigned tg = og / nx;
            if (og + 1u == (tg + 1u) * nx) xb_add(&bar[XB_TOPGEN], 1u);
            else XB_SPIN(xb_ld(&bar[XB_TOPGEN]) == tg, bar);
            __builtin_amdgcn_fence(__ATOMIC_ACQUIRE, "agent");
            xb_add(&bar[XB_XGEN(b.x)], 1u);
            asm volatile("s_waitcnt vmcnt(0)" ::: "memory");
        } else {
            XB_SPIN(xb_ld(&bar[XB_XGEN(b.x)]) == gen, bar);
            __builtin_amdgcn_fence(__ATOMIC_ACQUIRE, "agent");
            asm volatile("s_waitcnt vmcnt(0)" ::: "memory");
        }
    }
    __syncthreads();
}


namespace pg8 {
#define PG8_LAS __attribute__((address_space(3)))
typedef unsigned short bf16_t;
typedef short bf16x8 __attribute__((ext_vector_type(8)));
typedef float f32x4 __attribute__((ext_vector_type(4)));
typedef unsigned u32x4 __attribute__((ext_vector_type(4)));
constexpr int BM = 256, BK = 64, HALF = 128, HTB = HALF * BK * 2  , STAGE_BYTES = 8 * HTB, NXCD = 8, WGM = 8;

__host__ __device__ __forceinline__ int lds_byte(int r, int c) { const int st = (r >> 4) * 2 + (c >> 5), rr = r & 15, cc = c & 31, ob = rr * 64 + cc * 2; return st * 1024 + (ob ^ (((ob >> 9) & 1) << 5)); }
__host__ __device__ __forceinline__ void stage_rc(int b, int& R, int& C) { const int st = b / 1024, sb = b % 1024, swz = sb ^ (((sb >> 9) & 1) << 5); R = (st >> 1) * 16 + swz / 64; C = (st & 1) * 32 + (swz % 64) / 2; }
__host__ __device__ __forceinline__ int perm32(int rho) { const int n = rho >> 4, i = rho & 15; return 8 * (i >> 2) + 4 * n + (i & 3); }

struct Unit { int pm, pn, g; long arow, brow, bcol; };
struct Gemm { const bf16_t* A; const bf16_t* Bt; int lda, ldb, K; };

template <class Epi, class Sched, bool ALIGN_EPI = false, bool SP2 = false, bool FP8 = false>
__device__ __forceinline__ void gemm_phase(PG8_LAS unsigned char* lds, const Gemm g, const Sched& S, const Epi& E, int tid_in) {
    int tid_ = tid_in; asm volatile("" : "+v"(tid_));
    const int tid = tid_, wid = __builtin_amdgcn_readfirstlane(tid >> 6), lane = tid & 63, wr = wid >> 2, wc = wid & 3, fr = lane & 15, fq = lane >> 4;
    const int K = g.K, nt = K / BK;
    struct VOff { unsigned v; size_t step; } voffA, voffB;
    { int R, C; stage_rc(tid * 16, R, C); const int Rb = Epi::PERM ? ((R & ~31) + perm32(R & 31)) : R;
      voffA.v = (unsigned)(R * g.lda + C) * 2u; voffB.v = (unsigned)(Rb * g.ldb + C) * 2u; voffA.step = (size_t)64 * g.lda * 2; voffB.step = (size_t)64 * g.ldb * 2; }
    const size_t kstep = (size_t)(BK * 2);
    const size_t hstepA = (size_t)HALF * g.lda * 2, hstepB = (size_t)HALF * g.ldb * 2;
    const unsigned ldsw = (unsigned)wid * 1024u;
    const int aoff = lds_byte(wr * 64 + fr, fq * 8), boff = lds_byte(wc * 32 + fr, fq * 8);
#define PG8_SA(b, h) (((b) * 2 + (h)) * HTB)
#define PG8_SB(b, h) ((4 + (b) * 2 + (h)) * HTB)
#define PG8_STAGE(bufoff, gbase, voff) do { _Pragma("unroll") for (int _i = 0; _i < 2; ++_i) \
        __builtin_amdgcn_global_load_lds((const unsigned*)((const char*)(gbase) + _i * (voff).step + (voff).v), (PG8_LAS unsigned*)(lds + (bufoff) + ldsw + _i * 8192), 16, 0, 0); } while (0)
#define PG8_LDA(dst, b, h) do { _Pragma("unroll") for (int m = 0; m < 4; ++m) _Pragma("unroll") for (int k = 0; k < 2; ++k) dst[m][k] = *(const PG8_LAS bf16x8*)(lds + PG8_SA(b, h) + aoff + m * 2048 + k * 1024); } while (0)
#define PG8_LDB(dst, b, h) do { _Pragma("unroll") for (int n = 0; n < 2; ++n) _Pragma("unroll") for (int k = 0; k < 2; ++k) dst[n][k] = *(const PG8_LAS bf16x8*)(lds + PG8_SB(b, h) + boff + n * 2048 + k * 1024); } while (0)
#define PG8_MMA(ai, bj, At, Bt) do { __builtin_amdgcn_s_setprio(1); \
        if constexpr (FP8) { _Pragma("unroll") for (int m = 0; m < 4; ++m) _Pragma("unroll") for (int n = 0; n < 2; ++n) { \
            typedef int i32x8_ __attribute__((ext_vector_type(8))); typedef int i32x4_ __attribute__((ext_vector_type(4))); \
            const i32x8_ fa_ = __builtin_shufflevector(__builtin_bit_cast(i32x4_, Bt[n][0]), __builtin_bit_cast(i32x4_, Bt[n][1]), 0, 1, 2, 3, 4, 5, 6, 7); \
            const i32x8_ fb_ = __builtin_shufflevector(__builtin_bit_cast(i32x4_, At[m][0]), __builtin_bit_cast(i32x4_, At[m][1]), 0, 1, 2, 3, 4, 5, 6, 7); \
            acc[ai][bj][m][n] = __builtin_amdgcn_mfma_scale_f32_16x16x128_f8f6f4(fa_, fb_, acc[ai][bj][m][n], 0, 0, 0, 0x7b7b7b7b, 0, 0x7b7b7b7b); } } \
        else { _Pragma("unroll") for (int m = 0; m < 4; ++m) _Pragma("unroll") for (int n = 0; n < 2; ++n) _Pragma("unroll") for (int k = 0; k < 2; ++k) \
            acc[ai][bj][m][n] = __builtin_amdgcn_mfma_f32_16x16x32_bf16(Bt[n][k], At[m][k], acc[ai][bj][m][n], 0, 0, 0); } \
        __builtin_amdgcn_s_setprio(0); } while (0)
#define PG8_WAIT_V(n) asm volatile("s_waitcnt vmcnt(" #n ")" ::: "memory")
#define PG8_WAIT_L(n) asm volatile("s_waitcnt lgkmcnt(" #n ")" ::: "memory")
#define PG8_BAR __builtin_amdgcn_s_barrier()
#define PG8_SCHED __builtin_amdgcn_sched_barrier(0)
    Unit cur, nxt; int ui = 0;
    if (!S.next(0, cur)) return;
    f32x4 acc[2][2][4][2];
#pragma unroll
    for (int a = 0; a < 2; ++a)
#pragma unroll
        for (int b = 0; b < 2; ++b)
#pragma unroll
            for (int m = 0; m < 4; ++m)
#pragma unroll
                for (int n = 0; n < 2; ++n) acc[a][b][m][n] = (f32x4){0.f, 0.f, 0.f, 0.f};
    bf16x8 At[4][2], B0[2][2], B1[2][2];
    const char* cA = (const char*)g.A + (size_t)cur.arow * g.lda * 2; const char* cB = (const char*)g.Bt + ((size_t)cur.brow * g.ldb + cur.bcol) * 2;
    S.a_ready(cur);
    if constexpr (SP2) {
        PG8_STAGE(PG8_SB(0, 0), cB, voffB); PG8_STAGE(PG8_SB(0, 1), cB + hstepB, voffB); PG8_STAGE(PG8_SA(0, 0), cA, voffA); PG8_STAGE(PG8_SA(0, 1), cA + hstepA, voffA);
        if (wr == 1) PG8_BAR;
        PG8_WAIT_V(2); PG8_BAR;
        PG8_STAGE(PG8_SB(1, 0), cB + kstep, voffB); PG8_STAGE(PG8_SA(1, 0), cA + kstep, voffA); PG8_STAGE(PG8_SB(1, 1), cB + hstepB + kstep, voffB);
        PG8_WAIT_V(6); PG8_BAR;
    } else {
        PG8_STAGE(PG8_SB(0, 0), cB, voffB); PG8_STAGE(PG8_SA(0, 0), cA, voffA); PG8_STAGE(PG8_SB(0, 1), cB + hstepB, voffB); PG8_STAGE(PG8_SA(0, 1), cA + hstepA, voffA);
        if (wr == 1) PG8_BAR;
        PG8_WAIT_V(4); PG8_BAR;
        PG8_STAGE(PG8_SB(1, 0), cB + kstep, voffB); PG8_STAGE(PG8_SA(1, 0), cA + kstep, voffA); PG8_STAGE(PG8_SB(1, 1), cB + hstepB + kstep, voffB);
        PG8_WAIT_V(6); PG8_BAR;
    }
    for (;;) {
        const bool has_next = S.next(ui + 1, nxt);
        const char* nA = has_next ? (const char*)g.A + (size_t)nxt.arow * g.lda * 2 : cA; const char* nB = has_next ? (const char*)g.Bt + ((size_t)nxt.brow * g.ldb + nxt.bcol) * 2 : cB;
#pragma nounroll
        for (int t = 0; t < nt; t += 2) {
            const bool last = (t == nt - 2);
            const char* a1 = cA + (size_t)(t + 1) * kstep;
            const char* a2 = last ? nA : cA + (size_t)(t + 2) * kstep; const char* b2 = last ? nB : cB + (size_t)(t + 2) * kstep;
            const char* a3 = a2 + kstep; const char* b3 = b2 + kstep;
            if (last && has_next) S.a_ready(nxt);
            if constexpr (SP2) {
            PG8_LDB(B0, 0, 0); PG8_LDB(B1, 0, 1); PG8_SCHED; PG8_LDA(At, 0, 0); PG8_STAGE(PG8_SA(1, 1), a1 + hstepA, voffA);
            PG8_WAIT_V(8); PG8_WAIT_L(0); PG8_BAR; PG8_MMA(0, 0, At, B0); PG8_MMA(0, 1, At, B1); PG8_BAR; PG8_SCHED;
            PG8_LDA(At, 0, 1); PG8_STAGE(PG8_SB(0, 0), b2, voffB); PG8_STAGE(PG8_SB(0, 1), b2 + hstepB, voffB); PG8_STAGE(PG8_SA(0, 0), a2, voffA);
            PG8_WAIT_V(8); PG8_WAIT_L(0); PG8_BAR; PG8_MMA(1, 0, At, B0); PG8_MMA(1, 1, At, B1); PG8_BAR; PG8_SCHED;
            PG8_LDB(B0, 1, 0); PG8_LDB(B1, 1, 1); PG8_SCHED; PG8_LDA(At, 1, 0); PG8_STAGE(PG8_SA(0, 1), a2 + hstepA, voffA);
            PG8_WAIT_V(8); PG8_WAIT_L(0); PG8_BAR; PG8_MMA(0, 0, At, B0); PG8_MMA(0, 1, At, B1); PG8_BAR; PG8_SCHED;
            PG8_LDA(At, 1, 1); PG8_STAGE(PG8_SB(1, 0), b3, voffB); PG8_STAGE(PG8_SB(1, 1), b3 + hstepB, voffB); PG8_STAGE(PG8_SA(1, 0), a3, voffA);
            PG8_WAIT_V(8); PG8_WAIT_L(0); PG8_BAR; PG8_MMA(1, 0, At, B0); PG8_MMA(1, 1, At, B1); PG8_BAR; PG8_SCHED;
            } else {
            PG8_LDB(B0, 0, 0); PG8_SCHED; PG8_LDA(At, 0, 0); PG8_STAGE(PG8_SA(1, 1), a1 + hstepA, voffA);
            PG8_WAIT_L(8); PG8_BAR; PG8_WAIT_L(0); PG8_MMA(0, 0, At, B0); PG8_BAR; PG8_SCHED;
            PG8_LDB(B1, 0, 1); PG8_STAGE(PG8_SB(0, 0), b2, voffB);
            PG8_BAR; PG8_WAIT_L(0); PG8_MMA(0, 1, At, B1); PG8_BAR;
            PG8_LDA(At, 0, 1); PG8_STAGE(PG8_SA(0, 0), a2, voffA);
            PG8_BAR; PG8_WAIT_L(0); PG8_MMA(1, 0, At, B0); PG8_BAR; PG8_SCHED;
            PG8_STAGE(PG8_SB(0, 1), b2 + hstepB, voffB);
            PG8_WAIT_V(6); PG8_BAR; PG8_MMA(1, 1, At, B1); PG8_BAR;
            PG8_LDB(B0, 1, 0); PG8_SCHED; PG8_LDA(At, 1, 0); PG8_STAGE(PG8_SA(0, 1), a2 + hstepA, voffA);
            PG8_WAIT_L(8); PG8_BAR; PG8_WAIT_L(0); PG8_MMA(0, 0, At, B0); PG8_BAR; PG8_SCHED;
            PG8_LDB(B1, 1, 1); PG8_STAGE(PG8_SB(1, 0), b3, voffB);
            PG8_BAR; PG8_WAIT_L(0); PG8_MMA(0, 1, At, B1); PG8_BAR;
            PG8_LDA(At, 1, 1); PG8_STAGE(PG8_SA(1, 0), a3, voffA);
            PG8_BAR; PG8_WAIT_L(0); PG8_MMA(1, 0, At, B0); PG8_BAR; PG8_SCHED;
            PG8_STAGE(PG8_SB(1, 1), b3 + hstepB, voffB);
            PG8_WAIT_V(6); PG8_BAR; PG8_MMA(1, 1, At, B1); PG8_BAR;
            }
        }
        if constexpr (ALIGN_EPI) { if (wr == 0) PG8_BAR; }
        if constexpr (!Epi::AFTER_DRAIN) { E(acc, cur, wr, wc, fr, fq); S.done(cur); }
        if (!has_next) break;
#pragma unroll
        for (int a = 0; a < 2; ++a)
#pragma unroll
            for (int b = 0; b < 2; ++b)
#pragma unroll
                for (int m = 0; m < 4; ++m)
#pragma unroll
                    for (int n = 0; n < 2; ++n) acc[a][b][m][n] = (f32x4){0.f, 0.f, 0.f, 0.f};
        cur = nxt; cA = nA; cB = nB; ++ui;
        if constexpr (ALIGN_EPI) { if (wr == 1) PG8_BAR; }
    }
    PG8_WAIT_V(0);
    if constexpr (!ALIGN_EPI) { if (wr == 0) PG8_BAR; }
    PG8_BAR;
    if constexpr (Epi::AFTER_DRAIN) { E.fused(acc, cur, wr, wc, fr, fq, lds, wid, lane); S.done(cur); }
#undef PG8_SA
#undef PG8_SB
#undef PG8_STAGE
#undef PG8_LDA
#undef PG8_LDB
#undef PG8_MMA
#undef PG8_WAIT_V
#undef PG8_WAIT_L
#undef PG8_BAR
#undef PG8_SCHED
}
}

#define PG8_SP2 true
#define PG8_ALIGN true
typedef pg8::f32x4 f32x4;
struct SchedFlat {
    int nM, nN, nwg, G, c;
    __device__ __forceinline__ void init(int nM_, int nN_, int G_, int c_) { nM = nM_; nN = nN_; nwg = nM * nN; G = G_; c = c_; }
    __device__ __forceinline__ bool next(int i, pg8::Unit& u) const {
        const long L = (long)i * G + c; if (L >= nwg) return false;
        int wgid = (int)L; { const int q = nwg / 8, r = nwg % 8, xcd = wgid % 8, off = wgid / 8; wgid = (xcd < r ? xcd * (q + 1) : r * (q + 1) + (xcd - r) * q) + off; }
        const int nig = 8 * nN, gid = wgid / nig, fm = gid * 8, gsz = (nM - fm) < 8 ? (nM - fm) : 8;
        u.pm = fm + ((wgid % nig) % gsz); u.pn = (wgid % nig) / gsz; u.g = 0; u.arow = (long)u.pm * 256; u.brow = (long)u.pn * 256; u.bcol = 0; return true;
    }
    __device__ __forceinline__ void a_ready(const pg8::Unit&) const {}
    __device__ __forceinline__ void done(const pg8::Unit&) const {}
};
struct SchedGrouped {
    int tm, tn, arows, brows, G, c;
    __device__ __forceinline__ bool next(int i, pg8::Unit& u) const {
        const int L = i * G + c; if (L >= 16 * tm * tn) return false;
        const int g = L / (tm * tn), rem = L % (tm * tn);
        u.g = g; u.pm = rem % tm; u.pn = rem / tm; u.arow = (long)g * arows + u.pm * 256; u.brow = (long)g * brows + u.pn * 256; u.bcol = 0; return true;
    }
    __device__ __forceinline__ void a_ready(const pg8::Unit&) const {}
    __device__ __forceinline__ void done(const pg8::Unit&) const {}
};
struct SchedWsc {
    int G, c;
    __device__ __forceinline__ bool next(int i, pg8::Unit& u) const {
        const int L = i * G + c; if (L >= 32) return false;
        u.g = 0; u.pm = L & 7; u.pn = L >> 3; u.arow = (long)u.pm * 256; u.brow = (long)u.pn * 256; u.bcol = (long)u.pm * 256; return true;
    }
    __device__ __forceinline__ void a_ready(const pg8::Unit&) const {}
    __device__ __forceinline__ void done(const pg8::Unit&) const {}
};
template <class F> struct EpiNoFence { static constexpr bool value = false; };
template <> struct EpiNoFence<EpiMerge> { static constexpr bool value = true; };
template <> struct EpiNoFence<EpiWout> { static constexpr bool value = true; };
template <class F> struct EpiAdapt {
    static constexpr bool PERM = false, AFTER_DRAIN = false;
    F f;
    __device__ __forceinline__ void operator()(const f32x4 (&acc)[2][2][4][2], const pg8::Unit& u, int wr, int wc, int fr_, int fq_) const {
        int l2_; asm volatile("v_mbcnt_lo_u32_b32 %0, -1, 0\n\tv_mbcnt_hi_u32_b32 %0, -1, %0" : "=v"(l2_)); (void)fr_; (void)fq_;
        const int fr = l2_ & 15, fq = l2_ >> 4;
        F ff = f; ff.set_group(u.g);
#pragma unroll
        for (int bj = 0; bj < 2; ++bj) { const int c0 = u.pn * 256 + bj * 128 + wc * 32 + 4 * fq;
#pragma unroll
            for (int ai = 0; ai < 2; ++ai)
#pragma unroll
                for (int m = 0; m < 4; ++m) { int row = u.pm * 256 + ai * 128 + wr * 64 + m * 16 + fr; asm volatile("" : "+v"(row));
                    const f32x4 v0 = acc[ai][bj][m][0], v1 = acc[ai][bj][m][1];
                    const float a[4] = {v0[0], v0[1], v0[2], v0[3]}, b[4] = {v1[0], v1[1], v1[2], v1[3]};
                    ff(row, c0, a, b); if constexpr (!EpiNoFence<F>::value) asm volatile("" ::: "memory"); } }
    }
};


template <> struct EpiAdapt<EpiWinG> {
    static constexpr bool PERM = false, AFTER_DRAIN = false;
    EpiWinG f;
    template <int R> __device__ __forceinline__ void run(const f32x4 (&acc)[2][2][4][2], const pg8::Unit& u, int wr, int wc) const {
        int l2_; asm volatile("v_mbcnt_lo_u32_b32 %0, -1, 0\n\tv_mbcnt_hi_u32_b32 %0, -1, %0" : "=v"(l2_));
        const int fr = l2_ & 15, fq = l2_ >> 4;
#pragma unroll
        for (int bj = 0; bj < 2; ++bj) { const int c0 = u.pn * 256 + bj * 128 + wc * 32 + 4 * fq;
#pragma unroll
            for (int ai = 0; ai < 2; ++ai)
#pragma unroll
                for (int m = 0; m < 4; ++m) { int row = u.pm * 256 + ai * 128 + wr * 64 + m * 16 + fr; asm volatile("" : "+v"(row));
                    const f32x4 v0 = acc[ai][bj][m][0], v1 = acc[ai][bj][m][1];
                    const float a[4] = {v0[0], v0[1], v0[2], v0[3]}, b[4] = {v1[0], v1[1], v1[2], v1[3]};
                    f.template tile<R>(row, c0, a, b); asm volatile("" ::: "memory"); } }
    }
    __device__ __forceinline__ void operator()(const f32x4 (&acc)[2][2][4][2], const pg8::Unit& u, int wr, int wc, int, int) const {
        const int pn = __builtin_amdgcn_readfirstlane(u.pn);
        if (pn == 0) run<0>(acc, u, wr, wc); else if (pn < 5) run<1>(acc, u, wr, wc); else if (pn < 7) run<2>(acc, u, wr, wc); else if (pn < 10) run<3>(acc, u, wr, wc); else run<4>(acc, u, wr, wc);
    }
};

namespace dattn {
typedef short bf16x8 __attribute__((ext_vector_type(8)));
typedef short s16x4 __attribute__((ext_vector_type(4)));
typedef float f32x16 __attribute__((ext_vector_type(16)));
typedef unsigned u32x4 __attribute__((ext_vector_type(4)));
typedef float f32x2_t __attribute__((ext_vector_type(2))); typedef __bf16 bf16x2_t __attribute__((ext_vector_type(2)));
constexpr int KP = 272, VDT = 4160, KBYTES = 64 * KP, VBYTES = 4 * VDT, STAGE = KBYTES + VBYTES;
static_assert(3 * KBYTES + 2 * VBYTES <= 131072 && 4 * 128 * 32 * 4 <= 131072, "attention LDS");
__device__ __forceinline__ unsigned cvtpk(float lo, float hi) { f32x2_t v = {lo, hi}; bf16x2_t b = __builtin_convertvector(v, bf16x2_t); return __builtin_bit_cast(unsigned, b); }
__device__ __forceinline__ int crow(int reg, int h) { return (reg & 3) + 8 * (reg >> 2) + 4 * h; }
__device__ __forceinline__ float max3f(float a, float b, float c) { float r; asm("v_max3_f32 %0, %1, %2, %3" : "=v"(r) : "v"(a), "v"(b), "v"(c)); return r; }
__device__ __forceinline__ float max2f(float a, float b) { float r; asm("v_max_f32_e32 %0, %1, %2" : "=v"(r) : "v"(a), "v"(b)); return r; }
__device__ __forceinline__ float tile_max(f32x16& pA, f32x16& pB) {
    asm volatile("s_nop 15\n\ts_nop 7" : "+v"(pA), "+v"(pB));
    float a = max3f(pA[0], pA[1], pB[0]), b = max3f(pA[2], pA[3], pB[1]); a = max3f(a, pB[2], pB[3]);
#pragma unroll
    for (int r = 4; r < 16; r += 4) { a = max3f(a, pA[r], pA[r + 1]); b = max3f(b, pA[r + 2], pA[r + 3]); a = max3f(a, pB[r], pB[r + 1]); b = max3f(b, pB[r + 2], pB[r + 3]); }
    const float m = max2f(a, b);
    const unsigned tu = __float_as_uint(m); auto rr = __builtin_amdgcn_permlane32_swap(tu, tu, false, false);
    return max2f(__uint_as_float(rr[0]), __uint_as_float(rr[1]));
}
__device__ __forceinline__ float tile_max_old(const f32x16& pA, const f32x16& pB) {
    float a, b;
    asm volatile("v_max3_f32 %0, %1, %2, %3\n\tv_max3_f32 %0, %0, %4, %5\n\tv_max3_f32 %0, %0, %6, %7\n\tv_max3_f32 %0, %0, %8, %9\n\tv_max3_f32 %0, %0, %10, %11\n\tv_max3_f32 %0, %0, %12, %13\n\tv_max3_f32 %0, %0, %14, %15\n\tv_max_f32 %0, %0, %16"
        : "=&v"(a) : "v"(pA[0]), "v"(pA[1]), "v"(pA[2]), "v"(pA[3]), "v"(pA[4]), "v"(pA[5]), "v"(pA[6]), "v"(pA[7]), "v"(pA[8]), "v"(pA[9]), "v"(pA[10]), "v"(pA[11]), "v"(pA[12]), "v"(pA[13]), "v"(pA[14]), "v"(pA[15]));
    asm volatile("v_max3_f32 %0, %1, %2, %3\n\tv_max3_f32 %0, %0, %4, %5\n\tv_max3_f32 %0, %0, %6, %7\n\tv_max3_f32 %0, %0, %8, %9\n\tv_max3_f32 %0, %0, %10, %11\n\tv_max3_f32 %0, %0, %12, %13\n\tv_max3_f32 %0, %0, %14, %15\n\tv_max_f32 %0, %0, %16"
        : "=&v"(b) : "v"(pB[0]), "v"(pB[1]), "v"(pB[2]), "v"(pB[3]), "v"(pB[4]), "v"(pB[5]), "v"(pB[6]), "v"(pB[7]), "v"(pB[8]), "v"(pB[9]), "v"(pB[10]), "v"(pB[11]), "v"(pB[12]), "v"(pB[13]), "v"(pB[14]), "v"(pB[15]));
    const float m = max2f(a, b);
    const unsigned tu = __float_as_uint(m); auto rr = __builtin_amdgcn_permlane32_swap(tu, tu, false, false);
    return max2f(__uint_as_float(rr[0]), __uint_as_float(rr[1]));
}
#define DA_PACK(x, s) __builtin_bit_cast(bf16x8, (u32x4){cvtpk(x[8 * (s)], x[8 * (s) + 1]), cvtpk(x[8 * (s) + 2], x[8 * (s) + 3]), cvtpk(x[8 * (s) + 4], x[8 * (s) + 5]), cvtpk(x[8 * (s) + 6], x[8 * (s) + 7])})
typedef int i32x8 __attribute__((ext_vector_type(8))); typedef int i32x4 __attribute__((ext_vector_type(4)));
__device__ __forceinline__ int pk4f8(float a, float b, float c, float d) { int w = 0; w = __builtin_amdgcn_cvt_pk_fp8_f32(a, b, w, false); return __builtin_amdgcn_cvt_pk_fp8_f32(c, d, w, true); }
#define DA_RP1(w, a, b, c, d) do { w = __builtin_amdgcn_cvt_pk_fp8_f32(a, b, w, false); w = __builtin_amdgcn_cvt_pk_fp8_f32(c, d, w, true); } while (0)
#define DA_REPACK8(pf, x, y) do { DA_RP1(pf[0], x[0], x[1], x[2], x[3]); DA_RP1(pf[1], x[4], x[5], x[6], x[7]); DA_RP1(pf[2], x[8], x[9], x[10], x[11]); DA_RP1(pf[3], x[12], x[13], x[14], x[15]); \
        DA_RP1(pf[4], y[0], y[1], y[2], y[3]); DA_RP1(pf[5], y[4], y[5], y[6], y[7]); DA_RP1(pf[6], y[8], y[9], y[10], y[11]); DA_RP1(pf[7], y[12], y[13], y[14], y[15]); } while (0)
#define DA_PACK8(x, y) (i32x8){pk4f8(x[0], x[1], x[2], x[3]), pk4f8(x[4], x[5], x[6], x[7]), pk4f8(x[8], x[9], x[10], x[11]), pk4f8(x[12], x[13], x[14], x[15]), \
                               pk4f8(y[0], y[1], y[2], y[3]), pk4f8(y[4], y[5], y[6], y[7]), pk4f8(y[8], y[9], y[10], y[11]), pk4f8(y[12], y[13], y[14], y[15])}
typedef short v4i16_t __attribute__((ext_vector_type(4)));
__device__ __forceinline__ s16x4 vtr(const PG8_LAS unsigned char* q) { return __builtin_bit_cast(s16x4, __builtin_amdgcn_ds_read_tr16_b64_v4i16((PG8_LAS v4i16_t*)q)); }

__device__ __forceinline__ void diff_unit(const Params& p, int l, PG8_LAS unsigned char* lds, int b, int hh, int qrow0, bool isctx, int wave_s) {
    int tid_ = tid_of(wave_s); asm volatile("" : "+v"(tid_));
    const int tid = tid_, lane = tid & 63, wid = __builtin_amdgcn_readfirstlane(tid >> 6), m = wid >> 2, qt = wid & 3, r = lane & 31, h = lane >> 5;
    const int nkt = isctx ? C_ / 64 : (C_ + L_) / 64;
    i32x8 qf8;
    { const unsigned char GPTR* qp = (const unsigned char GPTR*)(p.ws + WS_QD) + (size_t)(qrow0 + qt * 32 + r) * 512 + hh * 128 + m * 64 + h * 32;
      qf8 = __builtin_shufflevector(*(const i32x4 GPTR*)qp, *(const i32x4 GPTR*)(qp + 16), 0, 1, 2, 3, 4, 5, 6, 7); }
    f32x16 o[4];
#pragma unroll
    for (int dt = 0; dt < 4; ++dt)
#pragma unroll
        for (int i = 0; i < 16; ++i) o[dt][i] = 0.f;
    float mrun = 0.f;
    i32x8 onesA; { const int on_ = (((lane & 15) == 0 && ((lane >> 4) & 1) == 0) || ((lane & 15) == 1 && ((lane >> 4) & 1) == 1)) ? 0x38383838 : 0;
#pragma unroll
      for (int i = 0; i < 8; ++i) onesA[i] = on_; }
    f32x4 lacc = {0.f, 0.f, 0.f, 0.f};
    constexpr int KPD = 128, KBYTES = 64 * KPD;
    const unsigned char GPTR* K8g = (const unsigned char GPTR*)(p.ws + WS_KD); const unsigned char GPTR* VTg = (const unsigned char GPTR*)(p.ws + WS_VT8);
    unsigned kgo;
    { const int row = 8 * wid + (lane >> 3), lc = (lane & 7) ^ ((row >> 1) & 7);
      const int kap = 32 * ((row >> 2) & 1) + (row & 3) + 4 * ((row & 31) >> 3) + 16 * (row >> 5); kgo = (unsigned)(kap * 512 + hh * 128 + lc * 16); }
    unsigned vgo; { const int d = 16 * wid + (lane >> 2), lc = (lane & 3) ^ ((d >> 2) & 3); vgo = (unsigned)(((b * 4 + hh) * 128 + d) * KVP + lc * 16); }
#define DA_ROW0(t) ((isctx || (t) < C_ / 64) ? (NRL + b * C_ + (t) * 64) : (b * L_ + ((t) - C_ / 64) * 64))
    const unsigned kro = (unsigned)(r * KPD + (((m * 4 + 2 * h) ^ ((r >> 1) & 7)) * 16));
    const unsigned vro0 = (unsigned)(r * 64 + (((2 * h) ^ ((r >> 2) & 3)) * 16)), vro1 = (unsigned)(r * 64 + (((2 * h + 1) ^ ((r >> 2) & 3)) * 16));
    PG8_LAS unsigned char* const KB0 = lds; PG8_LAS unsigned char* const VB0 = lds + 4 * KBYTES;
    constexpr int V8BYTES = 128 * 64;
    int scq_ = 0x7c7c7c7c; asm volatile("" : "+v"(scq_));
    int sc1_ = 0x7f7f7f7f; asm volatile("" : "+v"(sc1_));
#define DA_DMAK(t, boff) __builtin_amdgcn_global_load_lds((const unsigned GPTR*)(K8g + (size_t)DA_ROW0(t) * 512 + kgo), (PG8_LAS unsigned*)(KB0 + (boff) + wid * 1024), 16, 0, 0)
#define DA_DMAV(t, boff) __builtin_amdgcn_global_load_lds((const unsigned GPTR*)(VTg + vgo + (t) * 64), (PG8_LAS unsigned*)(VB0 + (boff) + wid * 1024), 16, 0, 0)
#define DA_LDK(off) __builtin_shufflevector(*(const PG8_LAS i32x4*)(Kb_ + (off)), *(const PG8_LAS i32x4*)(Kb_ + ((off) ^ 16)), 0, 1, 2, 3, 4, 5, 6, 7)
    const bf16x8 onesK = __builtin_bit_cast(bf16x8, (u32x4){h == 0 ? 0x3f80u : 0u, 0u, 0u, 0u});
    u32x4 negmB = {0u, 0u, 0u, 0u};
    const f32x16 zero16 = {0.f, 0.f, 0.f, 0.f, 0.f, 0.f, 0.f, 0.f, 0.f, 0.f, 0.f, 0.f, 0.f, 0.f, 0.f, 0.f};
#define DA_SETM() do { negmB[0] = h == 0 ? ((__float_as_uint(mrun) ^ 0x80000000u) >> 16) : 0u; } while (0)
#define DA_BFR(x) __uint_as_float((__float_as_uint(x) + 0x7fffu + ((__float_as_uint(x) >> 16) & 1u)) & 0xffff0000u)
#define DA_QK(PA, PB, boff) do { const PG8_LAS unsigned char* Kb_ = KB0 + (boff); \
        const f32x16 negm = __builtin_amdgcn_mfma_f32_32x32x16_bf16(onesK, __builtin_bit_cast(bf16x8, negmB), zero16, 0, 0, 0); \
        const i32x8 kfa_ = DA_LDK(kro), kfb_ = DA_LDK(kro + 32 * KPD); \
        __builtin_amdgcn_sched_barrier(0); \
        PA = __builtin_amdgcn_mfma_scale_f32_32x32x64_f8f6f4(kfa_, qf8, negm, 0, 0, 0, scq_, 0, scq_); \
        PB = __builtin_amdgcn_mfma_scale_f32_32x32x64_f8f6f4(kfb_, qf8, negm, 0, 0, 0, scq_, 0, scq_); } while (0)
    DA_DMAK(0, 0); DA_DMAK(1, KBYTES); DA_DMAV(0, 0); DA_DMAK(2, 2 * KBYTES); DA_DMAV(1, V8BYTES); DA_DMAK(3, 3 * KBYTES);
    asm volatile("s_waitcnt vmcnt(0)" ::: "memory"); __syncthreads();
    f32x16 pA, pB, nA, nB;
    DA_QK(pA, pB, 0);
    DA_QK(nA, nB, KBYTES);
    i32x8 pf8;
    { const float tm = DA_BFR(tile_max(pA, pB));
      mrun = tm; DA_SETM();
#pragma unroll
      for (int i = 0; i < 16; ++i) { pA[i] = __builtin_amdgcn_exp2f(pA[i] - tm); pB[i] = __builtin_amdgcn_exp2f(pB[i] - tm); nA[i] -= tm; nB[i] -= tm; }
      pf8 = DA_PACK8(pA, pB); }
    __syncthreads();
    if (wid >= 4) __builtin_amdgcn_s_setprio(1);
    int b0 = 0, b1 = 1, b2 = 2;
#define DA_LDV(dst, dt) dst = __builtin_shufflevector(*(const PG8_LAS i32x4*)(Vb + vro0 + (dt) * 2048), *(const PG8_LAS i32x4*)(Vb + vro1 + (dt) * 2048), 0, 1, 2, 3, 4, 5, 6, 7)
#define DA_PV(dt, src) o[dt] = __builtin_amdgcn_mfma_scale_f32_32x32x64_f8f6f4(src, pf8, o[dt], 0, 0, 0, sc1_, 0, sc1_)
#define DA_EXP8(XA, XB, k) do { float e0_ = __builtin_amdgcn_exp2f(XA[4 * (k)]), e1_ = __builtin_amdgcn_exp2f(XA[4 * (k) + 1]), e2_ = __builtin_amdgcn_exp2f(XA[4 * (k) + 2]), e3_ = __builtin_amdgcn_exp2f(XA[4 * (k) + 3]), \
            e4_ = __builtin_amdgcn_exp2f(XB[4 * (k)]), e5_ = __builtin_amdgcn_exp2f(XB[4 * (k) + 1]), e6_ = __builtin_amdgcn_exp2f(XB[4 * (k) + 2]), e7_ = __builtin_amdgcn_exp2f(XB[4 * (k) + 3]); \
        asm volatile("" : "+v"(e0_), "+v"(e1_), "+v"(e2_), "+v"(e3_), "+v"(e4_), "+v"(e5_), "+v"(e6_), "+v"(e7_));        \
        XA[4 * (k)] = e0_; XA[4 * (k) + 1] = e1_; XA[4 * (k) + 2] = e2_; XA[4 * (k) + 3] = e3_; XB[4 * (k)] = e4_; XB[4 * (k) + 1] = e5_; XB[4 * (k) + 2] = e6_; XB[4 * (k) + 3] = e7_; } while (0)
#define DA_SB __builtin_amdgcn_sched_barrier(0)
#define DA_ITER(XA, XB, YA, YB) do { \
        const bool more1 = (t + 1 < nkt), more2 = (t + 2 < nkt), more4 = (t + 4 < nkt); \
        if (more4) DA_DMAK(t + 4, (t & 3) * KBYTES);         \
        if (more2) DA_DMAV(t + 2, b2 * V8BYTES); \
        if (more2) DA_QK(YA, YB, ((t + 2) & 3) * KBYTES); \
        DA_SB; \
        const PG8_LAS unsigned char* Vb = VB0 + b0 * V8BYTES; \
        float alpha = 1.f; bool resc = false; \
        { const float tm = tile_max_old(XA, XB);        \
            const bool need = more1 && tm > 8.0f; \
            if (__builtin_amdgcn_ballot_w64(need) != 0ull) { const float mn_ = need ? DA_BFR(mrun + tm) : mrun, dl = mn_ - mrun; alpha = __builtin_amdgcn_exp2f(-dl); resc = true; mrun = mn_; DA_SETM(); \
                _Pragma("unroll") for (int i = 0; i < 16; ++i) { XA[i] -= dl; XB[i] -= dl; } \
                if (more2) { _Pragma("unroll") for (int i = 0; i < 16; ++i) { YA[i] -= dl; YB[i] -= dl; } } } } \
        i32x8 vfa, vfb; \
        DA_SB; DA_LDV(vfa, 0); DA_LDV(vfb, 1); \
        DA_SB; DA_PV(0, vfa); DA_SB; DA_EXP8(XA, XB, 0); DA_LDV(vfa, 2); \
        DA_SB; DA_PV(1, vfb); DA_SB; DA_EXP8(XA, XB, 1); DA_LDV(vfb, 3); \
        DA_SB; DA_PV(2, vfa); DA_SB; DA_EXP8(XA, XB, 2); \
        DA_SB; DA_PV(3, vfb); DA_SB; DA_EXP8(XA, XB, 3); \
        DA_SB; lacc = __builtin_amdgcn_mfma_scale_f32_16x16x128_f8f6f4(onesA, pf8, lacc, 0, 0, 0, sc1_, 0, sc1_); DA_SB; \
        if (resc) { lacc[0] *= alpha; lacc[1] *= shx(alpha, 16, lane); \
            _Pragma("unroll") for (int dt = 0; dt < 4; ++dt) _Pragma("unroll") for (int i = 0; i < 16; ++i) o[dt][i] *= alpha; } \
        DA_REPACK8(pf8, XA, XB); \
        if (more4) asm volatile("s_waitcnt vmcnt(2)" ::: "memory"); else asm volatile("s_waitcnt vmcnt(0)" ::: "memory");     \
        asm volatile("s_waitcnt lgkmcnt(0)" ::: "memory"); __builtin_amdgcn_s_barrier(); asm volatile("" ::: "memory");        \
        { const int r_ = b0; b0 = b1; b1 = b2; b2 = r_; } } while (0)
    for (int t = 0; t < nkt; ++t) {
        DA_ITER(nA, nB, pA, pB);
        ++t;
        DA_ITER(pA, pB, nA, nB);
    }
#undef DA_ITER
#undef DA_SB
#undef DA_EXP8
#undef DA_LDV
#undef DA_PV
#undef DA_DMAK
#undef DA_DMAV
#undef DA_QK
#undef DA_ROW0
    __builtin_amdgcn_s_setprio(0);
    const float l0_ = __int_as_float(__builtin_amdgcn_ds_bpermute((lane & 15) << 2, __float_as_int(lacc[0]))), l1_ = __int_as_float(__builtin_amdgcn_ds_bpermute((lane & 15) << 2, __float_as_int(lacc[1])));
    const float inv = 1.f / ((lane & 16) ? l1_ : l0_);
    PG8_LAS float* X = (PG8_LAS float*)lds;
    if (m == 1) {
#pragma unroll
        for (int dt = 0; dt < 4; ++dt)
#pragma unroll
            for (int i = 0; i < 16; ++i) X[(qt * 128 + dt * 32 + crow(i, h)) * 32 + r] = o[dt][i] * inv;
    }
    __syncthreads();
    if (m == 0) {
        const float lam = WSP(const float, WS_LAMD)[l], oml = WSP(const float, WS_LAMD)[2 + l];
        float ss = 0.f;
#pragma unroll
        for (int dt = 0; dt < 4; ++dt)
#pragma unroll
            for (int i = 0; i < 16; ++i) { const float v = o[dt][i] * inv - lam * X[(qt * 128 + dt * 32 + crow(i, h)) * 32 + r]; o[dt][i] = v; ss += v * v; }
        ss += shx(ss, 32, lane);
        const float rinv = oml / sqrtf(ss * (1.f / 128.f) + RMS_EPS);
        const float* sg = p.in[I_SUBLN] + (size_t)l * 128;
        bf16_t* y = WSP(bf16_t, WS_YD) + (size_t)(qrow0 + qt * 32 + r) * 512 + hh * 128;
#pragma unroll
        for (int dt = 0; dt < 4; ++dt)
#pragma unroll
            for (int g4 = 0; g4 < 4; ++g4) { const int d = dt * 32 + 8 * g4 + 4 * h;
                const unsigned w0 = cvtpk(o[dt][4 * g4] * rinv * sg[d], o[dt][4 * g4 + 1] * rinv * sg[d + 1]), w1 = cvtpk(o[dt][4 * g4 + 2] * rinv * sg[d + 2], o[dt][4 * g4 + 3] * rinv * sg[d + 3]);
                *(uint2*)(y + d) = make_uint2(w0, w1); }
    }
    __syncthreads();
}
__device__ __forceinline__ void diff_phase(const Params& p, int l, PG8_LAS unsigned char* lds, int wave_s) {
    const int G = gridDim.x, bid = blockIdx.x;
    constexpr int NQB = L_ / 128, NU = B_ * 4 * NQB;
    if (G % 8 == 0 && (16 % (G / 8) == 0 || (G / 8) % 16 == 0 || true)) {
        const int xcd = bid % 8, slot = bid / 8, per = G / 8;
        for (int combo = xcd; combo < B_ * 4; combo += 8)
            for (int qb = slot; qb < NQB; qb += per) diff_unit(p, l, lds, combo >> 2, combo & 3, (combo >> 2) * L_ + qb * 128, false, wave_s);
    } else {
        for (int u = bid; u < NU; u += G) { const int combo = u / NQB, qb = u % NQB; diff_unit(p, l, lds, combo >> 2, combo & 3, (combo >> 2) * L_ + qb * 128, false, wave_s); }
    }
    if (l == 0) { constexpr int NCU = B_ * 4 * (C_ / 128);
        for (int u = bid; u < NCU; u += G) { const int combo = u / (C_ / 128), qb = u % (C_ / 128); diff_unit(p, l, lds, combo >> 2, combo & 3, NRL + (combo >> 2) * C_ + qb * 128, true, wave_s); } }
}
}


namespace nattn {
#define DA_BFR_(x) __uint_as_float((__float_as_uint(x) + 0x7fffu + ((__float_as_uint(x) >> 16) & 1u)) & 0xffff0000u)
using dattn::bf16x8; using dattn::s16x4; using dattn::f32x16; using dattn::u32x4; using dattn::cvtpk; using dattn::crow; using dattn::vtr;
constexpr int KP = 144, VDT = 4160, KBYTES = 64 * KP, VBYTES = 2 * VDT, STAGE = KBYTES + VBYTES, BIAS_OFF = 2 * STAGE;
static_assert(C_ % 64 == 0 && (C_ == 256), "context-query units assume 256 context rows");
__device__ __forceinline__ int rs_of(int r) { int v = r - 4; v = v < 0 ? 0 : v; return v > GRR - 8 ? GRR - 8 : v; }
__device__ __forceinline__ void na_unit(const Params& p, int l, PG8_LAS unsigned char* lds, int b, int hh, int r0, bool isctx, int wave_s) {
    int tid_ = tid_of(wave_s); asm volatile("" : "+v"(tid_));
    const int tid = tid_, lane = tid & 63, wid = __builtin_amdgcn_readfirstlane(tid >> 6), r = lane & 31, h = lane >> 5;
    const bf16_t* QN = WSP(const bf16_t, WS_QN); const bf16_t* KN = WSP(const bf16_t, WS_KN); const bf16_t* VN = WSP(const bf16_t, WS_VN);
    const int rq = r0 + (wid >> 1), cq = (wid & 1) * 32 + r;
    const int qrow = isctx ? NRL + b * C_ + wid * 32 + r : b * L_ + rq * GRW + cq;
    const int rsq = rs_of(rq); int csq = cq - 8; csq = csq < 0 ? 0 : (csq > GRW - 16 ? GRW - 16 : csq);
    const int kr_lo = rs_of(r0), kr_hi = rs_of(r0 + 3) + 8;
    const int nct = C_ / 64, nkt = isctx ? nct : nct + (kr_hi - kr_lo);
    PG8_LAS float* BT = (PG8_LAS float*)(lds + BIAS_OFF);
    if (tid < 15 * 32) BT[tid] = (tid & 31) < 31 ? p.in[I_RPB][((size_t)l * 4 + hh) * 465 + (tid >> 5) * 31 + (tid & 31)] * LOG2E : -1e30f;
    bf16x8 qf[4];
    { const bf16_t* qp = QN + (size_t)qrow * 256 + hh * 64 + h * 8;
#pragma unroll
      for (int d0 = 0; d0 < 4; ++d0) qf[d0] = *(const bf16x8*)(qp + d0 * 16); }
    f32x16 o[2];
#pragma unroll
    for (int dt = 0; dt < 2; ++dt)
#pragma unroll
        for (int i = 0; i < 16; ++i) o[dt][i] = 0.f;
    float mrun = 0.f, lrun = 0.f;
    unsigned coA[16], coB[16];
#pragma unroll
    for (int i = 0; i < 16; ++i) { const int kcA = crow(i, h), kcB = 32 + kcA;
        coA[i] = (unsigned)(((unsigned)(kcA - csq) < 16u ? 15 - cq + kcA : 31) * 4); coB[i] = (unsigned)(((unsigned)(kcB - csq) < 16u ? 15 - cq + kcB : 31) * 4); }
    const bf16x8 onesK = __builtin_bit_cast(bf16x8, (u32x4){h == 0 ? 0x3f80u : 0u, 0u, 0u, 0u});
    u32x4 negmB = {0u, 0u, 0u, 0u};
    const f32x16 zero16 = {0.f, 0.f, 0.f, 0.f, 0.f, 0.f, 0.f, 0.f, 0.f, 0.f, 0.f, 0.f, 0.f, 0.f, 0.f, 0.f};
    const int srow = tid >> 3, sc8 = tid & 7;
    const unsigned kw = (unsigned)(srow * KP + sc8 * 16), vw = (unsigned)(KBYTES + (sc8 >> 2) * VDT + srow * 64 + (sc8 & 3) * 16);
    const size_t goff = (size_t)srow * 256 + hh * 64 + sc8 * 8;
    u32x4 kreg, vreg;
#define NA_ROW0(t) ((t) < nct ? (NRL + b * C_ + (t) * 64) : (b * L_ + (kr_lo + (t) - nct) * GRW))
#define NA_LOAD(t) do { const size_t g0 = (size_t)NA_ROW0(t) * 256 + goff; kreg = *(const u32x4*)(KN + g0); vreg = *(const u32x4*)(VN + g0); } while (0)
#define NA_WRITE(buf) do { PG8_LAS unsigned char* sb = lds + (buf) * STAGE; *(PG8_LAS u32x4*)(sb + kw) = kreg; *(PG8_LAS u32x4*)(sb + vw) = vreg; } while (0)
    const unsigned kro = (unsigned)(r * KP + h * 16);
    const unsigned vro = (unsigned)((4 * h + ((lane & 15) >> 2)) * 64 + ((lane >> 4) & 1) * 32 + (lane & 3) * 8);
    NA_LOAD(0); NA_WRITE(0); __syncthreads();
    for (int t = 0; t < nkt; ++t) {
        const bool more = (t + 1 < nkt);
        if (more) NA_LOAD(t + 1);
        const int kr = kr_lo + t - nct;
        const bool local = t >= nct;
        if (!local || (kr >= rsq && kr < rsq + 8)) {
            const PG8_LAS unsigned char* Kb = lds + (t & 1) * STAGE; const PG8_LAS unsigned char* Vb = Kb + KBYTES;
            f32x16 pA = __builtin_amdgcn_mfma_f32_32x32x16_bf16(onesK, __builtin_bit_cast(bf16x8, negmB), zero16, 0, 0, 0), pB = pA;
#pragma unroll
            for (int d0 = 0; d0 < 4; ++d0) {
                const bf16x8 ka = *(const PG8_LAS bf16x8*)(Kb + kro + d0 * 32), kb = *(const PG8_LAS bf16x8*)(Kb + kro + 32 * KP + d0 * 32);
                pA = __builtin_amdgcn_mfma_f32_32x32x16_bf16(ka, qf[d0], pA, 0, 0, 0);
                pB = __builtin_amdgcn_mfma_f32_32x32x16_bf16(kb, qf[d0], pB, 0, 0, 0);
            }
            if (local) {
                const PG8_LAS unsigned char* brow = (const PG8_LAS unsigned char*)BT + (kr - rq + 7) * 128;
#pragma unroll
                for (int i = 0; i < 16; ++i) { pA[i] += *(const PG8_LAS float*)(brow + coA[i]); pB[i] += *(const PG8_LAS float*)(brow + coB[i]); }
            }
            const float tm = dattn::tile_max(pA, pB);
            const bool need = (t == 0) || (tm > 8.0f);
            if (__builtin_amdgcn_ballot_w64(need) != 0ull) {
                const float mn_ = need ? DA_BFR_(mrun + tm) : mrun, dl = mn_ - mrun, alpha = (t == 0) ? 0.f : __builtin_amdgcn_exp2f(-dl);
                mrun = mn_; lrun *= alpha; negmB[0] = h == 0 ? ((__float_as_uint(mrun) ^ 0x80000000u) >> 16) : 0u;
#pragma unroll
                for (int i = 0; i < 16; ++i) { pA[i] -= dl; pB[i] -= dl; }
#pragma unroll
                for (int dt = 0; dt < 2; ++dt)
#pragma unroll
                    for (int i = 0; i < 16; ++i) o[dt][i] *= alpha;
            }
            float ps = 0.f;
#pragma unroll
            for (int i = 0; i < 16; ++i) { pA[i] = __builtin_amdgcn_exp2f(pA[i]); pB[i] = __builtin_amdgcn_exp2f(pB[i]); ps += pA[i] + pB[i]; }
            lrun += ps;
            const bf16x8 pf00 = DA_PACK(pA, 0), pf01 = DA_PACK(pA, 1), pf10 = DA_PACK(pB, 0), pf11 = DA_PACK(pB, 1);
#pragma unroll
            for (int dt = 0; dt < 2; ++dt) {
                const PG8_LAS unsigned char* vb = Vb + vro + dt * VDT;
#define NA_VF(kvh, st) __builtin_shufflevector(vtr(vb + ((kvh) * 32 + 16 * (st)) * 64), vtr(vb + ((kvh) * 32 + 16 * (st) + 8) * 64), 0, 1, 2, 3, 4, 5, 6, 7)
                o[dt] = __builtin_amdgcn_mfma_f32_32x32x16_bf16(NA_VF(0, 0), pf00, o[dt], 0, 0, 0);
                o[dt] = __builtin_amdgcn_mfma_f32_32x32x16_bf16(NA_VF(0, 1), pf01, o[dt], 0, 0, 0);
                o[dt] = __builtin_amdgcn_mfma_f32_32x32x16_bf16(NA_VF(1, 0), pf10, o[dt], 0, 0, 0);
                o[dt] = __builtin_amdgcn_mfma_f32_32x32x16_bf16(NA_VF(1, 1), pf11, o[dt], 0, 0, 0);
#undef NA_VF
            }
        }
        if (more) NA_WRITE((t + 1) & 1);
        __syncthreads();
    }
#undef NA_LOAD
#undef NA_WRITE
#undef NA_ROW0
    lrun += shx(lrun, 32, lane);
    const float inv = 1.f / lrun;
    bf16_t* y = WSP(bf16_t, WS_YN) + (size_t)qrow * 256 + hh * 64;
#pragma unroll
    for (int dt = 0; dt < 2; ++dt)
#pragma unroll
        for (int g4 = 0; g4 < 4; ++g4) { const int d = dt * 32 + 8 * g4 + 4 * h;
            *(uint2*)(y + d) = make_uint2(cvtpk(o[dt][4 * g4] * inv, o[dt][4 * g4 + 1] * inv), cvtpk(o[dt][4 * g4 + 2] * inv, o[dt][4 * g4 + 3] * inv)); }
}
__device__ __forceinline__ void na_phase(const Params& p, int l, PG8_LAS unsigned char* lds, int wave_s) {
    const int G = gridDim.x, bid = blockIdx.x;
    constexpr int NRG = GRR / 4, NU = B_ * 4 * NRG;
    for (int u = bid; u < NU; u += G) { const int combo = u / NRG, rg = u % NRG; na_unit(p, l, lds, combo >> 2, combo & 3, rg * 4, false, wave_s); }
    if (l == 0) for (int u = bid; u < B_ * 4; u += G) na_unit(p, l, lds, u >> 2, u & 3, 0, true, wave_s);
}
}

constexpr int NTHREADS = 512;

namespace fastp {
typedef float f32x4v __attribute__((ext_vector_type(4)));
typedef unsigned u32x4 __attribute__((ext_vector_type(4)));
typedef __bf16 bf16x2_t __attribute__((ext_vector_type(2)));
__device__ __forceinline__ float wave_sum(float v, int lane) {
#pragma unroll
    for (int o = 1; o < 64; o <<= 1) v += shx(v, o, lane);
    return v;
}
__device__ __forceinline__ unsigned pk2(float lo, float hi) { return dattn::cvtpk(lo, hi); }
__device__ __forceinline__ void norm_phase(const Params& p, int l, int which, int nrows, bool from_inputs, int wave_s) {
    int tid_ = tid_of(wave_s); asm volatile("" : "+v"(tid_));
    const int lane = tid_ & 63, wid = tid_ >> 6;
    const float* gain = p.in[which == 1 ? I_N1G : I_N2G] + (size_t)l * DM;
    const int seg_sh = which == 1 ? 0 : 3, seg_sc = which == 1 ? 1 : 4;
    for (int row = blockIdx.x * 8 + wid; row < nrows; row += gridDim.x * 8) {
        const float* src = from_inputs ? (row < NRL ? p.in[I_X] + (size_t)row * DM : p.in[I_CTX] + (size_t)(row - NRL) * DM) : xr_row(p, row);
        f32x4v v[4]; float ss = 0.f;
#pragma unroll
        for (int j = 0; j < 4; ++j) { v[j] = *(const f32x4v*)(src + j * 256 + lane * 4); ss += v[j][0] * v[j][0] + v[j][1] * v[j][1] + v[j][2] * v[j][2] + v[j][3] * v[j][3]; }
        ss = wave_sum(ss, lane);
        const float rinv = 1.f / sqrtf(ss * (1.f / DM) + RMS_EPS);
        if (from_inputs) { float* xr = xr_row(p, row);
#pragma unroll
            for (int j = 0; j < 4; ++j) *(f32x4v*)(xr + j * 256 + lane * 4) = v[j]; }
        const int bb = row_bb(row); const float* sh = mod_ptr(p, l, bb, seg_sh); const float* sc = mod_ptr(p, l, bb, seg_sc);
        bf16_t* h = WSP(bf16_t, WS_H) + (size_t)row * DM;
#pragma unroll
        for (int j = 0; j < 4; ++j) { const int c = j * 256 + lane * 4;
            const f32x4v gv = *(const f32x4v*)(gain + c), scv = *(const f32x4v*)(sc + c), shv = *(const f32x4v*)(sh + c);
            float o[4];
#pragma unroll
            for (int e = 0; e < 4; ++e) o[e] = v[j][e] * rinv * gv[e] * (1.f + scv[e]) + shv[e];
            if (which != 1) *(uint2*)(h + c) = make_uint2(pk2(o[0], o[1]), pk2(o[2], o[3]));
            { int pk = 0;
                pk = __builtin_amdgcn_cvt_pk_fp8_f32(fminf(fmaxf(o[0], -448.f), 448.f), fminf(fmaxf(o[1], -448.f), 448.f), pk, false);
                pk = __builtin_amdgcn_cvt_pk_fp8_f32(fminf(fmaxf(o[2], -448.f), 448.f), fminf(fmaxf(o[3], -448.f), 448.f), pk, true);
                *(unsigned*)(p.ws + (which == 1 ? WS_H8 : WS_H8B) + (size_t)row * DM + c) = (unsigned)pk; } }
    }
}
__device__ __forceinline__ void mod_phase(const Params& p, PG8_LAS unsigned char* lds, int wave_s) {
    int tid_ = tid_of(wave_s); asm volatile("" : "+v"(tid_));
    const int lane = tid_ & 63, wid = tid_ >> 6;
    PG8_LAS float* sl = (PG8_LAS float*)lds;
    PG8_LAS float* red = (PG8_LAS float*)(lds + 32768);
    for (int i = tid_; i < (B_ + 1) * DM; i += NTHREADS) { const int b = i / DM, d = i % DM; sl[i] = siluf_(b < B_ ? p.in[I_C][b * DM + d] : p.in[I_CCTX][d]); }
    __syncthreads();
    for (int it = blockIdx.x; it < DEPTH * 96; it += gridDim.x) {
        const int l = it / 96, col = (it % 96) * 64 + lane;
        const float* w = p.in[I_ADAW] + (size_t)l * DM * 6144 + col;
        float acc[B_ + 1];
#pragma unroll
        for (int b = 0; b <= B_; ++b) acc[b] = 0.f;
#pragma unroll 8
        for (int dd = 0; dd < 128; ++dd) { const int d = wid * 128 + dd; const float wv = w[(size_t)d * 6144];
#pragma unroll
            for (int b = 0; b <= B_; ++b) acc[b] += sl[b * DM + d] * wv; }
#pragma unroll
        for (int b = 0; b <= B_; ++b) red[(wid * (B_ + 1) + b) * 64 + lane] = acc[b];
        __syncthreads();
        if (tid_ < (B_ + 1) * 64) { const int b = tid_ / 64, c = tid_ % 64; float s = 0.f;
#pragma unroll
            for (int w8 = 0; w8 < 8; ++w8) s += red[(w8 * (B_ + 1) + b) * 64 + c];
            const int cc = (it % 96) * 64 + c;
            WSP(float, WS_MOD)[((size_t)(l * (B_ + 1) + b)) * 6144 + cc] = s + p.in[I_ADAB][l * 6144 + cc]; }
        __syncthreads();
    }
}
__device__ __forceinline__ void peer_phase(const Params& p, int l, int nrows, PG8_LAS unsigned char* lds, bool last, int wave_s) {
    int tid_ = tid_of(wave_s); asm volatile("" : "+v"(tid_));
    const int lane = tid_ & 63, wid = __builtin_amdgcn_readfirstlane(tid_ >> 6), j = lane & 7, g = lane >> 3;
    PG8_LAS float* wb = (PG8_LAS float*)(lds + wid * 1024); PG8_LAS int* eb = (PG8_LAS int*)(lds + wid * 1024 + 512);
    const bf16_t* UT = WSP(const bf16_t, WS_UT); const bf16_t* VT = WSP(const bf16_t, WS_VT); const bf16_t* H2 = WSP(const bf16_t, WS_H);
    const unsigned short* EI = WSP(const unsigned short, WS_EIDX); const float* GWp = WSP(const float, WS_GW);
    for (int row = blockIdx.x * 8 + wid; row < nrows; row += gridDim.x * 8) {
        u32x4 hq[16];
        { const bf16_t* hp = H2 + (size_t)row * DM + j * 8;
#pragma unroll
          for (int i = 0; i < 16; ++i) hq[i] = *(const u32x4*)(hp + i * 64); }
        for (int bt = 0; bt < 16; ++bt) {
            const int e = EI[(size_t)row * 128 + bt * 8 + g];
            const bf16_t* up = UT + (size_t)e * 1024 + j * 8;
            u32x4 uu[16];
#pragma unroll
            for (int i = 0; i < 16; ++i) uu[i] = *(const u32x4*)(up + i * 64);
            float a0 = 0.f, a1 = 0.f;
#pragma unroll
            for (int i = 0; i < 16; ++i)
#pragma unroll
                for (int c = 0; c < 4; ++c) { a0 += u2f(uu[i][c] << 16) * u2f(hq[i][c] << 16); a1 += u2f(uu[i][c] & 0xffff0000u) * u2f(hq[i][c] & 0xffff0000u); }
            float acc = a0 + a1;
            acc += shx(acc, 1, lane); acc += shx(acc, 2, lane); acc += shx(acc, 4, lane);
            const float w = GWp[(size_t)row * 128 + bt * 8 + g] * gelu_tanh(acc);
            if (j == 0) { wb[bt * 8 + g] = w; eb[bt * 8 + g] = e; }
        }
        asm volatile("s_waitcnt lgkmcnt(0)" ::: "memory");
        float out[16];
#pragma unroll
        for (int i = 0; i < 16; ++i) out[i] = 0.f;
        for (int bt = 0; bt < 16; ++bt) {
            u32x4 v0[8], v1[8]; float wk[8];
#pragma unroll
            for (int k = 0; k < 8; ++k) { const int e = __builtin_amdgcn_readfirstlane(eb[bt * 8 + k]); wk[k] = wb[bt * 8 + k];
                const bf16_t* vp = VT + (size_t)e * 1024 + lane * 16; v0[k] = *(const u32x4*)vp; v1[k] = *(const u32x4*)(vp + 8); }
#pragma unroll
            for (int k = 0; k < 8; ++k)
#pragma unroll
                for (int c = 0; c < 4; ++c) {
                    out[2 * c] += wk[k] * u2f(v0[k][c] << 16); out[2 * c + 1] += wk[k] * u2f(v0[k][c] & 0xffff0000u);
                    out[8 + 2 * c] += wk[k] * u2f(v1[k][c] << 16); out[8 + 2 * c + 1] += wk[k] * u2f(v1[k][c] & 0xffff0000u); }
        }
        asm volatile("" ::: "memory");
        float* x = xr_row(p, row) + lane * 16; const float* g2 = mod_ptr(p, l, row_bb(row), 5) + lane * 16;
        f32x4v xv[4]; float ss = 0.f;
#pragma unroll
        for (int q = 0; q < 4; ++q) { xv[q] = *(const f32x4v*)(x + q * 4); const f32x4v gv = *(const f32x4v*)(g2 + q * 4);
#pragma unroll
            for (int e = 0; e < 4; ++e) { xv[q][e] += gv[e] * out[q * 4 + e]; ss += xv[q][e] * xv[q][e]; } }
        if (last) { ss = wave_sum(ss, lane); const float rinv = 1.f / sqrtf(ss * (1.f / DM) + RMS_EPS); const float* fg = p.in[I_FNG] + lane * 16;
#pragma unroll
            for (int q = 0; q < 4; ++q) { const f32x4v gv = *(const f32x4v*)(fg + q * 4);
#pragma unroll
                for (int e = 0; e < 4; ++e) xv[q][e] = xv[q][e] * rinv * gv[e]; } }
#pragma unroll
        for (int q = 0; q < 4; ++q) *(f32x4v*)(x + q * 4) = xv[q];
    }
}

typedef float f2v __attribute__((ext_vector_type(2)));
__device__ __forceinline__ void tables8_phase(const Params& p, int l, long tid, long nthr) {
    const long n16 = (long)16384 * 1024 / 16;
    for (long it = tid; it < 2 * n16; it += nthr) {
        const int w = it >= n16; const long i = it - (w ? n16 : 0);
        const float* src = p.in[w ? I_PV : I_PU] + (size_t)l * 16384 * 1024 + i * 16; const float sc = w ? 16.f : 256.f;
        u32x4 o;
#pragma unroll
        for (int c = 0; c < 4; ++c) { const f32x4v v = *(const f32x4v*)(src + c * 4); int pk = 0;
            pk = __builtin_amdgcn_cvt_pk_fp8_f32(fminf(fmaxf(v[0] * sc, -448.f), 448.f), fminf(fmaxf(v[1] * sc, -448.f), 448.f), pk, false);
            pk = __builtin_amdgcn_cvt_pk_fp8_f32(fminf(fmaxf(v[2] * sc, -448.f), 448.f), fminf(fmaxf(v[3] * sc, -448.f), 448.f), pk, true);
            o[c] = (unsigned)pk; }
        *(u32x4*)(p.ws + (w ? WS_VT : WS_UT) + i * 16) = o;
    }
}
__device__ __forceinline__ void peer8_phase(const Params& p, int l, int nrows, PG8_LAS unsigned char* lds, bool last, int wave_s) {
    int tid_ = tid_of(wave_s); asm volatile("" : "+v"(tid_));
    const int lane = tid_ & 63, wid = __builtin_amdgcn_readfirstlane(tid_ >> 6), j = lane & 7, g = lane >> 3;
    PG8_LAS float* wb = (PG8_LAS float*)(lds + wid * 1024); PG8_LAS int* eb = (PG8_LAS int*)(lds + wid * 1024 + 512);
    const unsigned char* UT8 = p.ws + WS_UT; const unsigned char* VT8 = p.ws + WS_VT; const bf16_t* H2 = WSP(const bf16_t, WS_H);
    const unsigned short* EI = WSP(const unsigned short, WS_EIDX); const float* GWp = WSP(const float, WS_GW);
    for (int row = blockIdx.x * 8 + wid; row < nrows; row += gridDim.x * 8) {
        f2v hf[64];
        { const bf16_t* hp = H2 + (size_t)row * DM + j * 16;
#pragma unroll
          for (int i = 0; i < 8; ++i) { const u32x4 t0 = *(const u32x4*)(hp + i * 128), t1 = *(const u32x4*)(hp + i * 128 + 8);
#pragma unroll
              for (int c = 0; c < 4; ++c) { hf[i * 8 + c] = (f2v){u2f(t0[c] << 16), u2f(t0[c] & 0xffff0000u)}; hf[i * 8 + 4 + c] = (f2v){u2f(t1[c] << 16), u2f(t1[c] & 0xffff0000u)}; } } }
        for (int bt = 0; bt < 8; ++bt) {
            const int e0 = EI[(size_t)row * 128 + bt * 16 + g], e1 = EI[(size_t)row * 128 + bt * 16 + 8 + g];
            const unsigned char* u0 = UT8 + (size_t)e0 * 1024 + j * 16; const unsigned char* u1 = UT8 + (size_t)e1 * 1024 + j * 16;
            u32x4 ua[8], ub[8];
#pragma unroll
            for (int i = 0; i < 8; ++i) { ua[i] = *(const u32x4*)(u0 + i * 128); ub[i] = *(const u32x4*)(u1 + i * 128); }
            f2v acc0 = {0.f, 0.f}, acc1 = {0.f, 0.f};
#pragma unroll
            for (int i = 0; i < 8; ++i)
#pragma unroll
                for (int c = 0; c < 4; ++c) {
                    acc0 += __builtin_amdgcn_cvt_pk_f32_fp8((int)ua[i][c], false) * hf[i * 8 + 2 * c]; acc0 += __builtin_amdgcn_cvt_pk_f32_fp8((int)ua[i][c], true) * hf[i * 8 + 2 * c + 1];
                    acc1 += __builtin_amdgcn_cvt_pk_f32_fp8((int)ub[i][c], false) * hf[i * 8 + 2 * c]; acc1 += __builtin_amdgcn_cvt_pk_f32_fp8((int)ub[i][c], true) * hf[i * 8 + 2 * c + 1]; }
            float d0 = acc0[0] + acc0[1], d1 = acc1[0] + acc1[1];
            d0 += shx(d0, 1, lane); d1 += shx(d1, 1, lane); d0 += shx(d0, 2, lane); d1 += shx(d1, 2, lane); d0 += shx(d0, 4, lane); d1 += shx(d1, 4, lane);
            const float w0 = GWp[(size_t)row * 128 + bt * 16 + g] * gelu_tanh(d0 * (1.f / 256.f)), w1 = GWp[(size_t)row * 128 + bt * 16 + 8 + g] * gelu_tanh(d1 * (1.f / 256.f));
            if (j == 0) { wb[bt * 16 + g] = w0; eb[bt * 16 + g] = e0; wb[bt * 16 + 8 + g] = w1; eb[bt * 16 + 8 + g] = e1; }
        }
        asm volatile("s_waitcnt lgkmcnt(0)" ::: "memory");
        f2v out2[8];
#pragma unroll
        for (int q = 0; q < 8; ++q) out2[q] = (f2v){0.f, 0.f};
        for (int bt = 0; bt < 8; ++bt) {
            u32x4 vv[16]; float wk[16];
#pragma unroll
            for (int k = 0; k < 16; ++k) { const int e = __builtin_amdgcn_readfirstlane(eb[bt * 16 + k]); wk[k] = wb[bt * 16 + k]; vv[k] = *(const u32x4*)(VT8 + (size_t)e * 1024 + lane * 16); }
#pragma unroll
            for (int k = 0; k < 16; ++k) { const f2v w2 = {wk[k], wk[k]};
#pragma unroll
                for (int c = 0; c < 4; ++c) { out2[2 * c] += w2 * __builtin_amdgcn_cvt_pk_f32_fp8((int)vv[k][c], false); out2[2 * c + 1] += w2 * __builtin_amdgcn_cvt_pk_f32_fp8((int)vv[k][c], true); } }
        }
        asm volatile("" ::: "memory");
        float* x = xr_row(p, row) + lane * 16; const float* g2 = mod_ptr(p, l, row_bb(row), 5) + lane * 16;
        f32x4v xv[4]; float ss = 0.f;
#pragma unroll
        for (int q = 0; q < 4; ++q) { xv[q] = *(const f32x4v*)(x + q * 4); const f32x4v gv = *(const f32x4v*)(g2 + q * 4);
            xv[q][0] += gv[0] * out2[2 * q][0] * (1.f / 16.f); xv[q][1] += gv[1] * out2[2 * q][1] * (1.f / 16.f); xv[q][2] += gv[2] * out2[2 * q + 1][0] * (1.f / 16.f); xv[q][3] += gv[3] * out2[2 * q + 1][1] * (1.f / 16.f);
#pragma unroll
            for (int e = 0; e < 4; ++e) ss += xv[q][e] * xv[q][e]; }
        if (last) { ss = wave_sum(ss, lane); const float rinv = 1.f / sqrtf(ss * (1.f / DM) + RMS_EPS); const float* fg = p.in[I_FNG] + lane * 16;
#pragma unroll
            for (int q = 0; q < 4; ++q) { const f32x4v gv = *(const f32x4v*)(fg + q * 4);
#pragma unroll
                for (int e = 0; e < 4; ++e) xv[q][e] = xv[q][e] * rinv * gv[e]; } }
#pragma unroll
        for (int q = 0; q < 4; ++q) *(f32x4v*)(x + q * 4) = xv[q];
    }
}

constexpr int NSL = 8;
constexpr size_t WS_PART = WS_SC;
static_assert((size_t)NSL * NR * 128 * 4 <= (size_t)NR * 2048 * 4, "PART fits the score buffer");
struct XInfo { int xi, nx, rank, nloc; };
__device__ __forceinline__ void tables8s_phase(const Params& p, int l, long tid, long nthr) {
    const long n16 = (long)16384 * 1024 / 16;
    for (long it = tid; it < 2 * n16; it += nthr) {
        const int w = it >= n16; const long i = it - (w ? n16 : 0);
        const float GPTR* src = p.in[w ? I_PV : I_PU] + (size_t)l * 16384 * 1024 + i * 16; const float sc = w ? 16.f : 256.f;
        u32x4 o;
#pragma unroll
        for (int c = 0; c < 4; ++c) { const f32x4v v = *(const f32x4v GPTR*)(src + c * 4); int pk = 0;
            pk = __builtin_amdgcn_cvt_pk_fp8_f32(fminf(fmaxf(v[0] * sc, -448.f), 448.f), fminf(fmaxf(v[1] * sc, -448.f), 448.f), pk, false);
            pk = __builtin_amdgcn_cvt_pk_fp8_f32(fminf(fmaxf(v[2] * sc, -448.f), 448.f), fminf(fmaxf(v[3] * sc, -448.f), 448.f), pk, true);
            o[c] = (unsigned)pk; }
        const long e = i >> 6; const int ch = (int)(i & 63), sl = ch >> 3, within = (ch & 7) * 16;
        *(u32x4 GPTR*)(p.ws + (w ? WS_VT : WS_UT) + ((size_t)sl * 16384 + e) * 128 + within) = o;
    }
}
#define XR_STEP(v, n, bit, msk) _Pragma("unroll") for (int k_ = 0; k_ < (n); ++k_) { const float send_ = (bit) ? v[k_] : v[(n) + k_]; const float keep_ = (bit) ? v[(n) + k_] : v[k_]; v[k_] = keep_ + shx(send_, msk, lane); }
__device__ __forceinline__ void peer_u_phase(const Params& p, int nrows, const XInfo xi, PG8_LAS unsigned char* lds, int wave_s) {
    typedef int i32x8 __attribute__((ext_vector_type(8))); typedef int i32x4 __attribute__((ext_vector_type(4))); typedef float f32x4m __attribute__((ext_vector_type(4)));
    int tid_ = tid_of(wave_s); asm volatile("" : "+v"(tid_));
    const int lane = tid_ & 63, wid = __builtin_amdgcn_readfirstlane(tid_ >> 6), q = lane >> 3, pc = lane & 7, m = lane & 15, kg = lane >> 4;
    const unsigned short GPTR* EI = (const unsigned short GPTR*)(p.ws + WS_EIDX); const unsigned char GPTR* H8 = (const unsigned char GPTR*)(p.ws + WS_H8B);
    int sc_ = 0x7f7f7f7f; asm volatile("" : "+v"(sc_));
    const int gq = ((q >> 1) & 1) + ((q >> 2) & 1) * 4, gm = ((m >> 1) & 1) + ((m >> 2) & 1) * 4;
    PG8_LAS unsigned char* const wl = lds + wid * 16384;
    const unsigned rbase = (unsigned)((m & 7) * 128 + (m >> 3) * 8192), ro0 = rbase + (unsigned)(((2 * kg) ^ gm) * 16), ro1 = rbase + (unsigned)(((2 * kg + 1) ^ gm) * 16);
    for (int sl = xi.xi; sl < NSL; sl += xi.nx) {
        const unsigned char GPTR* UT = p.ws + WS_UT + (size_t)sl * 16384 * 128 + (pc ^ gq) * 16;
        float GPTR* PART = (float GPTR*)(p.ws + WS_PART) + (size_t)sl * NR * 128;
        for (int row = xi.rank * 8 + wid; row < nrows; row += xi.nloc * 8) {
            const u32x4 ev0 = *(const u32x4 GPTR*)(EI + (size_t)row * 128 + q * 16), ev1 = *(const u32x4 GPTR*)(EI + (size_t)row * 128 + q * 16 + 8);
            const unsigned char GPTR* hp = H8 + (size_t)row * DM + sl * 128 + kg * 32;
            const i32x8 hb = __builtin_shufflevector(*(const i32x4 GPTR*)hp, *(const i32x4 GPTR*)(hp + 16), 0, 1, 2, 3, 4, 5, 6, 7);
#pragma unroll
            for (int i = 0; i < 16; ++i) { const unsigned wrd = i < 8 ? ev0[i >> 1] : ev1[(i - 8) >> 1]; const unsigned e = (i & 1) ? (wrd >> 16) : (wrd & 0xffffu);
                __builtin_amdgcn_global_load_lds((const unsigned GPTR*)(UT + (size_t)e * 128), (PG8_LAS unsigned*)(wl + i * 1024), 16, 0, 0); }
            asm volatile("s_waitcnt vmcnt(0)" ::: "memory");
            f32x4m acc[8];
#pragma unroll
            for (int G = 0; G < 8; ++G) { const i32x8 ua = __builtin_shufflevector(*(const PG8_LAS i32x4*)(wl + G * 1024 + ro0), *(const PG8_LAS i32x4*)(wl + G * 1024 + ro1), 0, 1, 2, 3, 4, 5, 6, 7);
                acc[G] = __builtin_amdgcn_mfma_scale_f32_16x16x128_f8f6f4(ua, hb, (f32x4m){0.f, 0.f, 0.f, 0.f}, 0, 0, 0, sc_, 0, sc_); }
            if (m == 0) {
#pragma unroll
                for (int i = 0; i < 4; ++i) { const int mm = 4 * kg + i; float GPTR* d = PART + (size_t)row * 128 + (mm & 7) * 16 + (mm >> 3) * 8;
                    *(f32x4m GPTR*)d = (f32x4m){acc[0][i], acc[1][i], acc[2][i], acc[3][i]}; *(f32x4m GPTR*)(d + 4) = (f32x4m){acc[4][i], acc[5][i], acc[6][i], acc[7][i]}; } }
            asm volatile("s_waitcnt lgkmcnt(0)" ::: "memory");
        }
    }
}
__device__ __forceinline__ void peer_comb_phase(const Params& p, int nrows, long tid, long nthr) {
    const float GPTR* PART = (const float GPTR*)(p.ws + WS_PART); float GPTR* GWp = (float GPTR*)(p.ws + WS_GW);
    for (long it = tid; it < (long)nrows * 32; it += nthr) {
        f32x4v a = *(const f32x4v GPTR*)(PART + it * 4);
#pragma unroll
        for (int sl = 1; sl < NSL; ++sl) a += *(const f32x4v GPTR*)(PART + (size_t)sl * NR * 128 + it * 4);
        f32x4v gw = *(const f32x4v GPTR*)(GWp + it * 4);
#pragma unroll
        for (int e = 0; e < 4; ++e) gw[e] *= gelu_tanh(a[e] * (1.f / 256.f));
        int pk = 0;
        pk = __builtin_amdgcn_cvt_pk_fp8_f32(fminf(fmaxf(gw[0] * 64.f, -448.f), 448.f), fminf(fmaxf(gw[1] * 64.f, -448.f), 448.f), pk, false);
        pk = __builtin_amdgcn_cvt_pk_fp8_f32(fminf(fmaxf(gw[2] * 64.f, -448.f), 448.f), fminf(fmaxf(gw[3] * 64.f, -448.f), 448.f), pk, true);
        const long row = it >> 5; const int s0 = (int)(it & 31) * 4, q = s0 >> 4, i0 = s0 & 15;
        unsigned char GPTR* d = (unsigned char GPTR*)(p.ws + WS_GW8) + row * 128 + 8 * i0 + q;
        d[0] = (unsigned char)(pk & 255); d[8] = (unsigned char)((pk >> 8) & 255); d[16] = (unsigned char)((pk >> 16) & 255); d[24] = (unsigned char)((unsigned)pk >> 24);
    }
}
__device__ __forceinline__ void peer_v_phase(const Params& p, int l, int nrows, const XInfo xi, PG8_LAS unsigned char* lds, int wave_s) {
    typedef int i32x8 __attribute__((ext_vector_type(8))); typedef int i32x4 __attribute__((ext_vector_type(4))); typedef int i32x2 __attribute__((ext_vector_type(2))); typedef float f32x4m __attribute__((ext_vector_type(4)));
    int tid_ = tid_of(wave_s); asm volatile("" : "+v"(tid_));
    const int lane = tid_ & 63, wid = __builtin_amdgcn_readfirstlane(tid_ >> 6), q = lane >> 3, pc = lane & 7, m = lane & 15, kg = lane >> 4, r = m >> 1, cc = m & 1, n7 = m & 7;
    const unsigned short GPTR* EI = (const unsigned short GPTR*)(p.ws + WS_EIDX); const unsigned char GPTR* W8 = (const unsigned char GPTR*)(p.ws + WS_GW8);
    int sca_ = 0x7b7b7b7b, scb_ = 0x79797979; asm volatile("" : "+v"(sca_), "+v"(scb_));
    const int gq = ((q >> 1) & 1) + ((q >> 2) & 1) * 4, gr = ((r >> 1) & 1) + ((r >> 2) & 1) * 4;
    PG8_LAS unsigned char* const wl = lds + wid * 16384;
    const unsigned tro = (unsigned)((32 * kg + r) * 128 + 8 * cc);
    for (int sl = xi.xi; sl < NSL; sl += xi.nx) {
        const unsigned char GPTR* VT = p.ws + WS_VT + (size_t)sl * 16384 * 128 + (pc ^ gq) * 16;
        for (int row = xi.rank * 8 + wid; row < nrows; row += xi.nloc * 8) {
            const u32x4 ev0 = *(const u32x4 GPTR*)(EI + (size_t)row * 128 + q * 16), ev1 = *(const u32x4 GPTR*)(EI + (size_t)row * 128 + q * 16 + 8);
            const unsigned char GPTR* wp = W8 + (size_t)row * 128 + kg * 32;
            const i32x8 wb = __builtin_shufflevector(*(const i32x4 GPTR*)wp, *(const i32x4 GPTR*)(wp + 16), 0, 1, 2, 3, 4, 5, 6, 7);
            const int col = sl * 128 + 16 * n7 + 4 * kg;
            float* x = xr_row(p, row) + col; const float* g2 = mod_ptr(p, l, row_bb(row), 5) + col;
            const f32x4m xv = *(const f32x4m*)x, gv = *(const f32x4m*)g2;
#pragma unroll
            for (int i = 0; i < 16; ++i) { const unsigned wrd = i < 8 ? ev0[i >> 1] : ev1[(i - 8) >> 1]; const unsigned e = (i & 1) ? (wrd >> 16) : (wrd & 0xffffu);
                __builtin_amdgcn_global_load_lds((const unsigned GPTR*)(VT + (size_t)e * 128), (PG8_LAS unsigned*)(wl + i * 1024), 16, 0, 0); }
            asm volatile("s_waitcnt vmcnt(0)" ::: "memory");
            f32x4m acc[8];
#pragma unroll
            for (int c = 0; c < 8; ++c) { const PG8_LAS unsigned char* ap = wl + tro + ((c ^ gr) * 16);
                const i32x2 a0 = __builtin_amdgcn_ds_read_tr8_b64_v2i32((PG8_LAS i32x2*)(ap)), a1 = __builtin_amdgcn_ds_read_tr8_b64_v2i32((PG8_LAS i32x2*)(ap + 1024)),
                            a2 = __builtin_amdgcn_ds_read_tr8_b64_v2i32((PG8_LAS i32x2*)(ap + 2048)), a3 = __builtin_amdgcn_ds_read_tr8_b64_v2i32((PG8_LAS i32x2*)(ap + 3072));
                const i32x8 va = {a0[0], a0[1], a1[0], a1[1], a2[0], a2[1], a3[0], a3[1]};
                acc[c] = __builtin_amdgcn_mfma_scale_f32_16x16x128_f8f6f4(va, wb, (f32x4m){0.f, 0.f, 0.f, 0.f}, 0, 0, 0, sca_, 0, scb_); }
            f32x4m sel = acc[0];
#pragma unroll
            for (int c = 1; c < 8; ++c) { const bool t_ = (n7 == c);
#pragma unroll
                for (int i = 0; i < 4; ++i) sel[i] = t_ ? acc[c][i] : sel[i]; }
            if (m < 8) *(f32x4m*)x = xv + gv * sel;
            asm volatile("s_waitcnt lgkmcnt(0)" ::: "memory");
        }
    }
}
__device__ __forceinline__ void final_norm_phase(const Params& p, int wave_s) {
    int tid_ = tid_of(wave_s); asm volatile("" : "+v"(tid_));
    const int lane = tid_ & 63, wid = tid_ >> 6;
    for (int row = blockIdx.x * 8 + wid; row < NRL; row += gridDim.x * 8) {
        float GPTR* x = p.out + (size_t)row * DM; f32x4v v[4]; float ss = 0.f;
#pragma unroll
        for (int q = 0; q < 4; ++q) { v[q] = *(const f32x4v GPTR*)(x + q * 256 + lane * 4); ss += v[q][0] * v[q][0] + v[q][1] * v[q][1] + v[q][2] * v[q][2] + v[q][3] * v[q][3]; }
        ss = wave_sum(ss, lane); const float rinv = 1.f / sqrtf(ss * (1.f / DM) + RMS_EPS);
#pragma unroll
        for (int q = 0; q < 4; ++q) { const f32x4v gv = *(const f32x4v GPTR*)(p.in[I_FNG] + q * 256 + lane * 4);
#pragma unroll
            for (int e = 0; e < 4; ++e) v[q][e] = v[q][e] * rinv * gv[e];
            *(f32x4v GPTR*)(x + q * 256 + lane * 4) = v[q]; }
    }
}
__device__ __forceinline__ void carry_phase(const Params& p, int wave_s) {
    int tid_ = tid_of(wave_s); asm volatile("" : "+v"(tid_));
    if (tid_ >= 64) return;
    for (int wv = blockIdx.x; wv < B_ * 16 * 2; wv += gridDim.x) {
        const int n = tid_, dir = wv & 1, g = (wv >> 1) & 15, b = wv >> 5;
        const size_t sn = (size_t)(dir * 16 + g) * 64 + n;
        const float lr = WSP(const float, WS_POW)[(sn * 33 + 32) * 2], li = WSP(const float, WS_POW)[(sn * 33 + 32) * 2 + 1];
        float sr = 0.f, si = 0.f;
        constexpr int nsteps = CCH + LCH;
        constexpr int CB = (nsteps % 24 == 0) ? 24 : 8;
        static_assert(nsteps % CB == 0, "carry unroll");
        for (int s0 = 0; s0 < nsteps; s0 += CB) {
            float2 sl[CB]; int ch[CB];
#pragma unroll
            for (int k = 0; k < CB; ++k) { const int s = s0 + k;
                ch[k] = dir == 0 ? (s < CCH ? NRL / TCH + b * CCH + s : b * LCH + (s - CCH)) : (s < CCH ? NRL / TCH + b * CCH + (CCH - 1 - s) : b * LCH + (LCH - 1 - (s - CCH)));
                sl[k] = *(const float2*)(WSP(const float, WS_SLOC) + ((size_t)(g * NCH + ch[k])) * 256 + dir * 128 + n * 2); }
#pragma unroll
            for (int k = 0; k < CB; ++k) {
                *(unsigned*)(WSP(bf16_t, WS_ASSM) + ((size_t)(g * NCH + ch[k])) * KSS + 512 + dir * 128 + n * 2) = pk2(sr, si);
                const float nr = lr * sr - li * si + sl[k].x, ni = lr * si + li * sr + sl[k].y; sr = nr; si = ni; }
        }
    }
}
}

constexpr int LDS_BYTES = 147456, LDS_BAR_OFF = 131072;
#ifndef USE_MFMA_GEMM
#define USE_MFMA_GEMM 1
#endif
#ifndef USE_FAST_PEER
#define USE_FAST_PEER 1
#endif
#if USE_MFMA_GEMM
#define GEMM_FLAT(EpiT, einit, Aoff, lda_, Boff, ldb_, Mrows, Ncols, K_) do { pg8::Gemm g_{WSP(const bf16_t, Aoff), WSP(const bf16_t, Boff), (int)(lda_), (int)(ldb_), (int)(K_)}; \
        SchedFlat S_; S_.init((Mrows) / 256, (Ncols) / 256, (int)gridDim.x, (int)blockIdx.x); EpiAdapt<EpiT> E_{EpiT einit}; \
        pg8::gemm_phase<EpiAdapt<EpiT>, SchedFlat, PG8_ALIGN, PG8_SP2>(lds, g_, S_, E_, tid_of(wave_s)); } while (0)
#define GEMM_GROUPED(EpiT, einit, Boff, ldb_, brows_, tn_, K_) do { pg8::Gemm g_{WSP(const bf16_t, WS_ASSM), WSP(const bf16_t, Boff), KSS, (int)(ldb_), (int)(K_)}; \
        SchedGrouped S_{NCHP / 256, (tn_), NCH, (brows_), (int)gridDim.x, (int)blockIdx.x}; EpiAdapt<EpiT> E_{EpiT einit}; \
        pg8::gemm_phase<EpiAdapt<EpiT>, SchedGrouped, PG8_ALIGN, PG8_SP2>(lds, g_, S_, E_, tid_of(wave_s)); } while (0)
#else
#define GEMM_FLAT(EpiT, einit, Aoff, lda_, Boff, ldb_, Mrows, Ncols, K_) do { EpiT e_ einit; naive_gemm(WSP(const bf16_t, Aoff), lda_, WSP(const bf16_t, Boff), ldb_, Mrows, Ncols, K_, e_, tid, nthr); } while (0)
#define GEMM_GROUPED(EpiT, einit, Boff, ldb_, brows_, tn_, K_) do { for (int g__ = 0; g__ < 16; ++g__) { EpiT e_ einit; e_.set_group(g__); \
        naive_gemm(WSP(const bf16_t, WS_ASSM) + (size_t)g__ * NCH * KSS, KSS, WSP(const bf16_t, Boff) + (size_t)g__ * (brows_) * (ldb_), ldb_, NCH, (tn_) * 256, K_, e_, tid, nthr); } } while (0)
#endif

__global__ void __launch_bounds__(NTHREADS, 2) mega_fwd(ParamsH p0) {
    Params p;
#pragma unroll
    for (int i = 0; i < 30; ++i) p.in[i] = (const float GPTR*)p0.in[i];
    p.out = (float GPTR*)p0.out; p.ws = (unsigned char GPTR*)p0.ws;
    extern __shared__ __attribute__((aligned(16))) unsigned char lds_raw[];
    PG8_LAS unsigned char* lds = (PG8_LAS unsigned char*)lds_raw;
    const int wave_s = __builtin_amdgcn_readfirstlane((int)threadIdx.x >> 6);
    if (tid_of(wave_s) < 4) ((volatile LAS unsigned*)(lds + LDS_BAR_OFF))[tid_of(wave_s)] = 0u;
    __syncthreads();
    (void)xcd_barrier_post((unsigned*)(p.ws + WS_CTL), (volatile LAS unsigned*)(lds + LDS_BAR_OFF), tid_of(wave_s));
    long nthr, tid;
#define REFRESH() do { int t_ = tid_of(wave_s); asm volatile("" : "+v"(t_)); int g_ = gridDim.x; asm volatile("" : "+s"(g_)); tid = (long)blockIdx.x * NTHREADS + t_; nthr = (long)g_ * NTHREADS; \
        unsigned char* w_ = p0.ws; asm volatile("" : "+s"(w_)); p.ws = (unsigned char GPTR*)w_; float* o_ = p0.out; asm volatile("" : "+s"(o_)); p.out = (float GPTR*)o_; } while (0)
#define GBAR() do { asm volatile("; PHASE_MARK %0" :: "i"(__LINE__)); { XcdBarrier b_; b_.bar = (unsigned*)(p.ws + WS_CTL); b_.x = xb_xcc_id(); b_.st = (volatile LAS unsigned*)(lds + LDS_BAR_OFF); xcd_barrier(b_, tid_of(wave_s)); } REFRESH(); } while (0)
    REFRESH();
#ifndef DUP_MASK
#define DUP_MASK 0
#endif
#define DUP(bit, stmt) do { stmt; if (DUP_MASK & (1 << (bit))) { stmt; } } while (0)
    if (tid_of(wave_s) == 0) { const unsigned r_ = xb_add((unsigned*)(p.ws + WS_CTL) + 8192 + 64 * xb_xcc_id(), 1u); ((volatile LAS unsigned*)(lds + LDS_BAR_OFF))[4] = r_; }
    DUP(14, fastp::mod_phase(p, lds, wave_s); REFRESH()); ph_mod_small(p, tid, nthr); GBAR();
    fastp::XInfo xinf;
    { unsigned mine = xb_xcc_id(), xi_ = 0, nx_ = 0, nl_ = 1;
#pragma unroll
      for (unsigned j_ = 0; j_ < 16; ++j_) { const unsigned c_ = xb_ld((unsigned*)(p.ws + WS_CTL) + XB_XCNT(j_)); nx_ += c_ > 0u; xi_ += (c_ > 0u && j_ < mine); nl_ = (j_ == mine) ? c_ : nl_; }
      xinf.xi = __builtin_amdgcn_readfirstlane((int)xi_); xinf.nx = __builtin_amdgcn_readfirstlane((int)(nx_ ? nx_ : 1u)); xinf.nloc = __builtin_amdgcn_readfirstlane((int)(nl_ ? nl_ : 1u));
      xinf.rank = __builtin_amdgcn_readfirstlane((int)((volatile LAS unsigned*)(lds + LDS_BAR_OFF))[4]); }
    for (int l = 0; l < DEPTH; ++l) {
        const int nact = (l == 0) ? NR : NRL;
        DUP(0, ph_prep_a(p, l, tid, nthr)); DUP(2, fastp::norm_phase(p, l, 1, NR, l == 0, wave_s); REFRESH()); GBAR();
        DUP(1, ph_prep_b(p, l, tid, nthr));
        { pg8::Gemm g_{WSP(const bf16_t, WS_SKA), WSP(const bf16_t, WS_WQB), 256, 2048, 256}; SchedWsc S_{(int)gridDim.x, (int)blockIdx.x}; EpiAdapt<EpiWsc> E_{EpiWsc{p}};
          pg8::gemm_phase<EpiAdapt<EpiWsc>, SchedWsc, PG8_ALIGN, PG8_SP2>(lds, g_, S_, E_, tid_of(wave_s)); }
        {
          pg8::Gemm g_{(const bf16_t*)(p.ws + WS_H8), (const bf16_t*)(p.ws + WS_WG8), DM / 2, DM / 2, DM / 2};
          SchedFlat S_; S_.init(NR / 256, INW / 256, (int)gridDim.x, (int)blockIdx.x); EpiAdapt<EpiWinG> E_{EpiWinG{p}};
          DUP(3, (pg8::gemm_phase<EpiAdapt<EpiWinG>, SchedFlat, PG8_ALIGN, PG8_SP2, true>(lds, g_, S_, E_, tid_of(wave_s)))); }
        GBAR();
        DUP(1, ph_prep_c(p, l, tid, nthr));
        DUP(4, GEMM_GROUPED(EpiSsm1, ({p, 0}), WS_BT1, 512, 256, 1, 512));
        DUP(5, dattn::diff_phase(p, l, lds, wave_s); REFRESH());
        DUP(6, nattn::na_phase(p, l, lds, wave_s); REFRESH()); GBAR();
        DUP(7, fastp::carry_phase(p, wave_s); REFRESH()); GBAR();
        DUP(8, GEMM_GROUPED(EpiSsm2, ({p, 0}), WS_BT2, KSS, 512, 2, KSS)); GBAR();
        DUP(9, GEMM_FLAT(EpiGlu, {p}, WS_YG, 256, WS_WGLU, 256, nact, 512, 256)); GBAR();
        DUP(9, GEMM_FLAT(EpiMerge, ({p, WS_SGS, false}), WS_YS, 256, WS_WBS, 256, nact, DM, 256)); REFRESH();
        GEMM_FLAT(EpiMerge, ({p, WS_SGD, true}), WS_YD, 512, WS_WBD, 512, nact, DM, 512); REFRESH();
        GEMM_FLAT(EpiMerge, ({p, WS_SGN, true, true}), WS_YN, 256, WS_WBN, 256, nact, DM, 256); GBAR();
        {
          pg8::Gemm g_{(const bf16_t*)(p.ws + WS_MB8), (const bf16_t*)(p.ws + WS_WOUT), DM / 2, DM / 2, DM / 2};
          SchedFlat S_; S_.init(nact / 256, DM / 256, (int)gridDim.x, (int)blockIdx.x); EpiAdapt<EpiWout> E_{EpiWout{p, l}};
          pg8::gemm_phase<EpiAdapt<EpiWout>, SchedFlat, PG8_ALIGN, PG8_SP2, true>(lds, g_, S_, E_, tid_of(wave_s)); }
        GBAR();
        DUP(13, fastp::norm_phase(p, l, 2, nact, false, wave_s); REFRESH()); DUP(10, fastp::tables8s_phase(p, l, tid, nthr)); GBAR();
        DUP(11, GEMM_FLAT(EpiScore, {p}, WS_H, DM, WS_WSC, DM, nact, 2048, DM)); GBAR();
        DUP(12, ph_topk(p, nact, tid, nthr)); GBAR();
        fastp::peer_u_phase(p, nact, xinf, lds, wave_s); REFRESH(); GBAR();
        fastp::peer_comb_phase(p, nact, tid, nthr); GBAR();
        fastp::peer_v_phase(p, l, nact, xinf, lds, wave_s); REFRESH(); GBAR();
    }
    fastp::final_norm_phase(p, wave_s);
#undef GBAR
}

extern "C" void kernel_launch(void* const* d_in, const int* in_sizes, int n_in, void* d_out, int out_size, void* d_ws, size_t ws_size, hipStream_t stream) {
    static int grid = 0;
    if (grid == 0) {
        int dev = 0, cus = 0, per_cu = 0;
        (void)hipGetDevice(&dev);
        (void)hipDeviceGetAttribute(&cus, hipDeviceAttributeMultiprocessorCount, dev);
        (void)hipFuncSetAttribute((const void*)mega_fwd, hipFuncAttributeMaxDynamicSharedMemorySize, LDS_BYTES);
        (void)hipOccupancyMaxActiveBlocksPerMultiprocessor(&per_cu, (const void*)mega_fwd, NTHREADS, LDS_BYTES);
        (void)hipGetLastError();
        if (cus <= 0) cus = 256;
        grid = cus;
        if (n_in != 30 || ws_size < WS_TOTAL) { fprintf(stderr, "kernel_launch: unexpected n_in %d / ws %zu (need %zu)\n", n_in, ws_size, (size_t)WS_TOTAL); }
    }
    (void)hipMemsetAsync((char*)d_ws + WS_CTL, 0, CTL_BYTES, stream);
    ParamsH p{};
    for (int i = 0; i < 30; ++i) p.in[i] = (const float*)d_in[i];
    p.out = (float*)d_out; p.ws = (unsigned char*)d_ws;
    hipLaunchKernelGGL(mega_fwd, dim3(grid), dim3(NTHREADS), LDS_BYTES, stream, p);
}
#endif
```

```cpp
#ifndef HOST_EMU
#include <hip/hip_runtime.h>
#define HD __host__ __device__ __forceinline__
#else
#include <cmath>
#include <cstring>
#include <cstdio>
#include <cstdlib>
#define HD inline
#endif
#include <cstdint>
#include <cstddef>
#ifndef HOST_EMU
#define UNROLL _Pragma("unroll")
#else
#define UNROLL
#endif

#ifndef BATCH
#define BATCH 4
#endif
#ifndef SEQ
#define SEQ 8192
#endif
#ifndef CTX_LEN
#define CTX_LEN 256
#endif
constexpr int B_ = BATCH, L_ = SEQ, C_ = CTX_LEN, DM = 1024, DEPTH = 2;
constexpr int NRL = B_ * L_, NRC = B_ * C_, NR = NRL + NRC;
constexpr int GRW = 64, GRR = L_ / GRW;
constexpr int TCH = 32, NCH = NR / TCH;
constexpr int NCHP = ((NCH + 255) / 256) * 256;
constexpr int LCH = L_ / TCH, CCH = C_ / TCH;
constexpr int INW = 5632, KSS = 768;
constexpr float RMS_EPS = 1e-6f;
constexpr float LOG2E = 1.4426950408889634f;

typedef unsigned short bf16_t;

HD float u2f(unsigned u) { float f; memcpy(&f, &u, 4); return f; }
HD unsigned f2u(float f) { unsigned u; memcpy(&u, &f, 4); return u; }
HD float bf2f(bf16_t v) { return u2f((unsigned)v << 16); }
HD bf16_t f2bf(float f) { unsigned u = f2u(f); return (bf16_t)((u + 0x7fffu + ((u >> 16) & 1u)) >> 16); }
#if defined(__HIP_DEVICE_COMPILE__)
HD float fexp2_(float x) { return __builtin_amdgcn_exp2f(x); }
HD float frcp_(float x) { return __builtin_amdgcn_rcpf(x); }
#else
HD float fexp2_(float x) { return exp2f(x); }
HD float frcp_(float x) { return 1.f / x; }
#endif
HD float sigmoidf_(float x) { return frcp_(1.f + fexp2_(-1.4426950408889634f * x)); }
HD float gelu_tanh(float x) { const float z = 0.7978845608028654f * (x + 0.044715f * x * x * x); return x * (1.f - frcp_(fexp2_(2.885390081777927f * z) + 1.f)); }
HD float siluf_(float x) { return x * sigmoidf_(x); }
struct alignas(16) bf8 { bf16_t v[8]; };
struct alignas(8) bf4 { bf16_t v[4]; };
struct alignas(16) fl4 { float v[4]; };

constexpr size_t al256(size_t x) { return (x + 255) & ~(size_t)255; }
constexpr size_t WS_CTL = 0;
constexpr size_t CTL_BYTES = 65536;
constexpr size_t WS_MOD = WS_CTL + CTL_BYTES;
constexpr size_t WS_ROPE = al256(WS_MOD + (size_t)DEPTH * (B_ + 1) * 6144 * 4);
constexpr size_t WS_LAMD = al256(WS_ROPE + 128 * 16 * 8);
constexpr size_t WS_POW = al256(WS_LAMD + 256);
constexpr size_t WS_BBAR = al256(WS_POW + (size_t)2 * 16 * 64 * 33 * 8);
constexpr size_t WS_KK = al256(WS_BBAR + (size_t)2 * 16 * 64 * 16 * 8);
constexpr size_t WS_XRC = al256(WS_KK + (size_t)2 * 16 * 32 * 256 * 4);
constexpr size_t WS_WIN = al256(WS_XRC + (size_t)NRC * DM * 4);
constexpr size_t WS_WGLU = al256(WS_WIN + (size_t)INW * DM * 2);
constexpr size_t WS_WBS = al256(WS_WGLU + (size_t)512 * 256 * 2);
constexpr size_t WS_WBD = al256(WS_WBS + (size_t)1024 * 256 * 2);
constexpr size_t WS_WBN = al256(WS_WBD + (size_t)1024 * 512 * 2);
constexpr size_t WS_WOUT = al256(WS_WBN + (size_t)1024 * 256 * 2);
constexpr size_t WS_WSC = al256(WS_WOUT + (size_t)1024 * 1024 * 2);
constexpr size_t WS_BT1 = al256(WS_WSC + (size_t)2048 * 1024 * 2);
constexpr size_t WS_BT2 = al256(WS_BT1 + (size_t)16 * 256 * 512 * 2);
constexpr size_t WS_H = al256(WS_BT2 + (size_t)16 * 512 * 768 * 2);
constexpr size_t WS_YD = WS_H;
constexpr size_t WS_YN = WS_YD + (size_t)NR * 512 * 2;
constexpr size_t WS_YS = WS_YN + (size_t)NR * 256 * 2;
constexpr size_t WS_ASSM = al256(WS_H + (size_t)NR * DM * 2);
constexpr size_t WS_EIDX = WS_ASSM;
constexpr size_t WS_SLOC = al256(WS_ASSM + ((size_t)16 * NCH + 256) * KSS * 2);
constexpr size_t WS_WQB = WS_SLOC;
constexpr size_t WS_SKA = WS_WQB + (size_t)1024 * 2048 * 2;
constexpr size_t WS_QD = al256(WS_SLOC + (size_t)16 * NCH * 256 * 4);
constexpr size_t WS_KD = WS_QD + (size_t)NR * 512 * 2;
constexpr size_t WS_VD = WS_KD + (size_t)NR * 512 * 2;
constexpr size_t WS_QN = WS_VD + (size_t)NR * 512 * 2;
constexpr size_t WS_KN = WS_QN + (size_t)NR * 256 * 2;
constexpr size_t WS_VN = WS_KN + (size_t)NR * 256 * 2;
constexpr size_t WS_SGS = WS_VN + (size_t)NR * 256 * 2;
constexpr size_t WS_SGD = WS_SGS + (size_t)NR * DM * 2;
constexpr size_t WS_SGN = WS_SGD + (size_t)NR * DM * 2;
constexpr size_t WS_END1 = WS_SGN + (size_t)NR * DM * 2;
constexpr size_t WS_H8 = WS_H;
constexpr size_t WS_WG8 = WS_WIN;
constexpr size_t WS_VT8 = WS_VD;
constexpr int KVP = C_ + L_;
constexpr size_t WS_GW8 = WS_H;
constexpr size_t WS_MB8 = WS_ASSM;
constexpr size_t WS_MB = WS_QD;
constexpr size_t WS_YG = WS_QN;
#ifdef HOST_EMU
constexpr size_t WS_SC = WS_QD;
constexpr size_t TBL_BYTES = (size_t)16384 * 1024 * 2;
constexpr size_t WS_UT = al256(WS_SC + (size_t)NR * 2048 * 4);
constexpr size_t WS_VT = WS_UT + TBL_BYTES;
constexpr size_t WS_GW = WS_VT + TBL_BYTES;
#else
constexpr size_t TBL_BYTES = (size_t)16384 * 1024;
constexpr size_t WS_UT = WS_VD;
constexpr size_t WS_VT = WS_UT + TBL_BYTES;
static_assert(2 * TBL_BYTES <= (size_t)NR * 512 * 2, "tables fit the V region");
constexpr size_t WS_SC = WS_SGS;
constexpr size_t WS_GW = al256(WS_SC + (size_t)NR * 2048 * 2);
#endif
constexpr size_t WS_H8B = al256(WS_GW + (size_t)NR * 128 * 4);
constexpr size_t WS_END2 = WS_H8B + (size_t)NR * DM;
constexpr size_t WS_TOTAL = WS_END1 > WS_END2 ? WS_END1 : WS_END2;
#if BATCH == 4 && SEQ == 8192 && CTX_LEN == 256
static_assert(WS_TOTAL <= (size_t)512 * 1024 * 1024, "workspace map exceeds 512 MiB");
#endif

#if defined(__HIP_DEVICE_COMPILE__)
#define GPTR __attribute__((address_space(1)))
#else
#define GPTR
#endif
struct ParamsH { const float* in[30]; float* out; unsigned char* ws; };
struct Params {
    const float GPTR* in[30];
    float GPTR* out;
    unsigned char GPTR* ws;
};
enum { I_X = 0, I_C, I_CTX, I_CCTX, I_ADAW, I_ADAB, I_N1G, I_N2G, I_WIN, I_LRE, I_LIM, I_LSTEP, I_BRE, I_BIM, I_CRE, I_CIM, I_SSMD, I_GLUW,
       I_DLAM, I_SUBLN, I_RPB, I_WBS, I_WBD, I_WBN, I_WOUT, I_WQ, I_SUBK, I_PU, I_PV, I_FNG };

#define WSP(T, off) ((T*)(p.ws + (off)))
HD float* xr_row(const Params& p, int row) { return row < NRL ? (float*)(p.out + (size_t)row * DM) : WSP(float, WS_XRC) + (size_t)(row - NRL) * DM; }
HD int row_bb(int row) { return row < NRL ? row / L_ : B_; }
HD const float* mod_ptr(const Params& p, int l, int bb, int seg) { return WSP(const float, WS_MOD) + ((size_t)(l * (B_ + 1) + bb) * 6 + seg) * DM; }

template <class F>
HD void naive_gemm(const bf16_t* A, size_t lda, const bf16_t* Bt, size_t ldb, int M, int N, int K, const F& f, long tid, long nthr) {
    const long per_row = N / 8, items = (long)M * per_row;
    for (long it = tid; it < items; it += nthr) {
        const int row = (int)(it / per_row), cg = (int)(it % per_row), c0 = (cg >> 2) * 32 + (cg & 3) * 4;
        float a[4] = {0.f, 0.f, 0.f, 0.f}, b[4] = {0.f, 0.f, 0.f, 0.f};
        const bf16_t* ar = A + (size_t)row * lda;
        for (int k = 0; k < K; k += 8) {
            const bf8 av = *(const bf8*)(ar + k);
            float af[8];
            for (int e = 0; e < 8; ++e) af[e] = bf2f(av.v[e]);
            for (int j = 0; j < 4; ++j) {
                const bf8 b0 = *(const bf8*)(Bt + (size_t)(c0 + j) * ldb + k), b1 = *(const bf8*)(Bt + (size_t)(c0 + 16 + j) * ldb + k);
                for (int e = 0; e < 8; ++e) { a[j] += af[e] * bf2f(b0.v[e]); b[j] += af[e] * bf2f(b1.v[e]); }
            }
        }
        f(row, c0, a, b);
    }
}

HD void st_bf4(bf16_t* dst, const float* v) { bf4 o; for (int j = 0; j < 4; ++j) o.v[j] = f2bf(v[j]); *(bf4*)dst = o; }

struct EpiWin {
    Params p;
    HD void set_group(int) {}
    template <int R = -1> HD void one(int row, int col, const float* v, const float* partner, bool first) const {
#if defined(__HIP_DEVICE_COMPILE__)
        Params p = this->p; { unsigned char GPTR* w_ = p.ws; asm volatile("" : "+s"(w_)); p.ws = w_; }
#endif
        if (R == 0 || (R < 0 && col < 256)) {
            const int g = col >> 4, ch = col & 15, chunk = row / TCH, tk = row % TCH;
            st_bf4(WSP(bf16_t, WS_ASSM) + ((size_t)(g * NCH + chunk)) * KSS + tk * 16 + ch, v);
        } else if (R == 1 || (R < 0 && col < 1280)) {
            const bool isq = col < 768; const int cc = col - (isq ? 256 : 768);
            float o[4];
            if (row < NRL) {
                const int t = row % L_, grp = (cc >> 5) & 1, pos = grp ? (t % GRW) : (t / GRW), i0 = cc & 15;
                const float* cs = WSP(const float, WS_ROPE) + ((size_t)pos * 16 + i0) * 2;
                for (int j = 0; j < 4; ++j) { const float c = cs[2 * j], s = cs[2 * j + 1]; o[j] = first ? (v[j] * c - partner[j] * s) : (v[j] * c + partner[j] * s); }
            } else for (int j = 0; j < 4; ++j) o[j] = v[j];
            if (isq) for (int j = 0; j < 4; ++j) o[j] *= 0.125f * LOG2E;
#ifdef HOST_EMU
            st_bf4(WSP(bf16_t, isq ? WS_QD : WS_KD) + (size_t)row * 512 + cc, o);
#else
            { int pk = 0;
              pk = __builtin_amdgcn_cvt_pk_fp8_f32(fminf(fmaxf(o[0] * 8.f, -448.f), 448.f), fminf(fmaxf(o[1] * 8.f, -448.f), 448.f), pk, false);
              pk = __builtin_amdgcn_cvt_pk_fp8_f32(fminf(fmaxf(o[2] * 8.f, -448.f), 448.f), fminf(fmaxf(o[3] * 8.f, -448.f), 448.f), pk, true);
              *(unsigned GPTR*)(p.ws + (isq ? WS_QD : WS_KD) + (size_t)row * 512 + cc) = (unsigned)pk; }
#endif
        } else if (R == 2 || (R < 0 && col < 1792)) {
#ifdef HOST_EMU
            st_bf4(WSP(bf16_t, WS_VD) + (size_t)row * 512 + (col - 1280), v);
#else
            const int cc = col - 1280, bb = row < NRL ? row / L_ : (row - NRL) / C_, kp = row < NRL ? C_ + row % L_ : (row - NRL) % C_;
            unsigned char GPTR* vt = (unsigned char GPTR*)(p.ws + WS_VT8); const unsigned off = (unsigned)((bb * 512 + cc) * KVP + kp);
            int pk = 0;
            pk = __builtin_amdgcn_cvt_pk_fp8_f32(fminf(fmaxf(v[0], -448.f), 448.f), fminf(fmaxf(v[1], -448.f), 448.f), pk, false);
            pk = __builtin_amdgcn_cvt_pk_fp8_f32(fminf(fmaxf(v[2], -448.f), 448.f), fminf(fmaxf(v[3], -448.f), 448.f), pk, true);
            vt[off] = (unsigned char)(pk & 255); vt[off + KVP] = (unsigned char)((pk >> 8) & 255); vt[off + 2 * KVP] = (unsigned char)((pk >> 16) & 255); vt[off + 3 * KVP] = (unsigned char)((unsigned)pk >> 24);
#endif
        } else if ((R == 3 || R < 0) && col < 2048) { float o[4]; for (int j = 0; j < 4; ++j) o[j] = v[j] * (0.125f * LOG2E); st_bf4(WSP(bf16_t, WS_QN) + (size_t)row * 256 + (col - 1792), o);
        } else if ((R == 3 || R < 0) && col < 2304) { st_bf4(WSP(bf16_t, WS_KN) + (size_t)row * 256 + (col - 2048), v);
        } else if (R == 3 || (R < 0 && col < 2560)) { st_bf4(WSP(bf16_t, WS_VN) + (size_t)row * 256 + (col - 2304), v);
        } else {
            const int gc = col - 2560, which = gc >> 10, c = gc & 1023;
            float o[4]; for (int j = 0; j < 4; ++j) o[j] = sigmoidf_(v[j]);
            st_bf4(WSP(bf16_t, which == 0 ? WS_SGS : which == 1 ? WS_SGD : WS_SGN) + (size_t)row * DM + c, o);
        }
    }
    HD void operator()(int row, int c0, const float* a, const float* b) const { one(row, c0, a, b, true); one(row, c0 + 16, b, a, false); }
};
struct EpiWinG { Params p;
    HD void set_group(int) {}
    HD void operator()(int row, int c0, const float* a, const float* b) const { EpiWin e{p}; e.one(row, c0, a, b, true); e.one(row, c0 + 16, b, a, false); }
    template <int R> HD void tile(int row, int c0, const float* a, const float* b) const { EpiWin e{p}; e.template one<R>(row, c0, a, b, true); e.template one<R>(row, c0 + 16, b, a, false); } };
struct EpiSsm1 { Params p; int g;
    HD void set_group(int g_) { g = g_; }
    HD void operator()(int row, int c0, const float* a, const float* b) const {
        if (row >= NCH) return;
        float* d = WSP(float, WS_SLOC) + ((size_t)(g * NCH + row)) * 256 + c0;
        for (int j = 0; j < 4; ++j) { d[j] = a[j]; d[16 + j] = b[j]; }
    } };
struct EpiSsm2 { Params p; int g;
    HD void set_group(int g_) { g = g_; }
    HD void one(int chunk, int col, const float* v) const {
        const int tk = col >> 4, ch = col & 15; float o[4]; for (int j = 0; j < 4; ++j) o[j] = gelu_tanh(v[j]);
        st_bf4(WSP(bf16_t, WS_YG) + ((size_t)chunk * TCH + tk) * 256 + g * 16 + ch, o);
    }
    HD void operator()(int row, int c0, const float* a, const float* b) const { if (row >= NCH) return; one(row, c0, a); one(row, c0 + 16, b); } };
struct EpiGlu { Params p;
    HD void set_group(int) {}
    HD void one(int row, int col, const float* v) const {
        bf16_t* d = WSP(bf16_t, WS_YS) + (size_t)row * 256 + (col >> 1);
        const unsigned pk = (unsigned)f2bf(v[0] * sigmoidf_(v[1])) | ((unsigned)f2bf(v[2] * sigmoidf_(v[3])) << 16); *(unsigned*)d = pk;
    }
    HD void operator()(int row, int c0, const float* a, const float* b) const { one(row, c0, a); one(row, c0 + 16, b); } };
struct EpiMerge { Params p; size_t sg_off; bool accum; bool last = false;
    HD void set_group(int) {}
    HD void one(int row, int col, const float* v) const {
        const bf16_t* sg = WSP(const bf16_t, sg_off) + (size_t)row * DM + col; bf16_t* m = WSP(bf16_t, WS_MB) + (size_t)row * DM + col;
        float o[4]; for (int j = 0; j < 4; ++j) o[j] = bf2f(sg[j]) * v[j] + (accum ? bf2f(m[j]) : 0.f);
#ifndef HOST_EMU
        if (last) { int pk = 0;
            pk = __builtin_amdgcn_cvt_pk_fp8_f32(fminf(fmaxf(o[0], -448.f), 448.f), fminf(fmaxf(o[1], -448.f), 448.f), pk, false);
            pk = __builtin_amdgcn_cvt_pk_fp8_f32(fminf(fmaxf(o[2], -448.f), 448.f), fminf(fmaxf(o[3], -448.f), 448.f), pk, true);
            *(unsigned GPTR*)(p.ws + WS_MB8 + (size_t)row * DM + col) = (unsigned)pk; return; }
#endif
        st_bf4(m, o);
    }
    HD void operator()(int row, int c0, const float* a, const float* b) const { one(row, c0, a); one(row, c0 + 16, b); } };
struct EpiWout { Params p; int l;
    HD void set_group(int) {}
    HD void one(int row, int col, const float* v) const {
        float* x = xr_row(p, row) + col; const float* g1 = mod_ptr(p, l, row_bb(row), 2) + col;
        for (int j = 0; j < 4; ++j) x[j] += g1[j] * v[j];
    }
    HD void operator()(int row, int c0, const float* a, const float* b) const { one(row, c0, a); one(row, c0 + 16, b); } };
struct EpiWsc { Params p;
    HD void set_group(int) {}
    HD void operator()(int row, int c0, const float* a, const float* b) const { st_bf4(WSP(bf16_t, WS_WSC) + (size_t)row * 1024 + c0, a); st_bf4(WSP(bf16_t, WS_WSC) + (size_t)row * 1024 + c0 + 16, b); } };
struct EpiScore { Params p;
    HD void set_group(int) {}
    HD void operator()(int row, int c0, const float* a, const float* b) const {
        bf16_t* d = WSP(bf16_t, WS_SC) + ((size_t)(row >> 6) * 2048 + c0) * 64 + (row & 63);
        for (int j = 0; j < 4; ++j) { d[j * 64] = f2bf(a[j]); d[(16 + j) * 64] = f2bf(b[j]); }
    } };

HD void ph_copy_x(const Params& p, long tid, long nthr) {
    const long n4 = (long)NR * DM / 4;
    for (long i = tid; i < n4; i += nthr) {
        const int row = (int)(i / (DM / 4)), c = (int)(i % (DM / 4)) * 4;
        const float* src = row < NRL ? p.in[I_X] + (size_t)row * DM + c : p.in[I_CTX] + (size_t)(row - NRL) * DM + c;
        *(fl4*)(xr_row(p, row) + c) = *(const fl4*)src;
    }
}
HD void ph_mod_small(const Params& p, long tid, long nthr) {
    for (long it = tid; it < 128 * 16; it += nthr) {
        const int pos = (int)(it / 16), i = (int)(it % 16);
        const float fr = exp2f(-(float)i * (13.287712379549449f / 16.0f)), ang = (float)pos * fr;
        WSP(float, WS_ROPE)[it * 2] = cosf(ang); WSP(float, WS_ROPE)[it * 2 + 1] = sinf(ang);
    }
    for (long it = tid; it < DEPTH; it += nthr) {
        const float* lq = p.in[I_DLAM] + it * 4 * 64; float s01 = 0.f, s23 = 0.f;
        for (int d = 0; d < 64; ++d) { s01 += lq[d] * lq[64 + d]; s23 += lq[128 + d] * lq[192 + d]; }
        const float lam_init = 0.8f - 0.6f * expf(-0.3f * (float)it);
        WSP(float, WS_LAMD)[it] = expf(s01) - expf(s23) + lam_init; WSP(float, WS_LAMD)[2 + it] = 1.f - lam_init;
    }
}
HD void ph_mod(const Params& p, long tid, long nthr) {
    const long items = (long)DEPTH * 6144;
    for (long it = tid; it < items; it += nthr) {
        const int l = (int)(it / 6144), col = (int)(it % 6144);
        float acc[B_ + 1]; for (int b = 0; b <= B_; ++b) acc[b] = 0.f;
        const float* w = p.in[I_ADAW] + (size_t)l * DM * 6144 + col;
        for (int d = 0; d < DM; ++d) { const float wv = w[(size_t)d * 6144];
            for (int b = 0; b < B_; ++b) acc[b] += siluf_(p.in[I_C][b * DM + d]) * wv;
            acc[B_] += siluf_(p.in[I_CCTX][d]) * wv; }
        const float bias = p.in[I_ADAB][l * 6144 + col];
        for (int b = 0; b <= B_; ++b) WSP(float, WS_MOD)[((size_t)(l * (B_ + 1) + b)) * 6144 + col] = acc[b] + bias;
    }
    for (long it = tid; it < 128 * 16; it += nthr) {
        const int pos = (int)(it / 16), i = (int)(it % 16);
        const float fr = exp2f(-(float)i * (13.287712379549449f / 16.0f)), ang = (float)pos * fr;
        WSP(float, WS_ROPE)[it * 2] = cosf(ang); WSP(float, WS_ROPE)[it * 2 + 1] = sinf(ang);
    }
    for (long it = tid; it < DEPTH; it += nthr) {
        const float* lq = p.in[I_DLAM] + it * 4 * 64; float s01 = 0.f, s23 = 0.f;
        for (int d = 0; d < 64; ++d) { s01 += lq[d] * lq[64 + d]; s23 += lq[128 + d] * lq[192 + d]; }
        const float lam_init = 0.8f - 0.6f * expf(-0.3f * (float)it);
        WSP(float, WS_LAMD)[it] = expf(s01) - expf(s23) + lam_init;
    }
}
HD void tr_item(const float* W, int K, int N, bf16_t* WT, long it) {
    const int n = (int)(it % N), k0 = (int)(it / N) * 8; bf8 o;
    for (int e = 0; e < 8; ++e) o.v[e] = f2bf(W[(size_t)(k0 + e) * N + n]);
    *(bf8*)(WT + (size_t)n * K + k0) = o;
}
HD void ph_prep_a(const Params& p, int l, long tid, long nthr) {
#ifdef HOST_EMU
    for (long it = tid; it < (long)INW * DM / 8; it += nthr) tr_item(p.in[I_WIN] + (size_t)l * DM * INW, DM, INW, WSP(bf16_t, WS_WIN), it);
#else
    for (long it = tid; it < (long)INW * DM / 8; it += nthr) {
        const int n = (int)(it % INW), k0 = (int)(it / INW) * 8; const float* W = p.in[I_WIN] + (size_t)l * DM * INW;
        float v[8]; for (int e = 0; e < 8; ++e) v[e] = fminf(fmaxf(W[(size_t)(k0 + e) * INW + n] * 256.f, -448.f), 448.f);
        int lo = 0, hi = 0; lo = __builtin_amdgcn_cvt_pk_fp8_f32(v[0], v[1], lo, false); lo = __builtin_amdgcn_cvt_pk_fp8_f32(v[2], v[3], lo, true);
        hi = __builtin_amdgcn_cvt_pk_fp8_f32(v[4], v[5], hi, false); hi = __builtin_amdgcn_cvt_pk_fp8_f32(v[6], v[7], hi, true);
        *(uint2*)(p.ws + WS_WG8 + (size_t)n * DM + k0) = make_uint2((unsigned)lo, (unsigned)hi);
    }
#endif
    for (long it = tid; it < (long)512 * 256 / 8; it += nthr) {
        const int n = (int)(it % 512), k0 = (int)(it / 512) * 8, src = (n & 1) ? 256 + (n >> 1) : (n >> 1); bf8 o;
        for (int e = 0; e < 8; ++e) o.v[e] = f2bf(p.in[I_GLUW][(size_t)l * 256 * 512 + (size_t)(k0 + e) * 512 + src]);
        *(bf8*)(WSP(bf16_t, WS_WGLU) + (size_t)n * 256 + k0) = o;
    }
    for (long it = tid; it < (long)1024 * 256 / 8; it += nthr) tr_item(p.in[I_WBS] + (size_t)l * 256 * 1024, 256, 1024, WSP(bf16_t, WS_WBS), it);
    for (long it = tid; it < (long)1024 * 512 / 8; it += nthr) tr_item(p.in[I_WBD] + (size_t)l * 512 * 1024, 512, 1024, WSP(bf16_t, WS_WBD), it);
    for (long it = tid; it < (long)1024 * 256 / 8; it += nthr) tr_item(p.in[I_WBN] + (size_t)l * 256 * 1024, 256, 1024, WSP(bf16_t, WS_WBN), it);
#ifdef HOST_EMU
    for (long it = tid; it < (long)1024 * 1024 / 8; it += nthr) tr_item(p.in[I_WOUT] + (size_t)l * 1024 * 1024, 1024, 1024, WSP(bf16_t, WS_WOUT), it);
#else
    for (long it = tid; it < (long)1024 * 1024 / 8; it += nthr) {
        const int n = (int)(it % 1024), k0 = (int)(it / 1024) * 8; const float* W = p.in[I_WOUT] + (size_t)l * 1024 * 1024;
        float v[8]; for (int e = 0; e < 8; ++e) v[e] = fminf(fmaxf(W[(size_t)(k0 + e) * 1024 + n] * 256.f, -448.f), 448.f);
        int lo = 0, hi = 0; lo = __builtin_amdgcn_cvt_pk_fp8_f32(v[0], v[1], lo, false); lo = __builtin_amdgcn_cvt_pk_fp8_f32(v[2], v[3], lo, true);
        hi = __builtin_amdgcn_cvt_pk_fp8_f32(v[4], v[5], hi, false); hi = __builtin_amdgcn_cvt_pk_fp8_f32(v[6], v[7], hi, true);
        *(uint2*)(p.ws + WS_WOUT + (size_t)n * 1024 + k0) = make_uint2((unsigned)lo, (unsigned)hi);
    }
#endif
#ifdef HOST_EMU
    for (long it = tid; it < (long)2048 * 1024; it += nthr) {
        const int d = (int)(it % 1024), hxn = (int)(it / 1024), hx = hxn >> 7;
        const float* wq = p.in[I_WQ] + (size_t)l * 1024 * 2048 + (size_t)d * 2048 + hx * 128;
        const float* sk = p.in[I_SUBK] + (size_t)l * 2048 * 128 + (size_t)hxn * 128;
        float s = 0.f; for (int j = 0; j < 128; ++j) s += wq[j] * sk[j];
        WSP(bf16_t, WS_WSC)[(size_t)hxn * 1024 + d] = f2bf(s);
    }
#else
    for (long it = tid; it < (long)1024 * 2048 / 8; it += nthr) { const float* src = p.in[I_WQ] + (size_t)l * 1024 * 2048 + it * 8; bf8 o;
        for (int e = 0; e < 8; ++e) o.v[e] = f2bf(src[e]);
        *(bf8*)(WSP(bf16_t, WS_WQB) + it * 8) = o; }
    for (long it = tid; it < (long)2048 * 256 / 8; it += nthr) { const int r = (int)(it >> 5), c0 = (int)(it & 31) * 8, hx = r >> 7, cl = c0 >> 7, j0 = c0 & 127; bf8 o;
        const float* src = p.in[I_SUBK] + (size_t)l * 2048 * 128 + (size_t)r * 128 + j0;
        for (int e = 0; e < 8; ++e) o.v[e] = (cl == (hx & 1)) ? f2bf(src[e]) : (bf16_t)0;
        *(bf8*)(WSP(bf16_t, WS_SKA) + (size_t)r * 256 + c0) = o; }
#endif
    for (long it = tid; it < 2 * 16 * 64; it += nthr) {
        const int dir = (int)(it / 1024), g = (int)(it / 64) % 16;
        const size_t li = (size_t)l * 2048 + it;
        double lre = p.in[I_LRE][li]; if (lre > -1e-4) lre = -1e-4; const double lim = p.in[I_LIM][li];
        const double dt = (double)expf(p.in[I_LSTEP][(size_t)l * 32 + dir * 16 + g]);
        const double are = lre * dt, aim = lim * dt;
        float* pw = WSP(float, WS_POW) + it * 33 * 2;
        for (int k = 0; k <= 32; ++k) { const double x = aim * k, nrev = rint(x * 0.15915494309189535), r = x - nrev * 6.283185307179586; const float m = expf((float)(are * k));
            pw[2 * k] = m * cosf((float)r); pw[2 * k + 1] = m * sinf((float)r); }
        const double bre_ = (double)pw[2] - 1.0, bim_ = (double)pw[3];
        const double den = lre * lre + lim * lim, fre = (bre_ * lre + bim_ * lim) / den, fim = (bim_ * lre - bre_ * lim) / den;
        for (int q = 0; q < 16; ++q) {
            const size_t bi = ((size_t)l * 2048 + it) * 16 + q; const double br = p.in[I_BRE][bi], bm = p.in[I_BIM][bi];
            float* bb = WSP(float, WS_BBAR) + (it * 16 + q) * 2;
            bb[0] = (float)(fre * br - fim * bm); bb[1] = (float)(fre * bm + fim * br);
        }
    }
}
HD void ph_prep_b(const Params& p, int l, long tid, long nthr) {
    const float* POW = WSP(const float, WS_POW); const float* BB = WSP(const float, WS_BBAR);
    for (long it = tid; it < (long)2 * 16 * 32 * 256; it += nthr) {
        const int q = (int)(it & 15), pp = (int)(it >> 4) & 15, lag = (int)(it >> 8) & 31, g = (int)(it >> 13) & 15, dir = (int)(it >> 17);
        float s = 0.f;
        for (int n = 0; n < 64; ++n) {
            const size_t sn = (size_t)(dir * 16 + g) * 64 + n;
            const size_t ci = (((size_t)l * 2 + dir) * 16 + g) * 1024 + (size_t)pp * 64 + n;
            const float cr = p.in[I_CRE][ci], cim = p.in[I_CIM][ci];
            const float pr = POW[(sn * 33 + lag) * 2], pi = POW[(sn * 33 + lag) * 2 + 1];
            const float br = BB[(sn * 16 + q) * 2], bi = BB[(sn * 16 + q) * 2 + 1];
            const float tr = pr * br - pi * bi, ti = pr * bi + pi * br;
            s += cr * tr - cim * ti;
        }
        WSP(float, WS_KK)[it] = s;
    }
    for (long it = tid; it < (long)16 * 256 * 512; it += nthr) {
        const int col = (int)(it % 512), r1 = (int)(it / 512) % 256, g = (int)(it / (512 * 256));
        const int i = col >> 4, q = col & 15, dir = r1 >> 7, n = (r1 >> 1) & 63, reim = r1 & 1, k = dir ? i : (TCH - 1 - i);
        const size_t sn = (size_t)(dir * 16 + g) * 64 + n;
        const float pr = POW[(sn * 33 + k) * 2], pi = POW[(sn * 33 + k) * 2 + 1], br = BB[(sn * 16 + q) * 2], bi = BB[(sn * 16 + q) * 2 + 1];
        WSP(bf16_t, WS_BT1)[it] = f2bf(reim ? (pr * bi + pi * br) : (pr * br - pi * bi));
    }
    for (long it = tid; it < (long)16 * 512 * 256; it += nthr) {
        const int kc = (int)(it % 256), rr = (int)(it / 256) % 512, g = (int)(it / (256 * 512));
        const int j = rr >> 4, pp = rr & 15, dir = kc >> 7, n = (kc >> 1) & 63, reim = kc & 1, k = dir ? (TCH - j) : (j + 1);
        const size_t sn = (size_t)(dir * 16 + g) * 64 + n;
        const size_t ci = (((size_t)l * 2 + dir) * 16 + g) * 1024 + (size_t)pp * 64 + n;
        const float cr = p.in[I_CRE][ci], cim = p.in[I_CIM][ci], pr = POW[(sn * 33 + k) * 2], pi = POW[(sn * 33 + k) * 2 + 1];
        WSP(bf16_t, WS_BT2)[((size_t)g * 512 + rr) * KSS + 512 + kc] = f2bf(reim ? -(cr * pi + cim * pr) : (cr * pr - cim * pi));
    }
}
HD void ph_prep_c(const Params& p, int l, long tid, long nthr) {
    const float* KK = WSP(const float, WS_KK);
    for (long it = tid; it < (long)16 * 512 * 512; it += nthr) {
        const int cc = (int)(it % 512), rr = (int)(it / 512) % 512, g = (int)(it / (512 * 512));
        const int j = rr >> 4, pp = rr & 15, i = cc >> 4, q = cc & 15;
        float v = 0.f;
        if (j >= i) v += KK[((((size_t)0 * 16 + g) * 32 + (j - i)) * 16 + pp) * 16 + q];
        if (i >= j) v += KK[((((size_t)1 * 16 + g) * 32 + (i - j)) * 16 + pp) * 16 + q];
        if (i == j && pp == q) v += p.in[I_SSMD][(size_t)l * 256 + g * 16 + pp];
        WSP(bf16_t, WS_BT2)[((size_t)g * 512 + rr) * KSS + cc] = f2bf(v);
    }
}
HD void norm_row(const Params& p, int l, int row, const float* gain, int seg_sh, int seg_sc) {
    const float* x = xr_row(p, row); float ss = 0.f;
    for (int c = 0; c < DM; ++c) ss += x[c] * x[c];
    const float rinv = 1.f / sqrtf(ss / DM + RMS_EPS);
    const int bb = row_bb(row); const float* sh = mod_ptr(p, l, bb, seg_sh); const float* sc = mod_ptr(p, l, bb, seg_sc);
    bf16_t* h = WSP(bf16_t, WS_H) + (size_t)row * DM;
    for (int c = 0; c < DM; ++c) h[c] = f2bf(x[c] * rinv * gain[c] * (1.f + sc[c]) + sh[c]);
}
HD void ph_norm(const Params& p, int l, int which, int nrows, long tid, long nthr) {
    const float* gain = p.in[which == 1 ? I_N1G : I_N2G] + (size_t)l * DM;
    for (long r = tid; r < nrows; r += nthr) norm_row(p, l, (int)r, gain, which == 1 ? 0 : 3, which == 1 ? 1 : 4);
}
#if defined(HOST_EMU)
HD float q8e_(float x, float sc) { float v = x * sc, ax = fabsf(v); if (ax > 448.f) ax = 448.f; int ex; frexpf(ax, &ex); ex -= 1; if (ex < -6) ex = -6; const float q = ldexpf(1.f, ex - 3); ax = nearbyintf(ax / q) * q; return copysignf(ax, v) / sc; }
#endif
HD void diff_attn_sub(const Params& p, int row, int hh, int ds, int m, int b, int nk, float* o, float& lsum) {
    const bf16_t* Q = WSP(const bf16_t, WS_QD) + (size_t)row * 512 + hh * 128 + m * 64;
    const bf16_t* K = WSP(const bf16_t, WS_KD) + hh * 128 + m * 64; const bf16_t* V = WSP(const bf16_t, WS_VD) + hh * 128 + ds * 16;
    float q[64];
    UNROLL for (int d8 = 0; d8 < 8; ++d8) { const bf8 t = *(const bf8*)(Q + d8 * 8); UNROLL for (int e = 0; e < 8; ++e) q[d8 * 8 + e] = bf2f(t.v[e]); }
#if defined(HOST_EMU) && defined(EMU_FP8QK)
    for (int d = 0; d < 64; ++d) q[d] = q8e_(q[d], 16.f);
#endif
    float mx = -1e30f, ls = 0.f;
    UNROLL for (int j = 0; j < 16; ++j) o[j] = 0.f;
    for (int k = 0; k < nk; ++k) {
        const int kr = k < C_ ? NRL + b * C_ + k : b * L_ + (k - C_);
        const bf16_t* kp = K + (size_t)kr * 512; const bf16_t* vp = V + (size_t)kr * 512;
        float s = 0.f;
        UNROLL for (int d8 = 0; d8 < 8; ++d8) { const bf8 t = *(const bf8*)(kp + d8 * 8); UNROLL for (int e = 0; e < 8; ++e) {
#if defined(HOST_EMU) && defined(EMU_FP8QK)
            s += q[d8 * 8 + e] * q8e_(bf2f(t.v[e]), 4.f);
#else
            s += q[d8 * 8 + e] * bf2f(t.v[e]);
#endif
            } }
        if (s > mx) { const float sc = exp2f(mx - s); ls *= sc; UNROLL for (int j = 0; j < 16; ++j) o[j] *= sc; mx = s; }
        float pr = exp2f(s - mx); ls += pr;
#if defined(HOST_EMU) && defined(EMU_FP8PV)
        pr = q8e_(pr, 256.f);
        UNROLL for (int h8 = 0; h8 < 2; ++h8) { const bf8 t = *(const bf8*)(vp + h8 * 8); UNROLL for (int e = 0; e < 8; ++e) o[h8 * 8 + e] += pr * q8e_(bf2f(t.v[e]), 1.f); }
#else
        UNROLL for (int h8 = 0; h8 < 2; ++h8) { const bf8 t = *(const bf8*)(vp + h8 * 8); UNROLL for (int e = 0; e < 8; ++e) o[h8 * 8 + e] += pr * bf2f(t.v[e]); }
#endif
    }
    lsum = ls;
}
HD void diff_attn_item(const Params& p, int l, int row, int hh, int ds) {
    const bool isctx = row >= NRL; const int b = isctx ? (row - NRL) / C_ : row / L_;
    const int nk = isctx ? C_ : C_ + L_;
    float o0[16], o1[16], l0, l1;
    diff_attn_sub(p, row, hh, ds, 0, b, nk, o0, l0);
    diff_attn_sub(p, row, hh, ds, 1, b, nk, o1, l1);
    const float lam = WSP(const float, WS_LAMD)[l];
    bf16_t* y = WSP(bf16_t, WS_YD) + (size_t)row * 512 + hh * 128 + ds * 16;
    bf8 r0, r1;
    UNROLL for (int j = 0; j < 8; ++j) { r0.v[j] = f2bf(o0[j] / l0 - lam * o1[j] / l1); r1.v[j] = f2bf(o0[8 + j] / l0 - lam * o1[8 + j] / l1); }
    *(bf8*)y = r0; *(bf8*)(y + 8) = r1;
}
HD void diff_norm_item(const Params& p, int l, int row, int hh) {
    bf16_t* y = WSP(bf16_t, WS_YD) + (size_t)row * 512 + hh * 128; float ss = 0.f;
    for (int d = 0; d < 128; ++d) { const float v = bf2f(y[d]); ss += v * v; }
    const float lam_init = 0.8f - 0.6f * expf(-0.3f * (float)l);
    const float rinv = 1.f / sqrtf(ss / 128.f + RMS_EPS) * (1.f - lam_init);
    const float* sg = p.in[I_SUBLN] + (size_t)l * 128;
    for (int d = 0; d < 128; ++d) y[d] = f2bf(bf2f(y[d]) * rinv * sg[d]);
}
HD void na_attn_item(const Params& p, int l, int row, int hh, int ds) {
    const bool isctx = row >= NRL; const int b = isctx ? (row - NRL) / C_ : row / L_;
    const bf16_t* Q = WSP(const bf16_t, WS_QN) + (size_t)row * 256 + hh * 64;
    const bf16_t* K = WSP(const bf16_t, WS_KN); const bf16_t* V = WSP(const bf16_t, WS_VN);
    float q[64];
    UNROLL for (int d8 = 0; d8 < 8; ++d8) { const bf8 t = *(const bf8*)(Q + d8 * 8); UNROLL for (int e = 0; e < 8; ++e) q[d8 * 8 + e] = bf2f(t.v[e]); }
    const int nloc = isctx ? 0 : 128; const int nk = nloc + C_;
    int r = 0, c = 0, rs = 0, cs = 0;
    if (!isctx) { const int t = row % L_; r = t / GRW; c = t % GRW; const int kh = GRR < 8 ? GRR : 8; rs = r - kh / 2; if (rs < 0) rs = 0; if (rs > GRR - kh) rs = GRR - kh; cs = c - 8; if (cs < 0) cs = 0; if (cs > GRW - 16) cs = GRW - 16; }
    const float* rpb = p.in[I_RPB] + ((size_t)l * 4 + hh) * 15 * 31;
    float o[16], mx = -1e30f, ls = 0.f;
    UNROLL for (int j = 0; j < 16; ++j) o[j] = 0.f;
    for (int k = 0; k < nk; ++k) {
        int kr; float bias = 0.f;
        if (k < nloc) { const int krr = rs + (k >> 4), kc = cs + (k & 15); kr = b * L_ + krr * GRW + kc;
            int dc = kc - c + 15; if (dc < 0) dc = 0; if (dc > 30) dc = 30; bias = rpb[(krr - r + 7) * 31 + dc] * LOG2E; }
        else kr = NRL + b * C_ + (k - nloc);
        const bf16_t* kp = K + (size_t)kr * 256 + hh * 64; const bf16_t* vp = V + (size_t)kr * 256 + hh * 64 + ds * 16;
        float s = bias;
        UNROLL for (int d8 = 0; d8 < 8; ++d8) { const bf8 t = *(const bf8*)(kp + d8 * 8); UNROLL for (int e = 0; e < 8; ++e) {
#if defined(HOST_EMU) && defined(EMU_FP8QK)
            s += q[d8 * 8 + e] * q8e_(bf2f(t.v[e]), 4.f);
#else
            s += q[d8 * 8 + e] * bf2f(t.v[e]);
#endif
            } }
        if (s > mx) { const float sc = exp2f(mx - s); ls *= sc; UNROLL for (int j = 0; j < 16; ++j) o[j] *= sc; mx = s; }
        float pr = exp2f(s - mx); ls += pr;
#if defined(HOST_EMU) && defined(EMU_FP8PV)
        pr = q8e_(pr, 256.f);
        UNROLL for (int h8 = 0; h8 < 2; ++h8) { const bf8 t = *(const bf8*)(vp + h8 * 8); UNROLL for (int e = 0; e < 8; ++e) o[h8 * 8 + e] += pr * q8e_(bf2f(t.v[e]), 1.f); }
#else
        UNROLL for (int h8 = 0; h8 < 2; ++h8) { const bf8 t = *(const bf8*)(vp + h8 * 8); UNROLL for (int e = 0; e < 8; ++e) o[h8 * 8 + e] += pr * bf2f(t.v[e]); }
#endif
    }
    bf16_t* y = WSP(bf16_t, WS_YN) + (size_t)row * 256 + hh * 64 + ds * 16;
    bf8 o0, o1;
    UNROLL for (int j = 0; j < 8; ++j) { o0.v[j] = f2bf(o[j] / ls); o1.v[j] = f2bf(o[8 + j] / ls); }
    *(bf8*)y = o0; *(bf8*)(y + 8) = o1;
}
HD void ph_diff_naive(const Params& p, int l, long tid, long nthr) {
    const int nrows = (l == 0) ? NR : NRL;
    for (long it = tid; it < (long)nrows * 32; it += nthr) diff_attn_item(p, l, (int)(it >> 5), (int)(it >> 3) & 3, (int)(it & 7));
}
HD void ph_na_naive(const Params& p, int l, long tid, long nthr) {
    const int nrows = (l == 0) ? NR : NRL;
    for (long it = tid; it < (long)nrows * 16; it += nthr) na_attn_item(p, l, (int)(it >> 4), (int)(it >> 2) & 3, (int)(it & 3));
}
HD void ph_attn_naive(const Params& p, int l, long tid, long nthr) { ph_diff_naive(p, l, tid, nthr); ph_na_naive(p, l, tid, nthr); }
HD void ph_diff_norm(const Params& p, int l, long tid, long nthr) {
    const int nrows = (l == 0) ? NR : NRL;
    for (long it = tid; it < (long)nrows * 4; it += nthr) diff_norm_item(p, l, (int)(it >> 2), (int)(it & 3));
}
HD void ph_ssm1_naive(const Params& p, long tid, long nthr) {
    for (int g = 0; g < 16; ++g) { EpiSsm1 e{p, g};
        naive_gemm(WSP(const bf16_t, WS_ASSM) + (size_t)g * NCH * KSS, KSS, WSP(const bf16_t, WS_BT1) + (size_t)g * 256 * 512, 512, NCH, 256, 512, e, tid, nthr); }
}
HD void ph_ssm_carry(const Params& p, long tid, long nthr) {
    for (long it = tid; it < (long)B_ * 16 * 2 * 64; it += nthr) {
        const int n = (int)(it & 63), dir = (int)(it >> 6) & 1, g = (int)(it >> 7) & 15, b = (int)(it >> 11);
        const size_t sn = (size_t)(dir * 16 + g) * 64 + n;
        const float lr = WSP(const float, WS_POW)[(sn * 33 + 32) * 2], li = WSP(const float, WS_POW)[(sn * 33 + 32) * 2 + 1];
        float sr = 0.f, si = 0.f;
        const int nsteps = CCH + LCH;
        for (int s = 0; s < nsteps; ++s) {
            int chunk;
            if (dir == 0) chunk = s < CCH ? NRL / TCH + b * CCH + s : b * LCH + (s - CCH);
            else chunk = s < CCH ? NRL / TCH + b * CCH + (CCH - 1 - s) : b * LCH + (LCH - 1 - (s - CCH));
            bf16_t* d = WSP(bf16_t, WS_ASSM) + ((size_t)(g * NCH + chunk)) * KSS + 512 + dir * 128 + n * 2;
            d[0] = f2bf(sr); d[1] = f2bf(si);
            const float* sl = WSP(const float, WS_SLOC) + ((size_t)(g * NCH + chunk)) * 256 + dir * 128 + n * 2;
            const float nr = lr * sr - li * si + sl[0], ni = lr * si + li * sr + sl[1];
            sr = nr; si = ni;
        }
    }
}
HD void ph_ssm2_naive(const Params& p, long tid, long nthr) {
    for (int g = 0; g < 16; ++g) { EpiSsm2 e{p, g};
        naive_gemm(WSP(const bf16_t, WS_ASSM) + (size_t)g * NCH * KSS, KSS, WSP(const bf16_t, WS_BT2) + (size_t)g * 512 * KSS, KSS, NCH, 512, KSS, e, tid, nthr); }
}
HD unsigned ord_key(float v) { const unsigned u = f2u(v); return (u & 0x80000000u) ? ~u : (u | 0x80000000u); }
HD float ord_val(unsigned k) { const unsigned u = (k & 0x80000000u) ? (k & 0x7fffffffu) : ~k; return u2f(u); }
#define TK_INSERT(L, x) do { unsigned x_ = (x); UNROLL for (int j_ = 0; j_ < 16; ++j_) { const unsigned hi_ = L[j_] > x_ ? L[j_] : x_; x_ = L[j_] > x_ ? x_ : L[j_]; L[j_] = hi_; } } while (0)
template <int K, int J> HD void bitonic_stage16(unsigned* v) {
    UNROLL for (int i = 0; i < 16; ++i) { const int l = i ^ J; if (l > i) { const bool desc = ((i & K) == 0); const unsigned a = v[i], b = v[l]; const unsigned hi = a > b ? a : b, lo = a > b ? b : a; v[i] = desc ? hi : lo; v[l] = desc ? lo : hi; } }
}
HD void bitonic_sort16(unsigned* v) {
    bitonic_stage16<2, 1>(v);
    bitonic_stage16<4, 2>(v); bitonic_stage16<4, 1>(v);
    bitonic_stage16<8, 4>(v); bitonic_stage16<8, 2>(v); bitonic_stage16<8, 1>(v);
    bitonic_stage16<16, 8>(v); bitonic_stage16<16, 4>(v); bitonic_stage16<16, 2>(v); bitonic_stage16<16, 1>(v);
}
HD void top16_merge(unsigned* R, const unsigned* G) {
    UNROLL for (int i = 0; i < 16; ++i) { const unsigned g = G[15 - i]; R[i] = R[i] > g ? R[i] : g; }
    bitonic_stage16<16, 8>(R); bitonic_stage16<16, 4>(R); bitonic_stage16<16, 2>(R); bitonic_stage16<16, 1>(R);
}
HD void topk_item(const Params& p, int row, int h) {
    float sv[2][16]; unsigned long long ilo[2], ihi[2];
    {
        unsigned L0[16], L1[16];
        const bf16_t* s0 = WSP(const bf16_t, WS_SC) + ((size_t)(row >> 6) * 2048 + (h * 2) * 128) * 64 + (row & 63); const bf16_t* s1 = s0 + 128 * 64;
        float c0_[16], c1_[16], n0_[16], n1_[16];
        UNROLL for (int k = 0; k < 16; ++k) { c0_[k] = bf2f(s0[k * 64]); c1_[k] = bf2f(s1[k * 64]); }
        for (int n0 = 0; n0 < 128; n0 += 16) { unsigned G0[16], G1[16];
            if (n0 + 16 < 128) { UNROLL for (int k = 0; k < 16; ++k) { n0_[k] = bf2f(s0[(n0 + 16 + k) * 64]); n1_[k] = bf2f(s1[(n0 + 16 + k) * 64]); } }
            UNROLL for (int k = 0; k < 16; ++k) { G0[k] = (ord_key(c0_[k]) & ~127u) | (unsigned)(127 - (n0 + k)); G1[k] = (ord_key(c1_[k]) & ~127u) | (unsigned)(127 - (n0 + k)); }
            bitonic_sort16(G0); bitonic_sort16(G1);
            if (n0 == 0) { UNROLL for (int k = 0; k < 16; ++k) { L0[k] = G0[k]; L1[k] = G1[k]; } } else { top16_merge(L0, G0); top16_merge(L1, G1); }
            UNROLL for (int k = 0; k < 16; ++k) { c0_[k] = n0_[k]; c1_[k] = n1_[k]; } }
        unsigned long long lo = 0ull, hi = 0ull;
        UNROLL for (int j = 0; j < 16; ++j) { const unsigned long long id = (unsigned long long)(127u - (L0[j] & 127u)); if (j < 8) lo |= id << (8 * j); else hi |= id << (8 * (j - 8)); sv[0][j] = ord_val(L0[j] & ~127u); }
        ilo[0] = lo; ihi[0] = hi; lo = 0ull; hi = 0ull;
        UNROLL for (int j = 0; j < 16; ++j) { const unsigned long long id = (unsigned long long)(127u - (L1[j] & 127u)); if (j < 8) lo |= id << (8 * j); else hi |= id << (8 * (j - 8)); sv[1][j] = ord_val(L1[j] & ~127u); }
        ilo[1] = lo; ihi[1] = hi;
    }
    unsigned Lc[16]; UNROLL for (int j = 0; j < 16; ++j) Lc[j] = 0u;
    UNROLL for (int a = 0; a < 16; ++a) UNROLL for (int b = 0; b < 16; ++b) if ((a + 1) * (b + 1) <= 16) {
        const unsigned key = (ord_key(sv[0][a] + sv[1][b]) & ~255u) | (unsigned)(255 - (a * 16 + b)); TK_INSERT(Lc, key); }
    float best[16], mx = -1e30f; unsigned e[16];
    UNROLL for (int j = 0; j < 16; ++j) { best[j] = ord_val(Lc[j] & ~255u); if (best[j] > mx) mx = best[j]; const unsigned pos = 255u - (Lc[j] & 255u), a = pos >> 4, b = pos & 15u;
        const unsigned ia = (unsigned)(((a & 8u) ? ihi[0] : ilo[0]) >> (8u * (a & 7u))) & 0xffu, ib = (unsigned)(((b & 8u) ? ihi[1] : ilo[1]) >> (8u * (b & 7u))) & 0xffu;
        e[j] = ia * 128u + ib; }
    float sum = 0.f; UNROLL for (int j = 0; j < 16; ++j) { best[j] = expf(best[j] - mx); sum += best[j]; }
    UNROLL for (int j = 0; j < 16; ++j) { const int hk = h * 16 + j, pos = (hk & 7) * 16 + (hk >> 3); WSP(unsigned short, WS_EIDX)[(size_t)row * 128 + pos] = (unsigned short)e[j]; WSP(float, WS_GW)[(size_t)row * 128 + pos] = best[j] / sum; }
}
HD void ph_topk(const Params& p, int nrows, long tid, long nthr) { for (long it = tid; it < (long)nrows * 8; it += nthr) topk_item(p, (int)(it % nrows), (int)(it / nrows)); }
HD void ph_tables(const Params& p, int l, long tid, long nthr) {
    const long n8 = (long)16384 * 1024 / 8;
    for (long it = tid; it < 2 * n8; it += nthr) {
        const int w = it >= n8; const long i = it - (w ? n8 : 0);
        const float* src = p.in[w ? I_PV : I_PU] + (size_t)l * 16384 * 1024 + i * 8; bf8 o;
#ifdef EMU_FP8
        for (int e = 0; e < 8; ++e) { const float sc = w ? 16.f : 256.f; float x = src[e] * sc, ax = fabsf(x); if (ax > 448.f) ax = 448.f;
            int ex; frexpf(ax, &ex); ex -= 1; if (ex < -6) ex = -6; const float q = ldexpf(1.f, ex - 3); ax = nearbyintf(ax / q) * q; o.v[e] = f2bf(copysignf(ax, x) / sc); }
#else
        for (int e = 0; e < 8; ++e) o.v[e] = f2bf(src[e]);
#endif
        *(bf8*)(WSP(bf16_t, w ? WS_VT : WS_UT) + i * 8) = o;
    }
}
HD void ph_peer_act_naive(const Params& p, int nrows, long tid, long nthr) {
    for (long it = tid; it < (long)nrows * 128; it += nthr) {
        const int row = (int)(it >> 7); const int e = WSP(const unsigned short, WS_EIDX)[it];
        const bf16_t* u = WSP(const bf16_t, WS_UT) + (size_t)e * 1024; const bf16_t* h = WSP(const bf16_t, WS_H) + (size_t)row * DM;
        float s = 0.f; for (int d = 0; d < DM; ++d) s += bf2f(u[d]) * bf2f(h[d]);
        WSP(float, WS_GW)[it] *= gelu_tanh(s);
    }
}
HD void ph_peer_out_naive(const Params& p, int l, int nrows, long tid, long nthr) {
    for (long it = tid; it < (long)nrows * 256; it += nthr) {
        const int row = (int)(it >> 8), c = (int)(it & 255) * 4; float o[4] = {0.f, 0.f, 0.f, 0.f};
        for (int hk = 0; hk < 128; ++hk) { const int e = WSP(const unsigned short, WS_EIDX)[(size_t)row * 128 + hk]; const float w = WSP(const float, WS_GW)[(size_t)row * 128 + hk];
            const bf16_t* v = WSP(const bf16_t, WS_VT) + (size_t)e * 1024 + c; for (int j = 0; j < 4; ++j) o[j] += w * bf2f(v[j]); }
        float* x = xr_row(p, row) + c; const float* g2 = mod_ptr(p, l, row_bb(row), 5) + c;
        for (int j = 0; j < 4; ++j) x[j] += g2[j] * o[j];
    }
}
HD void ph_final_norm(const Params& p, long tid, long nthr) {
    for (long r = tid; r < NRL; r += nthr) { float* x = p.out + (size_t)r * DM; float ss = 0.f; for (int c = 0; c < DM; ++c) ss += x[c] * x[c];
        const float rinv = 1.f / sqrtf(ss / DM + RMS_EPS); for (int c = 0; c < DM; ++c) x[c] = x[c] * rinv * p.in[I_FNG][c]; }
}


#if defined(HOST_EMU) && defined(EMU_FP8G)
HD float q8_(float x, float sc) { float v = x * sc, ax = fabsf(v); if (ax > 448.f) ax = 448.f; int ex; frexpf(ax, &ex); ex -= 1; if (ex < -6) ex = -6; const float q = ldexpf(1.f, ex - 3); ax = nearbyintf(ax / q) * q; return copysignf(ax, v) / sc; }
#ifndef EMU_QCOL
#define EMU_QCOL(c) ((c) >= 2560)
#endif
struct EpiWinGE { Params p; const bf16_t* Hq;
    HD void operator()(int row, int c0, const float* a, const float* b) const { EpiWin e{p}; if (EMU_QCOL(c0)) e.one(row, c0, a, b, true); if (EMU_QCOL(c0 + 16)) e.one(row, c0 + 16, b, a, false); } };
static bf16_t* g_emu_tmp = nullptr;
#define EMU_FP8G_STEP
#define EMU_FP8G_AFTER(BAR) { bf16_t* Hq = g_emu_tmp; bf16_t* Wq = g_emu_tmp + (size_t)NR * DM; \
        for (long i = tid; i < (long)NR * DM; i += nthr) Hq[i] = f2bf(q8_(bf2f(WSP(const bf16_t, WS_H)[i]), 1.f)); \
        for (long i = tid; i < (long)INW * DM; i += nthr) Wq[i] = f2bf(q8_(bf2f(WSP(const bf16_t, WS_WIN)[i]), 256.f)); \
        BAR(); \
        { EpiWinGE e{p, Hq}; naive_gemm(Hq, DM, Wq, DM, NR, INW, DM, e, tid, nthr); } BAR(); }
#else
#define EMU_FP8G_STEP
#define EMU_FP8G_AFTER(BAR)
#endif
#if defined(HOST_EMU) && defined(EMU_FP8WO)
#define EMU_FP8WO_STEP(BAR) { for (long i = tid; i < (long)nact * DM; i += nthr) WSP(bf16_t, WS_MB)[i] = f2bf(q8e_(bf2f(WSP(const bf16_t, WS_MB)[i]), 4.f)); \
        for (long i = tid; i < (long)DM * DM; i += nthr) WSP(bf16_t, WS_WOUT)[i] = f2bf(q8e_(bf2f(WSP(const bf16_t, WS_WOUT)[i]), 256.f)); BAR(); }
#else
#define EMU_FP8WO_STEP(BAR)
#endif
#define NAIVE_PROGRAM(BAR) \
    ph_copy_x(p, tid, nthr); ph_mod(p, tid, nthr); BAR(); \
    for (int l = 0; l < DEPTH; ++l) { \
        const int nact = (l == 0) ? NR : NRL; \
        ph_prep_a(p, l, tid, nthr); ph_norm(p, l, 1, NR, tid, nthr); BAR(); \
        ph_prep_b(p, l, tid, nthr); BAR(); \
        ph_prep_c(p, l, tid, nthr); \
        EMU_FP8G_STEP \
        { EpiWin e{p}; naive_gemm(WSP(const bf16_t, WS_H), DM, WSP(const bf16_t, WS_WIN), DM, NR, INW, DM, e, tid, nthr); } BAR(); \
        EMU_FP8G_AFTER(BAR) \
        ph_ssm1_naive(p, tid, nthr); ph_attn_naive(p, l, tid, nthr); BAR(); \
        ph_ssm_carry(p, tid, nthr); ph_diff_norm(p, l, tid, nthr); BAR(); \
        ph_ssm2_naive(p, tid, nthr); BAR(); \
        { EpiGlu e{p}; naive_gemm(WSP(const bf16_t, WS_YG), 256, WSP(const bf16_t, WS_WGLU), 256, nact, 512, 256, e, tid, nthr); } BAR(); \
        { EpiMerge e{p, WS_SGS, false}; naive_gemm(WSP(const bf16_t, WS_YS), 256, WSP(const bf16_t, WS_WBS), 256, nact, DM, 256, e, tid, nthr); } BAR(); \
        { EpiMerge e{p, WS_SGD, true}; naive_gemm(WSP(const bf16_t, WS_YD), 512, WSP(const bf16_t, WS_WBD), 512, nact, DM, 512, e, tid, nthr); } BAR(); \
        { EpiMerge e{p, WS_SGN, true}; naive_gemm(WSP(const bf16_t, WS_YN), 256, WSP(const bf16_t, WS_WBN), 256, nact, DM, 256, e, tid, nthr); } BAR(); \
        EMU_FP8WO_STEP(BAR) \
        { EpiWout e{p, l}; naive_gemm(WSP(const bf16_t, WS_MB), DM, WSP(const bf16_t, WS_WOUT), DM, nact, DM, DM, e, tid, nthr); } BAR(); \
        ph_norm(p, l, 2, nact, tid, nthr); ph_tables(p, l, tid, nthr); BAR(); \
        { EpiScore e{p}; naive_gemm(WSP(const bf16_t, WS_H), DM, WSP(const bf16_t, WS_WSC), DM, nact, 2048, DM, e, tid, nthr); } BAR(); \
        ph_topk(p, nact, tid, nthr); BAR(); \
        ph_peer_act_naive(p, nact, tid, nthr); BAR(); \
        ph_peer_out_naive(p, l, nact, tid, nthr); BAR(); \
    } \
    ph_final_norm(p, tid, nthr);

#ifndef HOST_EMU
#define XB_TMO      128
#define XB_XCNT(j)  (256  + 64 * (j))
#define XB_XSUB(j)  (1280 + 64 * (j))
#define XB_XGEN(j)  (2304 + 64 * (j))
#define XB_TOP      3328
#define XB_TOPGEN   3392
#define XCD_BAR_WORDS 3456
#define XB_SPIN_CAP (1u << 26)
#define LAS __attribute__((address_space(3)))
__device__ __forceinline__ unsigned xb_ld(unsigned* p)              { return __hip_atomic_load(p, __ATOMIC_RELAXED, __HIP_MEMORY_SCOPE_AGENT); }
__device__ __forceinline__ unsigned xb_add(unsigned* p, unsigned v) { return __hip_atomic_fetch_add(p, v, __ATOMIC_RELAXED, __HIP_MEMORY_SCOPE_AGENT); }
__device__ __forceinline__ unsigned xb_xcc_id() { return (unsigned)__builtin_amdgcn_s_getreg((3 << 11) | 20) & 0xFu; }
#define XB_SPIN(cond, bar) do { unsigned _sp = 0; while (cond) { __builtin_amdgcn_s_sleep(1); \
    if ((++_sp & 255u) == 0u) { if (xb_ld(&(bar)[XB_TMO])) break; if (_sp > XB_SPIN_CAP) { atomicAdd(&(bar)[XB_TMO], 1u); break; } } } } while (0)
struct XcdBarrier { unsigned* bar; unsigned x; volatile LAS unsigned* st; };
__device__ __forceinline__ float shx(float v, int mask, int lane) { return __int_as_float(__builtin_amdgcn_ds_bpermute((lane ^ mask) << 2, __float_as_int(v))); }
__device__ __forceinline__ int tid_of(int wave_s) { int l_; asm volatile("v_mbcnt_lo_u32_b32 %0, -1, 0\n\tv_mbcnt_hi_u32_b32 %0, -1, %0" : "=v"(l_)); return wave_s * 64 + l_; }
__device__ __forceinline__ XcdBarrier xcd_barrier_post(unsigned* bar, volatile LAS unsigned* st, int tid0) {
    XcdBarrier b; b.bar = bar; b.x = xb_xcc_id(); b.st = st;
    if (tid0 == 0) (void)xb_add(&bar[XB_XCNT(b.x)], 1u);
    return b;
}
__device__ __forceinline__ void xcd_barrier_complete(unsigned* bar, unsigned x, unsigned& nloc, unsigned& nx) {
    const unsigned G = gridDim.x * gridDim.y * gridDim.z;
    unsigned sum, cnt, mine, sp = 0u;
    for (;;) {
        sum = 0u; cnt = 0u; mine = 0u;
#pragma unroll
        for (unsigned j = 0; j < 16; ++j) { const unsigned c = xb_ld(&bar[XB_XCNT(j)]); sum += c; cnt += (c > 0u) ? 1u : 0u; mine = (j == x) ? c : mine; }
        if (sum == G) break;
        __builtin_amdgcn_s_sleep(1);
        if ((++sp & 255u) == 0u) { if (xb_ld(&bar[XB_TMO])) break; if (sp > XB_SPIN_CAP) { atomicAdd(&bar[XB_TMO], 1u); break; } }
    }
    nloc = mine > 0u ? mine : 1u; nx = cnt > 0u ? cnt : 1u;
}
__device__ __forceinline__ void xcd_barrier(const XcdBarrier& b, int tid0) {
    asm volatile("s_waitcnt vmcnt(0)" ::: "memory");
    __syncthreads();
    if (tid0 == 0) {
        unsigned* bar = b.bar;
        __builtin_amdgcn_s_waitcnt(0);
        unsigned nloc = b.st[0], nx = b.st[1];
        if (nloc == 0u) { xcd_barrier_complete(bar, b.x, nloc, nx); b.st[0] = nloc; b.st[1] = nx; }
        const unsigned old = xb_add(&bar[XB_XSUB(b.x)], 1u);
        const unsigned gen = old / nloc;
        if (old + 1u == (gen + 1u) * nloc) {
            __builtin_amdgcn_fence(__ATOMIC_RELEASE, "agent");
            asm volatile("s_waitcnt vmcnt(0)" ::: "memory");
            const unsigned og = xb_add(&bar[XB_TOP], 1u);
            const unsigned tg = og / nx;
            if (og + 1u == (tg + 1u) * nx) xb_add(&bar[XB_TOPGEN], 1u);
            else XB_SPIN(xb_ld(&bar[XB_TOPGEN]) == tg, bar);
            __builtin_amdgcn_fence(__ATOMIC_ACQUIRE, "agent");
            xb_add(&bar[XB_XGEN(b.x)], 1u);
            asm volatile("s_waitcnt vmcnt(0)" ::: "memory");
        } else {
            XB_SPIN(xb_ld(&bar[XB_XGEN(b.x)]) == gen, bar);
            __builtin_amdgcn_fence(__ATOMIC_ACQUIRE, "agent");
            asm volatile("s_waitcnt vmcnt(0)" ::: "memory");
        }
    }
    __syncthreads();
}


namespace pg8 {
#define PG8_LAS __attribute__((address_space(3)))
typedef unsigned short bf16_t;
typedef short bf16x8 __attribute__((ext_vector_type(8)));
typedef float f32x4 __attribute__((ext_vector_type(4)));
typedef unsigned u32x4 __attribute__((ext_vector_type(4)));
constexpr int BM = 256, BK = 64, HALF = 128, HTB = HALF * BK * 2  , STAGE_BYTES = 8 * HTB, NXCD = 8, WGM = 8;

__host__ __device__ __forceinline__ int lds_byte(int r, int c) { const int st = (r >> 4) * 2 + (c >> 5), rr = r & 15, cc = c & 31, ob = rr * 64 + cc * 2; return st * 1024 + (ob ^ (((ob >> 9) & 1) << 5)); }
__host__ __device__ __forceinline__ void stage_rc(int b, int& R, int& C) { const int st = b / 1024, sb = b % 1024, swz = sb ^ (((sb >> 9) & 1) << 5); R = (st >> 1) * 16 + swz / 64; C = (st & 1) * 32 + (swz % 64) / 2; }
__host__ __device__ __forceinline__ int perm32(int rho) { const int n = rho >> 4, i = rho & 15; return 8 * (i >> 2) + 4 * n + (i & 3); }

struct Unit { int pm, pn, g; long arow, brow, bcol; };
struct Gemm { const bf16_t* A; const bf16_t* Bt; int lda, ldb, K; };

template <class Epi, class Sched, bool ALIGN_EPI = false, bool SP2 = false, bool FP8 = false>
__device__ __forceinline__ void gemm_phase(PG8_LAS unsigned char* lds, const Gemm g, const Sched& S, const Epi& E, int tid_in) {
    int tid_ = tid_in; asm volatile("" : "+v"(tid_));
    const int tid = tid_, wid = __builtin_amdgcn_readfirstlane(tid >> 6), lane = tid & 63, wr = wid >> 2, wc = wid & 3, fr = lane & 15, fq = lane >> 4;
    const int K = g.K, nt = K / BK;
    struct VOff { unsigned v; size_t step; } voffA, voffB;
    { int R, C; stage_rc(tid * 16, R, C); const int Rb = Epi::PERM ? ((R & ~31) + perm32(R & 31)) : R;
      voffA.v = (unsigned)(R * g.lda + C) * 2u; voffB.v = (unsigned)(Rb * g.ldb + C) * 2u; voffA.step = (size_t)64 * g.lda * 2; voffB.step = (size_t)64 * g.ldb * 2; }
    const size_t kstep = (size_t)(BK * 2);
    const size_t hstepA = (size_t)HALF * g.lda * 2, hstepB = (size_t)HALF * g.ldb * 2;
    const unsigned ldsw = (unsigned)wid * 1024u;
    const int aoff = lds_byte(wr * 64 + fr, fq * 8), boff = lds_byte(wc * 32 + fr, fq * 8);
#define PG8_SA(b, h) (((b) * 2 + (h)) * HTB)
#define PG8_SB(b, h) ((4 + (b) * 2 + (h)) * HTB)
#define PG8_STAGE(bufoff, gbase, voff) do { _Pragma("unroll") for (int _i = 0; _i < 2; ++_i) \
        __builtin_amdgcn_global_load_lds((const unsigned*)((const char*)(gbase) + _i * (voff).step + (voff).v), (PG8_LAS unsigned*)(lds + (bufoff) + ldsw + _i * 8192), 16, 0, 0); } while (0)
#define PG8_LDA(dst, b, h) do { _Pragma("unroll") for (int m = 0; m < 4; ++m) _Pragma("unroll") for (int k = 0; k < 2; ++k) dst[m][k] = *(const PG8_LAS bf16x8*)(lds + PG8_SA(b, h) + aoff + m * 2048 + k * 1024); } while (0)
#define PG8_LDB(dst, b, h) do { _Pragma("unroll") for (int n = 0; n < 2; ++n) _Pragma("unroll") for (int k = 0; k < 2; ++k) dst[n][k] = *(const PG8_LAS bf16x8*)(lds + PG8_SB(b, h) + boff + n * 2048 + k * 1024); } while (0)
#define PG8_MMA(ai, bj, At, Bt) do { __builtin_amdgcn_s_setprio(1); \
        if constexpr (FP8) { _Pragma("unroll") for (int m = 0; m < 4; ++m) _Pragma("unroll") for (int n = 0; n < 2; ++n) { \
            typedef int i32x8_ __attribute__((ext_vector_type(8))); typedef int i32x4_ __attribute__((ext_vector_type(4))); \
            const i32x8_ fa_ = __builtin_shufflevector(__builtin_bit_cast(i32x4_, Bt[n][0]), __builtin_bit_cast(i32x4_, Bt[n][1]), 0, 1, 2, 3, 4, 5, 6, 7); \
            const i32x8_ fb_ = __builtin_shufflevector(__builtin_bit_cast(i32x4_, At[m][0]), __builtin_bit_cast(i32x4_, At[m][1]), 0, 1, 2, 3, 4, 5, 6, 7); \
            acc[ai][bj][m][n] = __builtin_amdgcn_mfma_scale_f32_16x16x128_f8f6f4(fa_, fb_, acc[ai][bj][m][n], 0, 0, 0, 0x7b7b7b7b, 0, 0x7b7b7b7b); } } \
        else { _Pragma("unroll") for (int m = 0; m < 4; ++m) _Pragma("unroll") for (int n = 0; n < 2; ++n) _Pragma("unroll") for (int k = 0; k < 2; ++k) \
            acc[ai][bj][m][n] = __builtin_amdgcn_mfma_f32_16x16x32_bf16(Bt[n][k], At[m][k], acc[ai][bj][m][n], 0, 0, 0); } \
        __builtin_amdgcn_s_setprio(0); } while (0)
#define PG8_WAIT_V(n) asm volatile("s_waitcnt vmcnt(" #n ")" ::: "memory")
#define PG8_WAIT_L(n) asm volatile("s_waitcnt lgkmcnt(" #n ")" ::: "memory")
#define PG8_BAR __builtin_amdgcn_s_barrier()
#define PG8_SCHED __builtin_amdgcn_sched_barrier(0)
    Unit cur, nxt; int ui = 0;
    if (!S.next(0, cur)) return;
    f32x4 acc[2][2][4][2];
#pragma unroll
    for (int a = 0; a < 2; ++a)
#pragma unroll
        for (int b = 0; b < 2; ++b)
#pragma unroll
            for (int m = 0; m < 4; ++m)
#pragma unroll
                for (int n = 0; n < 2; ++n) acc[a][b][m][n] = (f32x4){0.f, 0.f, 0.f, 0.f};
    bf16x8 At[4][2], B0[2][2], B1[2][2];
    const char* cA = (const char*)g.A + (size_t)cur.arow * g.lda * 2; const char* cB = (const char*)g.Bt + ((size_t)cur.brow * g.ldb + cur.bcol) * 2;
    S.a_ready(cur);
    if constexpr (SP2) {
        PG8_STAGE(PG8_SB(0, 0), cB, voffB); PG8_STAGE(PG8_SB(0, 1), cB + hstepB, voffB); PG8_STAGE(PG8_SA(0, 0), cA, voffA); PG8_STAGE(PG8_SA(0, 1), cA + hstepA, voffA);
        if (wr == 1) PG8_BAR;
        PG8_WAIT_V(2); PG8_BAR;
        PG8_STAGE(PG8_SB(1, 0), cB + kstep, voffB); PG8_STAGE(PG8_SA(1, 0), cA + kstep, voffA); PG8_STAGE(PG8_SB(1, 1), cB + hstepB + kstep, voffB);
        PG8_WAIT_V(6); PG8_BAR;
    } else {
        PG8_STAGE(PG8_SB(0, 0), cB, voffB); PG8_STAGE(PG8_SA(0, 0), cA, voffA); PG8_STAGE(PG8_SB(0, 1), cB + hstepB, voffB); PG8_STAGE(PG8_SA(0, 1), cA + hstepA, voffA);
        if (wr == 1) PG8_BAR;
        PG8_WAIT_V(4); PG8_BAR;
        PG8_STAGE(PG8_SB(1, 0), cB + kstep, voffB); PG8_STAGE(PG8_SA(1, 0), cA + kstep, voffA); PG8_STAGE(PG8_SB(1, 1), cB + hstepB + kstep, voffB);
        PG8_WAIT_V(6); PG8_BAR;
    }
    for (;;) {
        const bool has_next = S.next(ui + 1, nxt);
        const char* nA = has_next ? (const char*)g.A + (size_t)nxt.arow * g.lda * 2 : cA; const char* nB = has_next ? (const char*)g.Bt + ((size_t)nxt.brow * g.ldb + nxt.bcol) * 2 : cB;
#pragma nounroll
        for (int t = 0; t < nt; t += 2) {
            const bool last = (t == nt - 2);
            const char* a1 = cA + (size_t)(t + 1) * kstep;
            const char* a2 = last ? nA : cA + (size_t)(t + 2) * kstep; const char* b2 = last ? nB : cB + (size_t)(t + 2) * kstep;
            const char* a3 = a2 + kstep; const char* b3 = b2 + kstep;
            if (last && has_next) S.a_ready(nxt);
            if constexpr (SP2) {
            PG8_LDB(B0, 0, 0); PG8_LDB(B1, 0, 1); PG8_SCHED; PG8_LDA(At, 0, 0); PG8_STAGE(PG8_SA(1, 1), a1 + hstepA, voffA);
            PG8_WAIT_V(8); PG8_WAIT_L(0); PG8_BAR; PG8_MMA(0, 0, At, B0); PG8_MMA(0, 1, At, B1); PG8_BAR; PG8_SCHED;
            PG8_LDA(At, 0, 1); PG8_STAGE(PG8_SB(0, 0), b2, voffB); PG8_STAGE(PG8_SB(0, 1), b2 + hstepB, voffB); PG8_STAGE(PG8_SA(0, 0), a2, voffA);
            PG8_WAIT_V(8); PG8_WAIT_L(0); PG8_BAR; PG8_MMA(1, 0, At, B0); PG8_MMA(1, 1, At, B1); PG8_BAR; PG8_SCHED;
            PG8_LDB(B0, 1, 0); PG8_LDB(B1, 1, 1); PG8_SCHED; PG8_LDA(At, 1, 0); PG8_STAGE(PG8_SA(0, 1), a2 + hstepA, voffA);
            PG8_WAIT_V(8); PG8_WAIT_L(0); PG8_BAR; PG8_MMA(0, 0, At, B0); PG8_MMA(0, 1, At, B1); PG8_BAR; PG8_SCHED;
            PG8_LDA(At, 1, 1); PG8_STAGE(PG8_SB(1, 0), b3, voffB); PG8_STAGE(PG8_SB(1, 1), b3 + hstepB, voffB); PG8_STAGE(PG8_SA(1, 0), a3, voffA);
            PG8_WAIT_V(8); PG8_WAIT_L(0); PG8_BAR; PG8_MMA(1, 0, At, B0); PG8_MMA(1, 1, At, B1); PG8_BAR; PG8_SCHED;
            } else {
            PG8_LDB(B0, 0, 0); PG8_SCHED; PG8_LDA(At, 0, 0); PG8_STAGE(PG8_SA(1, 1), a1 + hstepA, voffA);
            PG8_WAIT_L(8); PG8_BAR; PG8_WAIT_L(0); PG8_MMA(0, 0, At, B0); PG8_BAR; PG8_SCHED;
            PG8_LDB(B1, 0, 1); PG8_STAGE(PG8_SB(0, 0), b2, voffB);
            PG8_BAR; PG8_WAIT_L(0); PG8_MMA(0, 1, At, B1); PG8_BAR;
            PG8_LDA(At, 0, 1); PG8_STAGE(PG8_SA(0, 0), a2, voffA);
            PG8_BAR; PG8_WAIT_L(0); PG8_MMA(1, 0, At, B0); PG8_BAR; PG8_SCHED;
            PG8_STAGE(PG8_SB(0, 1), b2 + hstepB, voffB);
            PG8_WAIT_V(6); PG8_BAR; PG8_MMA(1, 1, At, B1); PG8_BAR;
            PG8_LDB(B0, 1, 0); PG8_SCHED; PG8_LDA(At, 1, 0); PG8_STAGE(PG8_SA(0, 1), a2 + hstepA, voffA);
            PG8_WAIT_L(8); PG8_BAR; PG8_WAIT_L(0); PG8_MMA(0, 0, At, B0); PG8_BAR; PG8_SCHED;
            PG8_LDB(B1, 1, 1); PG8_STAGE(PG8_SB(1, 0), b3, voffB);
            PG8_BAR; PG8_WAIT_L(0); PG8_MMA(0, 1, At, B1); PG8_BAR;
            PG8_LDA(At, 1, 1); PG8_STAGE(PG8_SA(1, 0), a3, voffA);
            PG8_BAR; PG8_WAIT_L(0); PG8_MMA(1, 0, At, B0); PG8_BAR; PG8_SCHED;
            PG8_STAGE(PG8_SB(1, 1), b3 + hstepB, voffB);
            PG8_WAIT_V(6); PG8_BAR; PG8_MMA(1, 1, At, B1); PG8_BAR;
            }
        }
        if constexpr (ALIGN_EPI) { if (wr == 0) PG8_BAR; }
        if constexpr (!Epi::AFTER_DRAIN) { E(acc, cur, wr, wc, fr, fq); S.done(cur); }
        if (!has_next) break;
#pragma unroll
        for (int a = 0; a < 2; ++a)
#pragma unroll
            for (int b = 0; b < 2; ++b)
#pragma unroll
                for (int m = 0; m < 4; ++m)
#pragma unroll
                    for (int n = 0; n < 2; ++n) acc[a][b][m][n] = (f32x4){0.f, 0.f, 0.f, 0.f};
        cur = nxt; cA = nA; cB = nB; ++ui;
        if constexpr (ALIGN_EPI) { if (wr == 1) PG8_BAR; }
    }
    PG8_WAIT_V(0);
    if constexpr (!ALIGN_EPI) { if (wr == 0) PG8_BAR; }
    PG8_BAR;
    if constexpr (Epi::AFTER_DRAIN) { E.fused(acc, cur, wr, wc, fr, fq, lds, wid, lane); S.done(cur); }
#undef PG8_SA
#undef PG8_SB
#undef PG8_STAGE
#undef PG8_LDA
#undef PG8_LDB
#undef PG8_MMA
#undef PG8_WAIT_V
#undef PG8_WAIT_L
#undef PG8_BAR
#undef PG8_SCHED
}
}

#define PG8_SP2 true
#define PG8_ALIGN true
typedef pg8::f32x4 f32x4;
struct SchedFlat {
    int nM, nN, nwg, G, c;
    __device__ __forceinline__ void init(int nM_, int nN_, int G_, int c_) { nM = nM_; nN = nN_; nwg = nM * nN; G = G_; c = c_; }
    __device__ __forceinline__ bool next(int i, pg8::Unit& u) const {
        const long L = (long)i * G + c; if (L >= nwg) return false;
        int wgid = (int)L; { const int q = nwg / 8, r = nwg % 8, xcd = wgid % 8, off = wgid / 8; wgid = (xcd < r ? xcd * (q + 1) : r * (q + 1) + (xcd - r) * q) + off; }
        const int nig = 8 * nN, gid = wgid / nig, fm = gid * 8, gsz = (nM - fm) < 8 ? (nM - fm) : 8;
        u.pm = fm + ((wgid % nig) % gsz); u.pn = (wgid % nig) / gsz; u.g = 0; u.arow = (long)u.pm * 256; u.brow = (long)u.pn * 256; u.bcol = 0; return true;
    }
    __device__ __forceinline__ void a_ready(const pg8::Unit&) const {}
    __device__ __forceinline__ void done(const pg8::Unit&) const {}
};
struct SchedGrouped {
    int tm, tn, arows, brows, G, c;
    __device__ __forceinline__ bool next(int i, pg8::Unit& u) const {
        const int L = i * G + c; if (L >= 16 * tm * tn) return false;
        const int g = L / (tm * tn), rem = L % (tm * tn);
        u.g = g; u.pm = rem % tm; u.pn = rem / tm; u.arow = (long)g * arows + u.pm * 256; u.brow = (long)g * brows + u.pn * 256; u.bcol = 0; return true;
    }
    __device__ __forceinline__ void a_ready(const pg8::Unit&) const {}
    __device__ __forceinline__ void done(const pg8::Unit&) const {}
};
struct SchedWsc {
    int G, c;
    __device__ __forceinline__ bool next(int i, pg8::Unit& u) const {
        const int L = i * G + c; if (L >= 32) return false;
        u.g = 0; u.pm = L & 7; u.pn = L >> 3; u.arow = (long)u.pm * 256; u.brow = (long)u.pn * 256; u.bcol = (long)u.pm * 256; return true;
    }
    __device__ __forceinline__ void a_ready(const pg8::Unit&) const {}
    __device__ __forceinline__ void done(const pg8::Unit&) const {}
};
template <class F> struct EpiAdapt {
    static constexpr bool PERM = false, AFTER_DRAIN = false;
    F f;
    __device__ __forceinline__ void operator()(const f32x4 (&acc)[2][2][4][2], const pg8::Unit& u, int wr, int wc, int fr_, int fq_) const {
        int l2_; asm volatile("v_mbcnt_lo_u32_b32 %0, -1, 0\n\tv_mbcnt_hi_u32_b32 %0, -1, %0" : "=v"(l2_)); (void)fr_; (void)fq_;
        const int fr = l2_ & 15, fq = l2_ >> 4;
        F ff = f; ff.set_group(u.g);
#pragma unroll
        for (int bj = 0; bj < 2; ++bj) { const int c0 = u.pn * 256 + bj * 128 + wc * 32 + 4 * fq;
#pragma unroll
            for (int ai = 0; ai < 2; ++ai)
#pragma unroll
                for (int m = 0; m < 4; ++m) { int row = u.pm * 256 + ai * 128 + wr * 64 + m * 16 + fr; asm volatile("" : "+v"(row));
                    const f32x4 v0 = acc[ai][bj][m][0], v1 = acc[ai][bj][m][1];
                    const float a[4] = {v0[0], v0[1], v0[2], v0[3]}, b[4] = {v1[0], v1[1], v1[2], v1[3]};
                    ff(row, c0, a, b); asm volatile("" ::: "memory"); } }
    }
};


template <> struct EpiAdapt<EpiWinG> {
    static constexpr bool PERM = false, AFTER_DRAIN = false;
    EpiWinG f;
    template <int R> __device__ __forceinline__ void run(const f32x4 (&acc)[2][2][4][2], const pg8::Unit& u, int wr, int wc) const {
        int l2_; asm volatile("v_mbcnt_lo_u32_b32 %0, -1, 0\n\tv_mbcnt_hi_u32_b32 %0, -1, %0" : "=v"(l2_));
        const int fr = l2_ & 15, fq = l2_ >> 4;
#pragma unroll
        for (int bj = 0; bj < 2; ++bj) { const int c0 = u.pn * 256 + bj * 128 + wc * 32 + 4 * fq;
#pragma unroll
            for (int ai = 0; ai < 2; ++ai)
#pragma unroll
                for (int m = 0; m < 4; ++m) { int row = u.pm * 256 + ai * 128 + wr * 64 + m * 16 + fr; asm volatile("" : "+v"(row));
                    const f32x4 v0 = acc[ai][bj][m][0], v1 = acc[ai][bj][m][1];
                    const float a[4] = {v0[0], v0[1], v0[2], v0[3]}, b[4] = {v1[0], v1[1], v1[2], v1[3]};
                    f.template tile<R>(row, c0, a, b); asm volatile("" ::: "memory"); } }
    }
    __device__ __forceinline__ void operator()(const f32x4 (&acc)[2][2][4][2], const pg8::Unit& u, int wr, int wc, int, int) const {
        const int pn = __builtin_amdgcn_readfirstlane(u.pn);
        if (pn == 0) run<0>(acc, u, wr, wc); else if (pn < 5) run<1>(acc, u, wr, wc); else if (pn < 7) run<2>(acc, u, wr, wc); else if (pn < 10) run<3>(acc, u, wr, wc); else run<4>(acc, u, wr, wc);
    }
};

namespace dattn {
typedef short bf16x8 __attribute__((ext_vector_type(8)));
typedef short s16x4 __attribute__((ext_vector_type(4)));
typedef float f32x16 __attribute__((ext_vector_type(16)));
typedef unsigned u32x4 __attribute__((ext_vector_type(4)));
typedef float f32x2_t __attribute__((ext_vector_type(2))); typedef __bf16 bf16x2_t __attribute__((ext_vector_type(2)));
constexpr int KP = 272, VDT = 4160, KBYTES = 64 * KP, VBYTES = 4 * VDT, STAGE = KBYTES + VBYTES;
static_assert(3 * KBYTES + 2 * VBYTES <= 131072 && 4 * 128 * 32 * 4 <= 131072, "attention LDS");
__device__ __forceinline__ unsigned cvtpk(float lo, float hi) { f32x2_t v = {lo, hi}; bf16x2_t b = __builtin_convertvector(v, bf16x2_t); return __builtin_bit_cast(unsigned, b); }
__device__ __forceinline__ int crow(int reg, int h) { return (reg & 3) + 8 * (reg >> 2) + 4 * h; }
__device__ __forceinline__ float max3f(float a, float b, float c) { float r; asm("v_max3_f32 %0, %1, %2, %3" : "=v"(r) : "v"(a), "v"(b), "v"(c)); return r; }
__device__ __forceinline__ float max2f(float a, float b) { float r; asm("v_max_f32_e32 %0, %1, %2" : "=v"(r) : "v"(a), "v"(b)); return r; }
__device__ __forceinline__ float tile_max(f32x16& pA, f32x16& pB) {
    asm volatile("s_nop 15\n\ts_nop 7" : "+v"(pA), "+v"(pB));
    float a = max3f(pA[0], pA[1], pB[0]), b = max3f(pA[2], pA[3], pB[1]); a = max3f(a, pB[2], pB[3]);
#pragma unroll
    for (int r = 4; r < 16; r += 4) { a = max3f(a, pA[r], pA[r + 1]); b = max3f(b, pA[r + 2], pA[r + 3]); a = max3f(a, pB[r], pB[r + 1]); b = max3f(b, pB[r + 2], pB[r + 3]); }
    const float m = max2f(a, b);
    const unsigned tu = __float_as_uint(m); auto rr = __builtin_amdgcn_permlane32_swap(tu, tu, false, false);
    return max2f(__uint_as_float(rr[0]), __uint_as_float(rr[1]));
}
__device__ __forceinline__ float tile_max_old(const f32x16& pA, const f32x16& pB) {
    float a, b;
    asm volatile("v_max3_f32 %0, %1, %2, %3\n\tv_max3_f32 %0, %0, %4, %5\n\tv_max3_f32 %0, %0, %6, %7\n\tv_max3_f32 %0, %0, %8, %9\n\tv_max3_f32 %0, %0, %10, %11\n\tv_max3_f32 %0, %0, %12, %13\n\tv_max3_f32 %0, %0, %14, %15\n\tv_max_f32 %0, %0, %16"
        : "=&v"(a) : "v"(pA[0]), "v"(pA[1]), "v"(pA[2]), "v"(pA[3]), "v"(pA[4]), "v"(pA[5]), "v"(pA[6]), "v"(pA[7]), "v"(pA[8]), "v"(pA[9]), "v"(pA[10]), "v"(pA[11]), "v"(pA[12]), "v"(pA[13]), "v"(pA[14]), "v"(pA[15]));
    asm volatile("v_max3_f32 %0, %1, %2, %3\n\tv_max3_f32 %0, %0, %4, %5\n\tv_max3_f32 %0, %0, %6, %7\n\tv_max3_f32 %0, %0, %8, %9\n\tv_max3_f32 %0, %0, %10, %11\n\tv_max3_f32 %0, %0, %12, %13\n\tv_max3_f32 %0, %0, %14, %15\n\tv_max_f32 %0, %0, %16"
        : "=&v"(b) : "v"(pB[0]), "v"(pB[1]), "v"(pB[2]), "v"(pB[3]), "v"(pB[4]), "v"(pB[5]), "v"(pB[6]), "v"(pB[7]), "v"(pB[8]), "v"(pB[9]), "v"(pB[10]), "v"(pB[11]), "v"(pB[12]), "v"(pB[13]), "v"(pB[14]), "v"(pB[15]));
    const float m = max2f(a, b);
    const unsigned tu = __float_as_uint(m); auto rr = __builtin_amdgcn_permlane32_swap(tu, tu, false, false);
    return max2f(__uint_as_float(rr[0]), __uint_as_float(rr[1]));
}
#define DA_PACK(x, s) __builtin_bit_cast(bf16x8, (u32x4){cvtpk(x[8 * (s)], x[8 * (s) + 1]), cvtpk(x[8 * (s) + 2], x[8 * (s) + 3]), cvtpk(x[8 * (s) + 4], x[8 * (s) + 5]), cvtpk(x[8 * (s) + 6], x[8 * (s) + 7])})
typedef int i32x8 __attribute__((ext_vector_type(8))); typedef int i32x4 __attribute__((ext_vector_type(4)));
__device__ __forceinline__ int pk4f8(float a, float b, float c, float d) { int w = 0; w = __builtin_amdgcn_cvt_pk_fp8_f32(a, b, w, false); return __builtin_amdgcn_cvt_pk_fp8_f32(c, d, w, true); }
#define DA_RP1(w, a, b, c, d) do { w = __builtin_amdgcn_cvt_pk_fp8_f32(a, b, w, false); w = __builtin_amdgcn_cvt_pk_fp8_f32(c, d, w, true); } while (0)
#define DA_REPACK8(pf, x, y) do { DA_RP1(pf[0], x[0], x[1], x[2], x[3]); DA_RP1(pf[1], x[4], x[5], x[6], x[7]); DA_RP1(pf[2], x[8], x[9], x[10], x[11]); DA_RP1(pf[3], x[12], x[13], x[14], x[15]); \
        DA_RP1(pf[4], y[0], y[1], y[2], y[3]); DA_RP1(pf[5], y[4], y[5], y[6], y[7]); DA_RP1(pf[6], y[8], y[9], y[10], y[11]); DA_RP1(pf[7], y[12], y[13], y[14], y[15]); } while (0)
#define DA_PACK8(x, y) (i32x8){pk4f8(x[0], x[1], x[2], x[3]), pk4f8(x[4], x[5], x[6], x[7]), pk4f8(x[8], x[9], x[10], x[11]), pk4f8(x[12], x[13], x[14], x[15]), \
                               pk4f8(y[0], y[1], y[2], y[3]), pk4f8(y[4], y[5], y[6], y[7]), pk4f8(y[8], y[9], y[10], y[11]), pk4f8(y[12], y[13], y[14], y[15])}
typedef short v4i16_t __attribute__((ext_vector_type(4)));
__device__ __forceinline__ s16x4 vtr(const PG8_LAS unsigned char* q) { return __builtin_bit_cast(s16x4, __builtin_amdgcn_ds_read_tr16_b64_v4i16((PG8_LAS v4i16_t*)q)); }

__device__ __forceinline__ void diff_unit(const Params& p, int l, PG8_LAS unsigned char* lds, int b, int hh, int qrow0, bool isctx, int wave_s) {
    int tid_ = tid_of(wave_s); asm volatile("" : "+v"(tid_));
    const int tid = tid_, lane = tid & 63, wid = __builtin_amdgcn_readfirstlane(tid >> 6), m = wid >> 2, qt = wid & 3, r = lane & 31, h = lane >> 5;
    const int nkt = isctx ? C_ / 64 : (C_ + L_) / 64;
    i32x8 qf8;
    { const unsigned char GPTR* qp = (const unsigned char GPTR*)(p.ws + WS_QD) + (size_t)(qrow0 + qt * 32 + r) * 512 + hh * 128 + m * 64 + h * 32;
      qf8 = __builtin_shufflevector(*(const i32x4 GPTR*)qp, *(const i32x4 GPTR*)(qp + 16), 0, 1, 2, 3, 4, 5, 6, 7); }
    f32x16 o[4];
#pragma unroll
    for (int dt = 0; dt < 4; ++dt)
#pragma unroll
        for (int i = 0; i < 16; ++i) o[dt][i] = 0.f;
    float mrun = 0.f;
    i32x8 onesA; { const int on_ = (((lane & 15) == 0 && ((lane >> 4) & 1) == 0) || ((lane & 15) == 1 && ((lane >> 4) & 1) == 1)) ? 0x38383838 : 0;
#pragma unroll
      for (int i = 0; i < 8; ++i) onesA[i] = on_; }
    f32x4 lacc = {0.f, 0.f, 0.f, 0.f};
    constexpr int KPD = 128, KBYTES = 64 * KPD;
    const unsigned char GPTR* K8g = (const unsigned char GPTR*)(p.ws + WS_KD); const unsigned char GPTR* VTg = (const unsigned char GPTR*)(p.ws + WS_VT8);
    unsigned kgo;
    { const int row = 8 * wid + (lane >> 3), lc = (lane & 7) ^ ((row >> 1) & 7);
      const int kap = 32 * ((row >> 2) & 1) + (row & 3) + 4 * ((row & 31) >> 3) + 16 * (row >> 5); kgo = (unsigned)(kap * 512 + hh * 128 + lc * 16); }
    unsigned vgo; { const int d = 16 * wid + (lane >> 2), lc = (lane & 3) ^ ((d >> 2) & 3); vgo = (unsigned)(((b * 4 + hh) * 128 + d) * KVP + lc * 16); }
#define DA_ROW0(t) ((isctx || (t) < C_ / 64) ? (NRL + b * C_ + (t) * 64) : (b * L_ + ((t) - C_ / 64) * 64))
    const unsigned kro = (unsigned)(r * KPD + (((m * 4 + 2 * h) ^ ((r >> 1) & 7)) * 16));
    const unsigned vro0 = (unsigned)(r * 64 + (((2 * h) ^ ((r >> 2) & 3)) * 16)), vro1 = (unsigned)(r * 64 + (((2 * h + 1) ^ ((r >> 2) & 3)) * 16));
    PG8_LAS unsigned char* const KB0 = lds; PG8_LAS unsigned char* const VB0 = lds + 4 * KBYTES;
    constexpr int V8BYTES = 128 * 64;
    int scq_ = 0x7c7c7c7c; asm volatile("" : "+v"(scq_));
    int sc1_ = 0x7f7f7f7f; asm volatile("" : "+v"(sc1_));
#define DA_DMAK(t, boff) __builtin_amdgcn_global_load_lds((const unsigned GPTR*)(K8g + (size_t)DA_ROW0(t) * 512 + kgo), (PG8_LAS unsigned*)(KB0 + (boff) + wid * 1024), 16, 0, 0)
#define DA_DMAV(t, boff) __builtin_amdgcn_global_load_lds((const unsigned GPTR*)(VTg + vgo + (t) * 64), (PG8_LAS unsigned*)(VB0 + (boff) + wid * 1024), 16, 0, 0)
#define DA_LDK(off) __builtin_shufflevector(*(const PG8_LAS i32x4*)(Kb_ + (off)), *(const PG8_LAS i32x4*)(Kb_ + ((off) ^ 16)), 0, 1, 2, 3, 4, 5, 6, 7)
    const bf16x8 onesK = __builtin_bit_cast(bf16x8, (u32x4){h == 0 ? 0x3f80u : 0u, 0u, 0u, 0u});
    u32x4 negmB = {0u, 0u, 0u, 0u};
    const f32x16 zero16 = {0.f, 0.f, 0.f, 0.f, 0.f, 0.f, 0.f, 0.f, 0.f, 0.f, 0.f, 0.f, 0.f, 0.f, 0.f, 0.f};
#define DA_SETM() do { negmB[0] = h == 0 ? ((__float_as_uint(mrun) ^ 0x80000000u) >> 16) : 0u; } while (0)
#define DA_BFR(x) __uint_as_float((__float_as_uint(x) + 0x7fffu + ((__float_as_uint(x) >> 16) & 1u)) & 0xffff0000u)
#define DA_QK(PA, PB, boff) do { const PG8_LAS unsigned char* Kb_ = KB0 + (boff); \
        const f32x16 negm = __builtin_amdgcn_mfma_f32_32x32x16_bf16(onesK, __builtin_bit_cast(bf16x8, negmB), zero16, 0, 0, 0); \
        const i32x8 kfa_ = DA_LDK(kro), kfb_ = DA_LDK(kro + 32 * KPD); \
        __builtin_amdgcn_sched_barrier(0); \
        PA = __builtin_amdgcn_mfma_scale_f32_32x32x64_f8f6f4(kfa_, qf8, negm, 0, 0, 0, scq_, 0, scq_); \
        PB = __builtin_amdgcn_mfma_scale_f32_32x32x64_f8f6f4(kfb_, qf8, negm, 0, 0, 0, scq_, 0, scq_); } while (0)
    DA_DMAK(0, 0); DA_DMAK(1, KBYTES); DA_DMAV(0, 0); DA_DMAK(2, 2 * KBYTES); DA_DMAV(1, V8BYTES); DA_DMAK(3, 3 * KBYTES);
    asm volatile("s_waitcnt vmcnt(0)" ::: "memory"); __syncthreads();
    f32x16 pA, pB, nA, nB;
    DA_QK(pA, pB, 0);
    DA_QK(nA, nB, KBYTES);
    i32x8 pf8;
    { const float tm = DA_BFR(tile_max(pA, pB));
      mrun = tm; DA_SETM();
#pragma unroll
      for (int i = 0; i < 16; ++i) { pA[i] = __builtin_amdgcn_exp2f(pA[i] - tm); pB[i] = __builtin_amdgcn_exp2f(pB[i] - tm); nA[i] -= tm; nB[i] -= tm; }
      pf8 = DA_PACK8(pA, pB); }
    __syncthreads();
    if (wid >= 4) __builtin_amdgcn_s_setprio(1);
    int b0 = 0, b1 = 1, b2 = 2;
#define DA_LDV(dst, dt) dst = __builtin_shufflevector(*(const PG8_LAS i32x4*)(Vb + vro0 + (dt) * 2048), *(const PG8_LAS i32x4*)(Vb + vro1 + (dt) * 2048), 0, 1, 2, 3, 4, 5, 6, 7)
#define DA_PV(dt, src) o[dt] = __builtin_amdgcn_mfma_scale_f32_32x32x64_f8f6f4(src, pf8, o[dt], 0, 0, 0, sc1_, 0, sc1_)
#define DA_EXP8(XA, XB, k) do { float e0_ = __builtin_amdgcn_exp2f(XA[4 * (k)]), e1_ = __builtin_amdgcn_exp2f(XA[4 * (k) + 1]), e2_ = __builtin_amdgcn_exp2f(XA[4 * (k) + 2]), e3_ = __builtin_amdgcn_exp2f(XA[4 * (k) + 3]), \
            e4_ = __builtin_amdgcn_exp2f(XB[4 * (k)]), e5_ = __builtin_amdgcn_exp2f(XB[4 * (k) + 1]), e6_ = __builtin_amdgcn_exp2f(XB[4 * (k) + 2]), e7_ = __builtin_amdgcn_exp2f(XB[4 * (k) + 3]); \
        asm volatile("" : "+v"(e0_), "+v"(e1_), "+v"(e2_), "+v"(e3_), "+v"(e4_), "+v"(e5_), "+v"(e6_), "+v"(e7_));        \
        XA[4 * (k)] = e0_; XA[4 * (k) + 1] = e1_; XA[4 * (k) + 2] = e2_; XA[4 * (k) + 3] = e3_; XB[4 * (k)] = e4_; XB[4 * (k) + 1] = e5_; XB[4 * (k) + 2] = e6_; XB[4 * (k) + 3] = e7_; } while (0)
#define DA_SB __builtin_amdgcn_sched_barrier(0)
#define DA_ITER(XA, XB, YA, YB) do { \
        const bool more1 = (t + 1 < nkt), more2 = (t + 2 < nkt), more4 = (t + 4 < nkt); \
        if (more4) DA_DMAK(t + 4, (t & 3) * KBYTES);         \
        if (more2) DA_DMAV(t + 2, b2 * V8BYTES); \
        if (more2) DA_QK(YA, YB, ((t + 2) & 3) * KBYTES); \
        DA_SB; \
        const PG8_LAS unsigned char* Vb = VB0 + b0 * V8BYTES; \
        float alpha = 1.f; bool resc = false; \
        { const float tm = tile_max_old(XA, XB);        \
            const bool need = more1 && tm > 8.0f; \
            if (__builtin_amdgcn_ballot_w64(need) != 0ull) { const float mn_ = need ? DA_BFR(mrun + tm) : mrun, dl = mn_ - mrun; alpha = __builtin_amdgcn_exp2f(-dl); resc = true; mrun = mn_; DA_SETM(); \
                _Pragma("unroll") for (int i = 0; i < 16; ++i) { XA[i] -= dl; XB[i] -= dl; } \
                if (more2) { _Pragma("unroll") for (int i = 0; i < 16; ++i) { YA[i] -= dl; YB[i] -= dl; } } } } \
        i32x8 vfa, vfb; \
        DA_SB; DA_LDV(vfa, 0); DA_LDV(vfb, 1); \
        DA_SB; DA_PV(0, vfa); DA_SB; DA_EXP8(XA, XB, 0); DA_LDV(vfa, 2); \
        DA_SB; DA_PV(1, vfb); DA_SB; DA_EXP8(XA, XB, 1); DA_LDV(vfb, 3); \
        DA_SB; DA_PV(2, vfa); DA_SB; DA_EXP8(XA, XB, 2); \
        DA_SB; DA_PV(3, vfb); DA_SB; DA_EXP8(XA, XB, 3); \
        DA_SB; lacc = __builtin_amdgcn_mfma_scale_f32_16x16x128_f8f6f4(onesA, pf8, lacc, 0, 0, 0, sc1_, 0, sc1_); DA_SB; \
        if (resc) { lacc[0] *= alpha; lacc[1] *= shx(alpha, 16, lane); \
            _Pragma("unroll") for (int dt = 0; dt < 4; ++dt) _Pragma("unroll") for (int i = 0; i < 16; ++i) o[dt][i] *= alpha; } \
        DA_REPACK8(pf8, XA, XB); \
        if (more4) asm volatile("s_waitcnt vmcnt(2)" ::: "memory"); else asm volatile("s_waitcnt vmcnt(0)" ::: "memory");     \
        asm volatile("s_waitcnt lgkmcnt(0)" ::: "memory"); __builtin_amdgcn_s_barrier(); asm volatile("" ::: "memory");        \
        { const int r_ = b0; b0 = b1; b1 = b2; b2 = r_; } } while (0)
    for (int t = 0; t < nkt; ++t) {
        DA_ITER(nA, nB, pA, pB);
        ++t;
        DA_ITER(pA, pB, nA, nB);
    }
#undef DA_ITER
#undef DA_SB
#undef DA_EXP8
#undef DA_LDV
#undef DA_PV
#undef DA_DMAK
#undef DA_DMAV
#undef DA_QK
#undef DA_ROW0
    __builtin_amdgcn_s_setprio(0);
    const float l0_ = __int_as_float(__builtin_amdgcn_ds_bpermute((lane & 15) << 2, __float_as_int(lacc[0]))), l1_ = __int_as_float(__builtin_amdgcn_ds_bpermute((lane & 15) << 2, __float_as_int(lacc[1])));
    const float inv = 1.f / ((lane & 16) ? l1_ : l0_);
    PG8_LAS float* X = (PG8_LAS float*)lds;
    if (m == 1) {
#pragma unroll
        for (int dt = 0; dt < 4; ++dt)
#pragma unroll
            for (int i = 0; i < 16; ++i) X[(qt * 128 + dt * 32 + crow(i, h)) * 32 + r] = o[dt][i] * inv;
    }
    __syncthreads();
    if (m == 0) {
        const float lam = WSP(const float, WS_LAMD)[l], oml = WSP(const float, WS_LAMD)[2 + l];
        float ss = 0.f;
#pragma unroll
        for (int dt = 0; dt < 4; ++dt)
#pragma unroll
            for (int i = 0; i < 16; ++i) { const float v = o[dt][i] * inv - lam * X[(qt * 128 + dt * 32 + crow(i, h)) * 32 + r]; o[dt][i] = v; ss += v * v; }
        ss += shx(ss, 32, lane);
        const float rinv = oml / sqrtf(ss * (1.f / 128.f) + RMS_EPS);
        const float* sg = p.in[I_SUBLN] + (size_t)l * 128;
        bf16_t* y = WSP(bf16_t, WS_YD) + (size_t)(qrow0 + qt * 32 + r) * 512 + hh * 128;
#pragma unroll
        for (int dt = 0; dt < 4; ++dt)
#pragma unroll
            for (int g4 = 0; g4 < 4; ++g4) { const int d = dt * 32 + 8 * g4 + 4 * h;
                const unsigned w0 = cvtpk(o[dt][4 * g4] * rinv * sg[d], o[dt][4 * g4 + 1] * rinv * sg[d + 1]), w1 = cvtpk(o[dt][4 * g4 + 2] * rinv * sg[d + 2], o[dt][4 * g4 + 3] * rinv * sg[d + 3]);
                *(uint2*)(y + d) = make_uint2(w0, w1); }
    }
    __syncthreads();
}
__device__ __forceinline__ void diff_phase(const Params& p, int l, PG8_LAS unsigned char* lds, int wave_s) {
    const int G = gridDim.x, bid = blockIdx.x;
    constexpr int NQB = L_ / 128, NU = B_ * 4 * NQB;
    if (G % 8 == 0 && (16 % (G / 8) == 0 || (G / 8) % 16 == 0 || true)) {
        const int xcd = bid % 8, slot = bid / 8, per = G / 8;
        for (int combo = xcd; combo < B_ * 4; combo += 8)
            for (int qb = slot; qb < NQB; qb += per) diff_unit(p, l, lds, combo >> 2, combo & 3, (combo >> 2) * L_ + qb * 128, false, wave_s);
    } else {
        for (int u = bid; u < NU; u += G) { const int combo = u / NQB, qb = u % NQB; diff_unit(p, l, lds, combo >> 2, combo & 3, (combo >> 2) * L_ + qb * 128, false, wave_s); }
    }
    if (l == 0) { constexpr int NCU = B_ * 4 * (C_ / 128);
        for (int u = bid; u < NCU; u += G) { const int combo = u / (C_ / 128), qb = u % (C_ / 128); diff_unit(p, l, lds, combo >> 2, combo & 3, NRL + (combo >> 2) * C_ + qb * 128, true, wave_s); } }
}
}


namespace nattn {
#define DA_BFR_(x) __uint_as_float((__float_as_uint(x) + 0x7fffu + ((__float_as_uint(x) >> 16) & 1u)) & 0xffff0000u)
using dattn::bf16x8; using dattn::s16x4; using dattn::f32x16; using dattn::u32x4; using dattn::cvtpk; using dattn::crow; using dattn::vtr;
constexpr int KP = 144, VDT = 4160, KBYTES = 64 * KP, VBYTES = 2 * VDT, STAGE = KBYTES + VBYTES, BIAS_OFF = 2 * STAGE;
static_assert(C_ % 64 == 0 && (C_ == 256), "context-query units assume 256 context rows");
__device__ __forceinline__ int rs_of(int r) { int v = r - 4; v = v < 0 ? 0 : v; return v > GRR - 8 ? GRR - 8 : v; }
__device__ __forceinline__ void na_unit(const Params& p, int l, PG8_LAS unsigned char* lds, int b, int hh, int r0, bool isctx, int wave_s) {
    int tid_ = tid_of(wave_s); asm volatile("" : "+v"(tid_));
    const int tid = tid_, lane = tid & 63, wid = __builtin_amdgcn_readfirstlane(tid >> 6), r = lane & 31, h = lane >> 5;
    const bf16_t* QN = WSP(const bf16_t, WS_QN); const bf16_t* KN = WSP(const bf16_t, WS_KN); const bf16_t* VN = WSP(const bf16_t, WS_VN);
    const int rq = r0 + (wid >> 1), cq = (wid & 1) * 32 + r;
    const int qrow = isctx ? NRL + b * C_ + wid * 32 + r : b * L_ + rq * GRW + cq;
    const int rsq = rs_of(rq); int csq = cq - 8; csq = csq < 0 ? 0 : (csq > GRW - 16 ? GRW - 16 : csq);
    const int kr_lo = rs_of(r0), kr_hi = rs_of(r0 + 3) + 8;
    const int nct = C_ / 64, nkt = isctx ? nct : nct + (kr_hi - kr_lo);
    PG8_LAS float* BT = (PG8_LAS float*)(lds + BIAS_OFF);
    if (tid < 15 * 32) BT[tid] = (tid & 31) < 31 ? p.in[I_RPB][((size_t)l * 4 + hh) * 465 + (tid >> 5) * 31 + (tid & 31)] * LOG2E : -1e30f;
    bf16x8 qf[4];
    { const bf16_t* qp = QN + (size_t)qrow * 256 + hh * 64 + h * 8;
#pragma unroll
      for (int d0 = 0; d0 < 4; ++d0) qf[d0] = *(const bf16x8*)(qp + d0 * 16); }
    f32x16 o[2];
#pragma unroll
    for (int dt = 0; dt < 2; ++dt)
#pragma unroll
        for (int i = 0; i < 16; ++i) o[dt][i] = 0.f;
    float mrun = 0.f, lrun = 0.f;
    unsigned coA[16], coB[16];
#pragma unroll
    for (int i = 0; i < 16; ++i) { const int kcA = crow(i, h), kcB = 32 + kcA;
        coA[i] = (unsigned)(((unsigned)(kcA - csq) < 16u ? 15 - cq + kcA : 31) * 4); coB[i] = (unsigned)(((unsigned)(kcB - csq) < 16u ? 15 - cq + kcB : 31) * 4); }
    const bf16x8 onesK = __builtin_bit_cast(bf16x8, (u32x4){h == 0 ? 0x3f80u : 0u, 0u, 0u, 0u});
    u32x4 negmB = {0u, 0u, 0u, 0u};
    const f32x16 zero16 = {0.f, 0.f, 0.f, 0.f, 0.f, 0.f, 0.f, 0.f, 0.f, 0.f, 0.f, 0.f, 0.f, 0.f, 0.f, 0.f};
    const int srow = tid >> 3, sc8 = tid & 7;
    const unsigned kw = (unsigned)(srow * KP + sc8 * 16), vw = (unsigned)(KBYTES + (sc8 >> 2) * VDT + srow * 64 + (sc8 & 3) * 16);
    const size_t goff = (size_t)srow * 256 + hh * 64 + sc8 * 8;
    u32x4 kreg, vreg;
#define NA_ROW0(t) ((t) < nct ? (NRL + b * C_ + (t) * 64) : (b * L_ + (kr_lo + (t) - nct) * GRW))
#define NA_LOAD(t) do { const size_t g0 = (size_t)NA_ROW0(t) * 256 + goff; kreg = *(const u32x4*)(KN + g0); vreg = *(const u32x4*)(VN + g0); } while (0)
#define NA_WRITE(buf) do { PG8_LAS unsigned char* sb = lds + (buf) * STAGE; *(PG8_LAS u32x4*)(sb + kw) = kreg; *(PG8_LAS u32x4*)(sb + vw) = vreg; } while (0)
    const unsigned kro = (unsigned)(r * KP + h * 16);
    const unsigned vro = (unsigned)((4 * h + ((lane & 15) >> 2)) * 64 + ((lane >> 4) & 1) * 32 + (lane & 3) * 8);
    NA_LOAD(0); NA_WRITE(0); __syncthreads();
    for (int t = 0; t < nkt; ++t) {
        const bool more = (t + 1 < nkt);
        if (more) NA_LOAD(t + 1);
        const int kr = kr_lo + t - nct;
        const bool local = t >= nct;
        if (!local || (kr >= rsq && kr < rsq + 8)) {
            const PG8_LAS unsigned char* Kb = lds + (t & 1) * STAGE; const PG8_LAS unsigned char* Vb = Kb + KBYTES;
            f32x16 pA = __builtin_amdgcn_mfma_f32_32x32x16_bf16(onesK, __builtin_bit_cast(bf16x8, negmB), zero16, 0, 0, 0), pB = pA;
#pragma unroll
            for (int d0 = 0; d0 < 4; ++d0) {
                const bf16x8 ka = *(const PG8_LAS bf16x8*)(Kb + kro + d0 * 32), kb = *(const PG8_LAS bf16x8*)(Kb + kro + 32 * KP + d0 * 32);
                pA = __builtin_amdgcn_mfma_f32_32x32x16_bf16(ka, qf[d0], pA, 0, 0, 0);
                pB = __builtin_amdgcn_mfma_f32_32x32x16_bf16(kb, qf[d0], pB, 0, 0, 0);
            }
            if (local) {
                const PG8_LAS unsigned char* brow = (const PG8_LAS unsigned char*)BT + (kr - rq + 7) * 128;
#pragma unroll
                for (int i = 0; i < 16; ++i) { pA[i] += *(const PG8_LAS float*)(brow + coA[i]); pB[i] += *(const PG8_LAS float*)(brow + coB[i]); }
            }
            const float tm = dattn::tile_max(pA, pB);
            const bool need = (t == 0) || (tm > 8.0f);
            if (__builtin_amdgcn_ballot_w64(need) != 0ull) {
                const float mn_ = need ? DA_BFR_(mrun + tm) : mrun, dl = mn_ - mrun, alpha = (t == 0) ? 0.f : __builtin_amdgcn_exp2f(-dl);
                mrun = mn_; lrun *= alpha; negmB[0] = h == 0 ? ((__float_as_uint(mrun) ^ 0x80000000u) >> 16) : 0u;
#pragma unroll
                for (int i = 0; i < 16; ++i) { pA[i] -= dl; pB[i] -= dl; }
#pragma unroll
                for (int dt = 0; dt < 2; ++dt)
#pragma unroll
                    for (int i = 0; i < 16; ++i) o[dt][i] *= alpha;
            }
            float ps = 0.f;
#pragma unroll
            for (int i = 0; i < 16; ++i) { pA[i] = __builtin_amdgcn_exp2f(pA[i]); pB[i] = __builtin_amdgcn_exp2f(pB[i]); ps += pA[i] + pB[i]; }
            lrun += ps;
            const bf16x8 pf00 = DA_PACK(pA, 0), pf01 = DA_PACK(pA, 1), pf10 = DA_PACK(pB, 0), pf11 = DA_PACK(pB, 1);
#pragma unroll
            for (int dt = 0; dt < 2; ++dt) {
                const PG8_LAS unsigned char* vb = Vb + vro + dt * VDT;
#define NA_VF(kvh, st) __builtin_shufflevector(vtr(vb + ((kvh) * 32 + 16 * (st)) * 64), vtr(vb + ((kvh) * 32 + 16 * (st) + 8) * 64), 0, 1, 2, 3, 4, 5, 6, 7)
                o[dt] = __builtin_amdgcn_mfma_f32_32x32x16_bf16(NA_VF(0, 0), pf00, o[dt], 0, 0, 0);
                o[dt] = __builtin_amdgcn_mfma_f32_32x32x16_bf16(NA_VF(0, 1), pf01, o[dt], 0, 0, 0);
                o[dt] = __builtin_amdgcn_mfma_f32_32x32x16_bf16(NA_VF(1, 0), pf10, o[dt], 0, 0, 0);
                o[dt] = __builtin_amdgcn_mfma_f32_32x32x16_bf16(NA_VF(1, 1), pf11, o[dt], 0, 0, 0);
#undef NA_VF
            }
        }
        if (more) NA_WRITE((t + 1) & 1);
        __syncthreads();
    }
#undef NA_LOAD
#undef NA_WRITE
#undef NA_ROW0
    lrun += shx(lrun, 32, lane);
    const float inv = 1.f / lrun;
    bf16_t* y = WSP(bf16_t, WS_YN) + (size_t)qrow * 256 + hh * 64;
#pragma unroll
    for (int dt = 0; dt < 2; ++dt)
#pragma unroll
        for (int g4 = 0; g4 < 4; ++g4) { const int d = dt * 32 + 8 * g4 + 4 * h;
            *(uint2*)(y + d) = make_uint2(cvtpk(o[dt][4 * g4] * inv, o[dt][4 * g4 + 1] * inv), cvtpk(o[dt][4 * g4 + 2] * inv, o[dt][4 * g4 + 3] * inv)); }
}
__device__ __forceinline__ void na_phase(const Params& p, int l, PG8_LAS unsigned char* lds, int wave_s) {
    const int G = gridDim.x, bid = blockIdx.x;
    constexpr int NRG = GRR / 4, NU = B_ * 4 * NRG;
    for (int u = bid; u < NU; u += G) { const int combo = u / NRG, rg = u % NRG; na_unit(p, l, lds, combo >> 2, combo & 3, rg * 4, false, wave_s); }
    if (l == 0) for (int u = bid; u < B_ * 4; u += G) na_unit(p, l, lds, u >> 2, u & 3, 0, true, wave_s);
}
}

constexpr int NTHREADS = 512;

namespace fastp {
typedef float f32x4v __attribute__((ext_vector_type(4)));
typedef unsigned u32x4 __attribute__((ext_vector_type(4)));
typedef __bf16 bf16x2_t __attribute__((ext_vector_type(2)));
__device__ __forceinline__ float wave_sum(float v, int lane) {
#pragma unroll
    for (int o = 1; o < 64; o <<= 1) v += shx(v, o, lane);
    return v;
}
__device__ __forceinline__ unsigned pk2(float lo, float hi) { return dattn::cvtpk(lo, hi); }
__device__ __forceinline__ void norm_phase(const Params& p, int l, int which, int nrows, bool from_inputs, int wave_s) {
    int tid_ = tid_of(wave_s); asm volatile("" : "+v"(tid_));
    const int lane = tid_ & 63, wid = tid_ >> 6;
    const float* gain = p.in[which == 1 ? I_N1G : I_N2G] + (size_t)l * DM;
    const int seg_sh = which == 1 ? 0 : 3, seg_sc = which == 1 ? 1 : 4;
    for (int row = blockIdx.x * 8 + wid; row < nrows; row += gridDim.x * 8) {
        const float* src = from_inputs ? (row < NRL ? p.in[I_X] + (size_t)row * DM : p.in[I_CTX] + (size_t)(row - NRL) * DM) : xr_row(p, row);
        f32x4v v[4]; float ss = 0.f;
#pragma unroll
        for (int j = 0; j < 4; ++j) { v[j] = *(const f32x4v*)(src + j * 256 + lane * 4); ss += v[j][0] * v[j][0] + v[j][1] * v[j][1] + v[j][2] * v[j][2] + v[j][3] * v[j][3]; }
        ss = wave_sum(ss, lane);
        const float rinv = 1.f / sqrtf(ss * (1.f / DM) + RMS_EPS);
        if (from_inputs) { float* xr = xr_row(p, row);
#pragma unroll
            for (int j = 0; j < 4; ++j) *(f32x4v*)(xr + j * 256 + lane * 4) = v[j]; }
        const int bb = row_bb(row); const float* sh = mod_ptr(p, l, bb, seg_sh); const float* sc = mod_ptr(p, l, bb, seg_sc);
        bf16_t* h = WSP(bf16_t, WS_H) + (size_t)row * DM;
#pragma unroll
        for (int j = 0; j < 4; ++j) { const int c = j * 256 + lane * 4;
            const f32x4v gv = *(const f32x4v*)(gain + c), scv = *(const f32x4v*)(sc + c), shv = *(const f32x4v*)(sh + c);
            float o[4];
#pragma unroll
            for (int e = 0; e < 4; ++e) o[e] = v[j][e] * rinv * gv[e] * (1.f + scv[e]) + shv[e];
            if (which != 1) *(uint2*)(h + c) = make_uint2(pk2(o[0], o[1]), pk2(o[2], o[3]));
            { int pk = 0;
                pk = __builtin_amdgcn_cvt_pk_fp8_f32(fminf(fmaxf(o[0], -448.f), 448.f), fminf(fmaxf(o[1], -448.f), 448.f), pk, false);
                pk = __builtin_amdgcn_cvt_pk_fp8_f32(fminf(fmaxf(o[2], -448.f), 448.f), fminf(fmaxf(o[3], -448.f), 448.f), pk, true);
                *(unsigned*)(p.ws + (which == 1 ? WS_H8 : WS_H8B) + (size_t)row * DM + c) = (unsigned)pk; } }
    }
}
__device__ __forceinline__ void mod_phase(const Params& p, PG8_LAS unsigned char* lds, int wave_s) {
    int tid_ = tid_of(wave_s); asm volatile("" : "+v"(tid_));
    const int lane = tid_ & 63, wid = tid_ >> 6;
    PG8_LAS float* sl = (PG8_LAS float*)lds;
    PG8_LAS float* red = (PG8_LAS float*)(lds + 32768);
    for (int i = tid_; i < (B_ + 1) * DM; i += NTHREADS) { const int b = i / DM, d = i % DM; sl[i] = siluf_(b < B_ ? p.in[I_C][b * DM + d] : p.in[I_CCTX][d]); }
    __syncthreads();
    for (int it = blockIdx.x; it < DEPTH * 96; it += gridDim.x) {
        const int l = it / 96, col = (it % 96) * 64 + lane;
        const float* w = p.in[I_ADAW] + (size_t)l * DM * 6144 + col;
        float acc[B_ + 1];
#pragma unroll
        for (int b = 0; b <= B_; ++b) acc[b] = 0.f;
#pragma unroll 8
        for (int dd = 0; dd < 128; ++dd) { const int d = wid * 128 + dd; const float wv = w[(size_t)d * 6144];
#pragma unroll
            for (int b = 0; b <= B_; ++b) acc[b] += sl[b * DM + d] * wv; }
#pragma unroll
        for (int b = 0; b <= B_; ++b) red[(wid * (B_ + 1) + b) * 64 + lane] = acc[b];
        __syncthreads();
        if (tid_ < (B_ + 1) * 64) { const int b = tid_ / 64, c = tid_ % 64; float s = 0.f;
#pragma unroll
            for (int w8 = 0; w8 < 8; ++w8) s += red[(w8 * (B_ + 1) + b) * 64 + c];
            const int cc = (it % 96) * 64 + c;
            WSP(float, WS_MOD)[((size_t)(l * (B_ + 1) + b)) * 6144 + cc] = s + p.in[I_ADAB][l * 6144 + cc]; }
        __syncthreads();
    }
}
__device__ __forceinline__ void peer_phase(const Params& p, int l, int nrows, PG8_LAS unsigned char* lds, bool last, int wave_s) {
    int tid_ = tid_of(wave_s); asm volatile("" : "+v"(tid_));
    const int lane = tid_ & 63, wid = __builtin_amdgcn_readfirstlane(tid_ >> 6), j = lane & 7, g = lane >> 3;
    PG8_LAS float* wb = (PG8_LAS float*)(lds + wid * 1024); PG8_LAS int* eb = (PG8_LAS int*)(lds + wid * 1024 + 512);
    const bf16_t* UT = WSP(const bf16_t, WS_UT); const bf16_t* VT = WSP(const bf16_t, WS_VT); const bf16_t* H2 = WSP(const bf16_t, WS_H);
    const unsigned short* EI = WSP(const unsigned short, WS_EIDX); const float* GWp = WSP(const float, WS_GW);
    for (int row = blockIdx.x * 8 + wid; row < nrows; row += gridDim.x * 8) {
        u32x4 hq[16];
        { const bf16_t* hp = H2 + (size_t)row * DM + j * 8;
#pragma unroll
          for (int i = 0; i < 16; ++i) hq[i] = *(const u32x4*)(hp + i * 64); }
        for (int bt = 0; bt < 16; ++bt) {
            const int e = EI[(size_t)row * 128 + bt * 8 + g];
            const bf16_t* up = UT + (size_t)e * 1024 + j * 8;
            u32x4 uu[16];
#pragma unroll
            for (int i = 0; i < 16; ++i) uu[i] = *(const u32x4*)(up + i * 64);
            float a0 = 0.f, a1 = 0.f;
#pragma unroll
            for (int i = 0; i < 16; ++i)
#pragma unroll
                for (int c = 0; c < 4; ++c) { a0 += u2f(uu[i][c] << 16) * u2f(hq[i][c] << 16); a1 += u2f(uu[i][c] & 0xffff0000u) * u2f(hq[i][c] & 0xffff0000u); }
            float acc = a0 + a1;
            acc += shx(acc, 1, lane); acc += shx(acc, 2, lane); acc += shx(acc, 4, lane);
            const float w = GWp[(size_t)row * 128 + bt * 8 + g] * gelu_tanh(acc);
            if (j == 0) { wb[bt * 8 + g] = w; eb[bt * 8 + g] = e; }
        }
        asm volatile("s_waitcnt lgkmcnt(0)" ::: "memory");
        float out[16];
#pragma unroll
        for (int i = 0; i < 16; ++i) out[i] = 0.f;
        for (int bt = 0; bt < 16; ++bt) {
            u32x4 v0[8], v1[8]; float wk[8];
#pragma unroll
            for (int k = 0; k < 8; ++k) { const int e = __builtin_amdgcn_readfirstlane(eb[bt * 8 + k]); wk[k] = wb[bt * 8 + k];
                const bf16_t* vp = VT + (size_t)e * 1024 + lane * 16; v0[k] = *(const u32x4*)vp; v1[k] = *(const u32x4*)(vp + 8); }
#pragma unroll
            for (int k = 0; k < 8; ++k)
#pragma unroll
                for (int c = 0; c < 4; ++c) {
                    out[2 * c] += wk[k] * u2f(v0[k][c] << 16); out[2 * c + 1] += wk[k] * u2f(v0[k][c] & 0xffff0000u);
                    out[8 + 2 * c] += wk[k] * u2f(v1[k][c] << 16); out[8 + 2 * c + 1] += wk[k] * u2f(v1[k][c] & 0xffff0000u); }
        }
        asm volatile("" ::: "memory");
        float* x = xr_row(p, row) + lane * 16; const float* g2 = mod_ptr(p, l, row_bb(row), 5) + lane * 16;
        f32x4v xv[4]; float ss = 0.f;
#pragma unroll
        for (int q = 0; q < 4; ++q) { xv[q] = *(const f32x4v*)(x + q * 4); const f32x4v gv = *(const f32x4v*)(g2 + q * 4);
#pragma unroll
            for (int e = 0; e < 4; ++e) { xv[q][e] += gv[e] * out[q * 4 + e]; ss += xv[q][e] * xv[q][e]; } }
        if (last) { ss = wave_sum(ss, lane); const float rinv = 1.f / sqrtf(ss * (1.f / DM) + RMS_EPS); const float* fg = p.in[I_FNG] + lane * 16;
#pragma unroll
            for (int q = 0; q < 4; ++q) { const f32x4v gv = *(const f32x4v*)(fg + q * 4);
#pragma unroll
                for (int e = 0; e < 4; ++e) xv[q][e] = xv[q][e] * rinv * gv[e]; } }
#pragma unroll
        for (int q = 0; q < 4; ++q) *(f32x4v*)(x + q * 4) = xv[q];
    }
}

typedef float f2v __attribute__((ext_vector_type(2)));
__device__ __forceinline__ void tables8_phase(const Params& p, int l, long tid, long nthr) {
    const long n16 = (long)16384 * 1024 / 16;
    for (long it = tid; it < 2 * n16; it += nthr) {
        const int w = it >= n16; const long i = it - (w ? n16 : 0);
        const float* src = p.in[w ? I_PV : I_PU] + (size_t)l * 16384 * 1024 + i * 16; const float sc = w ? 16.f : 256.f;
        u32x4 o;
#pragma unroll
        for (int c = 0; c < 4; ++c) { const f32x4v v = *(const f32x4v*)(src + c * 4); int pk = 0;
            pk = __builtin_amdgcn_cvt_pk_fp8_f32(fminf(fmaxf(v[0] * sc, -448.f), 448.f), fminf(fmaxf(v[1] * sc, -448.f), 448.f), pk, false);
            pk = __builtin_amdgcn_cvt_pk_fp8_f32(fminf(fmaxf(v[2] * sc, -448.f), 448.f), fminf(fmaxf(v[3] * sc, -448.f), 448.f), pk, true);
            o[c] = (unsigned)pk; }
        *(u32x4*)(p.ws + (w ? WS_VT : WS_UT) + i * 16) = o;
    }
}
__device__ __forceinline__ void peer8_phase(const Params& p, int l, int nrows, PG8_LAS unsigned char* lds, bool last, int wave_s) {
    int tid_ = tid_of(wave_s); asm volatile("" : "+v"(tid_));
    const int lane = tid_ & 63, wid = __builtin_amdgcn_readfirstlane(tid_ >> 6), j = lane & 7, g = lane >> 3;
    PG8_LAS float* wb = (PG8_LAS float*)(lds + wid * 1024); PG8_LAS int* eb = (PG8_LAS int*)(lds + wid * 1024 + 512);
    const unsigned char* UT8 = p.ws + WS_UT; const unsigned char* VT8 = p.ws + WS_VT; const bf16_t* H2 = WSP(const bf16_t, WS_H);
    const unsigned short* EI = WSP(const unsigned short, WS_EIDX); const float* GWp = WSP(const float, WS_GW);
    for (int row = blockIdx.x * 8 + wid; row < nrows; row += gridDim.x * 8) {
        f2v hf[64];
        { const bf16_t* hp = H2 + (size_t)row * DM + j * 16;
#pragma unroll
          for (int i = 0; i < 8; ++i) { const u32x4 t0 = *(const u32x4*)(hp + i * 128), t1 = *(const u32x4*)(hp + i * 128 + 8);
#pragma unroll
              for (int c = 0; c < 4; ++c) { hf[i * 8 + c] = (f2v){u2f(t0[c] << 16), u2f(t0[c] & 0xffff0000u)}; hf[i * 8 + 4 + c] = (f2v){u2f(t1[c] << 16), u2f(t1[c] & 0xffff0000u)}; } } }
        for (int bt = 0; bt < 8; ++bt) {
            const int e0 = EI[(size_t)row * 128 + bt * 16 + g], e1 = EI[(size_t)row * 128 + bt * 16 + 8 + g];
            const unsigned char* u0 = UT8 + (size_t)e0 * 1024 + j * 16; const unsigned char* u1 = UT8 + (size_t)e1 * 1024 + j * 16;
            u32x4 ua[8], ub[8];
#pragma unroll
            for (int i = 0; i < 8; ++i) { ua[i] = *(const u32x4*)(u0 + i * 128); ub[i] = *(const u32x4*)(u1 + i * 128); }
            f2v acc0 = {0.f, 0.f}, acc1 = {0.f, 0.f};
#pragma unroll
            for (int i = 0; i < 8; ++i)
#pragma unroll
                for (int c = 0; c < 4; ++c) {
                    acc0 += __builtin_amdgcn_cvt_pk_f32_fp8((int)ua[i][c], false) * hf[i * 8 + 2 * c]; acc0 += __builtin_amdgcn_cvt_pk_f32_fp8((int)ua[i][c], true) * hf[i * 8 + 2 * c + 1];
                    acc1 += __builtin_amdgcn_cvt_pk_f32_fp8((int)ub[i][c], false) * hf[i * 8 + 2 * c]; acc1 += __builtin_amdgcn_cvt_pk_f32_fp8((int)ub[i][c], true) * hf[i * 8 + 2 * c + 1]; }
            float d0 = acc0[0] + acc0[1], d1 = acc1[0] + acc1[1];
            d0 += shx(d0, 1, lane); d1 += shx(d1, 1, lane); d0 += shx(d0, 2, lane); d1 += shx(d1, 2, lane); d0 += shx(d0, 4, lane); d1 += shx(d1, 4, lane);
            const float w0 = GWp[(size_t)row * 128 + bt * 16 + g] * gelu_tanh(d0 * (1.f / 256.f)), w1 = GWp[(size_t)row * 128 + bt * 16 + 8 + g] * gelu_tanh(d1 * (1.f / 256.f));
            if (j == 0) { wb[bt * 16 + g] = w0; eb[bt * 16 + g] = e0; wb[bt * 16 + 8 + g] = w1; eb[bt * 16 + 8 + g] = e1; }
        }
        asm volatile("s_waitcnt lgkmcnt(0)" ::: "memory");
        f2v out2[8];
#pragma unroll
        for (int q = 0; q < 8; ++q) out2[q] = (f2v){0.f, 0.f};
        for (int bt = 0; bt < 8; ++bt) {
            u32x4 vv[16]; float wk[16];
#pragma unroll
            for (int k = 0; k < 16; ++k) { const int e = __builtin_amdgcn_readfirstlane(eb[bt * 16 + k]); wk[k] = wb[bt * 16 + k]; vv[k] = *(const u32x4*)(VT8 + (size_t)e * 1024 + lane * 16); }
#pragma unroll
            for (int k = 0; k < 16; ++k) { const f2v w2 = {wk[k], wk[k]};
#pragma unroll
                for (int c = 0; c < 4; ++c) { out2[2 * c] += w2 * __builtin_amdgcn_cvt_pk_f32_fp8((int)vv[k][c], false); out2[2 * c + 1] += w2 * __builtin_amdgcn_cvt_pk_f32_fp8((int)vv[k][c], true); } }
        }
        asm volatile("" ::: "memory");
        float* x = xr_row(p, row) + lane * 16; const float* g2 = mod_ptr(p, l, row_bb(row), 5) + lane * 16;
        f32x4v xv[4]; float ss = 0.f;
#pragma unroll
        for (int q = 0; q < 4; ++q) { xv[q] = *(const f32x4v*)(x + q * 4); const f32x4v gv = *(const f32x4v*)(g2 + q * 4);
            xv[q][0] += gv[0] * out2[2 * q][0] * (1.f / 16.f); xv[q][1] += gv[1] * out2[2 * q][1] * (1.f / 16.f); xv[q][2] += gv[2] * out2[2 * q + 1][0] * (1.f / 16.f); xv[q][3] += gv[3] * out2[2 * q + 1][1] * (1.f / 16.f);
#pragma unroll
            for (int e = 0; e < 4; ++e) ss += xv[q][e] * xv[q][e]; }
        if (last) { ss = wave_sum(ss, lane); const float rinv = 1.f / sqrtf(ss * (1.f / DM) + RMS_EPS); const float* fg = p.in[I_FNG] + lane * 16;
#pragma unroll
            for (int q = 0; q < 4; ++q) { const f32x4v gv = *(const f32x4v*)(fg + q * 4);
#pragma unroll
                for (int e = 0; e < 4; ++e) xv[q][e] = xv[q][e] * rinv * gv[e]; } }
#pragma unroll
        for (int q = 0; q < 4; ++q) *(f32x4v*)(x + q * 4) = xv[q];
    }
}

constexpr int NSL = 8;
constexpr size_t WS_PART = WS_SC;
static_assert((size_t)NSL * NR * 128 * 4 <= (size_t)NR * 2048 * 2, "PART fits the score buffer");
struct XInfo { int xi, nx, rank, nloc; };
__device__ __forceinline__ void tables8s_phase(const Params& p, int l, long tid, long nthr) {
    const long n16 = (long)16384 * 1024 / 16;
    for (long it = tid; it < 2 * n16; it += nthr) {
        const int w = it >= n16; const long i = it - (w ? n16 : 0);
        const float GPTR* src = p.in[w ? I_PV : I_PU] + (size_t)l * 16384 * 1024 + i * 16; const float sc = w ? 16.f : 256.f;
        u32x4 o;
#pragma unroll
        for (int c = 0; c < 4; ++c) { const f32x4v v = *(const f32x4v GPTR*)(src + c * 4); int pk = 0;
            pk = __builtin_amdgcn_cvt_pk_fp8_f32(fminf(fmaxf(v[0] * sc, -448.f), 448.f), fminf(fmaxf(v[1] * sc, -448.f), 448.f), pk, false);
            pk = __builtin_amdgcn_cvt_pk_fp8_f32(fminf(fmaxf(v[2] * sc, -448.f), 448.f), fminf(fmaxf(v[3] * sc, -448.f), 448.f), pk, true);
            o[c] = (unsigned)pk; }
        const long e = i >> 6; const int ch = (int)(i & 63), sl = ch >> 3, within = (ch & 7) * 16;
        *(u32x4 GPTR*)(p.ws + (w ? WS_VT : WS_UT) + ((size_t)sl * 16384 + e) * 128 + within) = o;
    }
}
#define XR_STEP(v, n, bit, msk) _Pragma("unroll") for (int k_ = 0; k_ < (n); ++k_) { const float send_ = (bit) ? v[k_] : v[(n) + k_]; const float keep_ = (bit) ? v[(n) + k_] : v[k_]; v[k_] = keep_ + shx(send_, msk, lane); }
__device__ __forceinline__ void peer_u_phase(const Params& p, int nrows, const XInfo xi, PG8_LAS unsigned char* lds, int wave_s) {
    typedef int i32x8 __attribute__((ext_vector_type(8))); typedef int i32x4 __attribute__((ext_vector_type(4))); typedef float f32x4m __attribute__((ext_vector_type(4)));
    int tid_ = tid_of(wave_s); asm volatile("" : "+v"(tid_));
    const int lane = tid_ & 63, wid = __builtin_amdgcn_readfirstlane(tid_ >> 6), q = lane >> 3, pc = lane & 7, m = lane & 15, kg = lane >> 4;
    const unsigned short GPTR* EI = (const unsigned short GPTR*)(p.ws + WS_EIDX); const unsigned char GPTR* H8 = (const unsigned char GPTR*)(p.ws + WS_H8B);
    int sc_ = 0x7f7f7f7f; asm volatile("" : "+v"(sc_));
    const int gq = ((q >> 1) & 1) + ((q >> 2) & 1) * 4, gm = ((m >> 1) & 1) + ((m >> 2) & 1) * 4;
    PG8_LAS unsigned char* const wl = lds + wid * 16384;
    const unsigned rbase = (unsigned)((m & 7) * 128 + (m >> 3) * 8192), ro0 = rbase + (unsigned)(((2 * kg) ^ gm) * 16), ro1 = rbase + (unsigned)(((2 * kg + 1) ^ gm) * 16);
    for (int sl = xi.xi; sl < NSL; sl += xi.nx) {
        const unsigned char GPTR* UT = p.ws + WS_UT + (size_t)sl * 16384 * 128 + (pc ^ gq) * 16;
        float GPTR* PART = (float GPTR*)(p.ws + WS_PART) + (size_t)sl * NR * 128;
        for (int row = xi.rank * 8 + wid; row < nrows; row += xi.nloc * 8) {
            const u32x4 ev0 = *(const u32x4 GPTR*)(EI + (size_t)row * 128 + q * 16), ev1 = *(const u32x4 GPTR*)(EI + (size_t)row * 128 + q * 16 + 8);
            const unsigned char GPTR* hp = H8 + (size_t)row * DM + sl * 128 + kg * 32;
            const i32x8 hb = __builtin_shufflevector(*(const i32x4 GPTR*)hp, *(const i32x4 GPTR*)(hp + 16), 0, 1, 2, 3, 4, 5, 6, 7);
#pragma unroll
            for (int i = 0; i < 16; ++i) { const unsigned wrd = i < 8 ? ev0[i >> 1] : ev1[(i - 8) >> 1]; const unsigned e = (i & 1) ? (wrd >> 16) : (wrd & 0xffffu);
                __builtin_amdgcn_global_load_lds((const unsigned GPTR*)(UT + (size_t)e * 128), (PG8_LAS unsigned*)(wl + i * 1024), 16, 0, 0); }
            asm volatile("s_waitcnt vmcnt(0)" ::: "memory");
            f32x4m acc[8];
#pragma unroll
            for (int G = 0; G < 8; ++G) { const i32x8 ua = __builtin_shufflevector(*(const PG8_LAS i32x4*)(wl + G * 1024 + ro0), *(const PG8_LAS i32x4*)(wl + G * 1024 + ro1), 0, 1, 2, 3, 4, 5, 6, 7);
                acc[G] = __builtin_amdgcn_mfma_scale_f32_16x16x128_f8f6f4(ua, hb, (f32x4m){0.f, 0.f, 0.f, 0.f}, 0, 0, 0, sc_, 0, sc_); }
            if (m == 0) {
#pragma unroll
                for (int i = 0; i < 4; ++i) { const int mm = 4 * kg + i; float GPTR* d = PART + (size_t)row * 128 + (mm & 7) * 16 + (mm >> 3) * 8;
                    *(f32x4m GPTR*)d = (f32x4m){acc[0][i], acc[1][i], acc[2][i], acc[3][i]}; *(f32x4m GPTR*)(d + 4) = (f32x4m){acc[4][i], acc[5][i], acc[6][i], acc[7][i]}; } }
            asm volatile("s_waitcnt lgkmcnt(0)" ::: "memory");
        }
    }
}
__device__ __forceinline__ void peer_comb_phase(const Params& p, int nrows, long tid, long nthr) {
    const float GPTR* PART = (const float GPTR*)(p.ws + WS_PART); float GPTR* GWp = (float GPTR*)(p.ws + WS_GW);
    for (long it = tid; it < (long)nrows * 32; it += nthr) {
        f32x4v a = *(const f32x4v GPTR*)(PART + it * 4);
#pragma unroll
        for (int sl = 1; sl < NSL; ++sl) a += *(const f32x4v GPTR*)(PART + (size_t)sl * NR * 128 + it * 4);
        f32x4v gw = *(const f32x4v GPTR*)(GWp + it * 4);
#pragma unroll
        for (int e = 0; e < 4; ++e) gw[e] *= gelu_tanh(a[e] * (1.f / 256.f));
        int pk = 0;
        pk = __builtin_amdgcn_cvt_pk_fp8_f32(fminf(fmaxf(gw[0] * 64.f, -448.f), 448.f), fminf(fmaxf(gw[1] * 64.f, -448.f), 448.f), pk, false);
        pk = __builtin_amdgcn_cvt_pk_fp8_f32(fminf(fmaxf(gw[2] * 64.f, -448.f), 448.f), fminf(fmaxf(gw[3] * 64.f, -448.f), 448.f), pk, true);
        const long row = it >> 5; const int s0 = (int)(it & 31) * 4, q = s0 >> 4, i0 = s0 & 15;
        unsigned char GPTR* d = (unsigned char GPTR*)(p.ws + WS_GW8) + row * 128 + 8 * i0 + q;
        d[0] = (unsigned char)(pk & 255); d[8] = (unsigned char)((pk >> 8) & 255); d[16] = (unsigned char)((pk >> 16) & 255); d[24] = (unsigned char)((unsigned)pk >> 24);
    }
}
__device__ __forceinline__ void peer_v_phase(const Params& p, int l, int nrows, const XInfo xi, PG8_LAS unsigned char* lds, int wave_s) {
    typedef int i32x8 __attribute__((ext_vector_type(8))); typedef int i32x4 __attribute__((ext_vector_type(4))); typedef int i32x2 __attribute__((ext_vector_type(2))); typedef float f32x4m __attribute__((ext_vector_type(4)));
    int tid_ = tid_of(wave_s); asm volatile("" : "+v"(tid_));
    const int lane = tid_ & 63, wid = __builtin_amdgcn_readfirstlane(tid_ >> 6), q = lane >> 3, pc = lane & 7, m = lane & 15, kg = lane >> 4, r = m >> 1, cc = m & 1, n7 = m & 7;
    const unsigned short GPTR* EI = (const unsigned short GPTR*)(p.ws + WS_EIDX); const unsigned char GPTR* W8 = (const unsigned char GPTR*)(p.ws + WS_GW8);
    int sca_ = 0x7b7b7b7b, scb_ = 0x79797979; asm volatile("" : "+v"(sca_), "+v"(scb_));
    const int gq = ((q >> 1) & 1) + ((q >> 2) & 1) * 4, gr = ((r >> 1) & 1) + ((r >> 2) & 1) * 4;
    PG8_LAS unsigned char* const wl = lds + wid * 16384;
    const unsigned tro = (unsigned)((32 * kg + r) * 128 + 8 * cc);
    for (int sl = xi.xi; sl < NSL; sl += xi.nx) {
        const unsigned char GPTR* VT = p.ws + WS_VT + (size_t)sl * 16384 * 128 + (pc ^ gq) * 16;
        for (int row = xi.rank * 8 + wid; row < nrows; row += xi.nloc * 8) {
            const u32x4 ev0 = *(const u32x4 GPTR*)(EI + (size_t)row * 128 + q * 16), ev1 = *(const u32x4 GPTR*)(EI + (size_t)row * 128 + q * 16 + 8);
            const unsigned char GPTR* wp = W8 + (size_t)row * 128 + kg * 32;
            const i32x8 wb = __builtin_shufflevector(*(const i32x4 GPTR*)wp, *(const i32x4 GPTR*)(wp + 16), 0, 1, 2, 3, 4, 5, 6, 7);
            const int col = sl * 128 + 16 * n7 + 4 * kg;
            float* x = xr_row(p, row) + col; const float* g2 = mod_ptr(p, l, row_bb(row), 5) + col;
            const f32x4m xv = *(const f32x4m*)x, gv = *(const f32x4m*)g2;
#pragma unroll
            for (int i = 0; i < 16; ++i) { const unsigned wrd = i < 8 ? ev0[i >> 1] : ev1[(i - 8) >> 1]; const unsigned e = (i & 1) ? (wrd >> 16) : (wrd & 0xffffu);
                __builtin_amdgcn_global_load_lds((const unsigned GPTR*)(VT + (size_t)e * 128), (PG8_LAS unsigned*)(wl + i * 1024), 16, 0, 0); }
            asm volatile("s_waitcnt vmcnt(0)" ::: "memory");
            f32x4m acc[8];
#pragma unroll
            for (int c = 0; c < 8; ++c) { const PG8_LAS unsigned char* ap = wl + tro + ((c ^ gr) * 16);
                const i32x2 a0 = __builtin_amdgcn_ds_read_tr8_b64_v2i32((PG8_LAS i32x2*)(ap)), a1 = __builtin_amdgcn_ds_read_tr8_b64_v2i32((PG8_LAS i32x2*)(ap + 1024)),
                            a2 = __builtin_amdgcn_ds_read_tr8_b64_v2i32((PG8_LAS i32x2*)(ap + 2048)), a3 = __builtin_amdgcn_ds_read_tr8_b64_v2i32((PG8_LAS i32x2*)(ap + 3072));
                const i32x8 va = {a0[0], a0[1], a1[0], a1[1], a2[0], a2[1], a3[0], a3[1]};
                acc[c] = __builtin_amdgcn_mfma_scale_f32_16x16x128_f8f6f4(va, wb, (f32x4m){0.f, 0.f, 0.f, 0.f}, 0, 0, 0, sca_, 0, scb_); }
            f32x4m sel = acc[0];
#pragma unroll
            for (int c = 1; c < 8; ++c) { const bool t_ = (n7 == c);
#pragma unroll
                for (int i = 0; i < 4; ++i) sel[i] = t_ ? acc[c][i] : sel[i]; }
            if (m < 8) *(f32x4m*)x = xv + gv * sel;
            asm volatile("s_waitcnt lgkmcnt(0)" ::: "memory");
        }
    }
}
__device__ __forceinline__ void final_norm_phase(const Params& p, int wave_s) {
    int tid_ = tid_of(wave_s); asm volatile("" : "+v"(tid_));
    const int lane = tid_ & 63, wid = tid_ >> 6;
    for (int row = blockIdx.x * 8 + wid; row < NRL; row += gridDim.x * 8) {
        float GPTR* x = p.out + (size_t)row * DM; f32x4v v[4]; float ss = 0.f;
#pragma unroll
        for (int q = 0; q < 4; ++q) { v[q] = *(const f32x4v GPTR*)(x + q * 256 + lane * 4); ss += v[q][0] * v[q][0] + v[q][1] * v[q][1] + v[q][2] * v[q][2] + v[q][3] * v[q][3]; }
        ss = wave_sum(ss, lane); const float rinv = 1.f / sqrtf(ss * (1.f / DM) + RMS_EPS);
#pragma unroll
        for (int q = 0; q < 4; ++q) { const f32x4v gv = *(const f32x4v GPTR*)(p.in[I_FNG] + q * 256 + lane * 4);
#pragma unroll
            for (int e = 0; e < 4; ++e) v[q][e] = v[q][e] * rinv * gv[e];
            *(f32x4v GPTR*)(x + q * 256 + lane * 4) = v[q]; }
    }
}
__device__ __forceinline__ void carry_phase(const Params& p, int wave_s) {
    int tid_ = tid_of(wave_s); asm volatile("" : "+v"(tid_));
    if (tid_ >= 64) return;
    for (int wv = blockIdx.x; wv < B_ * 16 * 2; wv += gridDim.x) {
        const int n = tid_, dir = wv & 1, g = (wv >> 1) & 15, b = wv >> 5;
        const size_t sn = (size_t)(dir * 16 + g) * 64 + n;
        const float lr = WSP(const float, WS_POW)[(sn * 33 + 32) * 2], li = WSP(const float, WS_POW)[(sn * 33 + 32) * 2 + 1];
        float sr = 0.f, si = 0.f;
        constexpr int nsteps = CCH + LCH;
        constexpr int CB = (nsteps % 24 == 0) ? 24 : 8;
        static_assert(nsteps % CB == 0, "carry unroll");
        for (int s0 = 0; s0 < nsteps; s0 += CB) {
            float2 sl[CB]; int ch[CB];
#pragma unroll
            for (int k = 0; k < CB; ++k) { const int s = s0 + k;
                ch[k] = dir == 0 ? (s < CCH ? NRL / TCH + b * CCH + s : b * LCH + (s - CCH)) : (s < CCH ? NRL / TCH + b * CCH + (CCH - 1 - s) : b * LCH + (LCH - 1 - (s - CCH)));
                sl[k] = *(const float2*)(WSP(const float, WS_SLOC) + ((size_t)(g * NCH + ch[k])) * 256 + dir * 128 + n * 2); }
#pragma unroll
            for (int k = 0; k < CB; ++k) {
                *(unsigned*)(WSP(bf16_t, WS_ASSM) + ((size_t)(g * NCH + ch[k])) * KSS + 512 + dir * 128 + n * 2) = pk2(sr, si);
                const float nr = lr * sr - li * si + sl[k].x, ni = lr * si + li * sr + sl[k].y; sr = nr; si = ni; }
        }
    }
}
}

constexpr int LDS_BYTES = 147456, LDS_BAR_OFF = 131072;
#ifndef USE_MFMA_GEMM
#define USE_MFMA_GEMM 1
#endif
#ifndef USE_FAST_PEER
#define USE_FAST_PEER 1
#endif
#if USE_MFMA_GEMM
#define GEMM_FLAT(EpiT, einit, Aoff, lda_, Boff, ldb_, Mrows, Ncols, K_) do { pg8::Gemm g_{WSP(const bf16_t, Aoff), WSP(const bf16_t, Boff), (int)(lda_), (int)(ldb_), (int)(K_)}; \
        SchedFlat S_; S_.init((Mrows) / 256, (Ncols) / 256, (int)gridDim.x, (int)blockIdx.x); EpiAdapt<EpiT> E_{EpiT einit}; \
        pg8::gemm_phase<EpiAdapt<EpiT>, SchedFlat, PG8_ALIGN, PG8_SP2>(lds, g_, S_, E_, tid_of(wave_s)); } while (0)
#define GEMM_GROUPED(EpiT, einit, Boff, ldb_, brows_, tn_, K_) do { pg8::Gemm g_{WSP(const bf16_t, WS_ASSM), WSP(const bf16_t, Boff), KSS, (int)(ldb_), (int)(K_)}; \
        SchedGrouped S_{NCHP / 256, (tn_), NCH, (brows_), (int)gridDim.x, (int)blockIdx.x}; EpiAdapt<EpiT> E_{EpiT einit}; \
        pg8::gemm_phase<EpiAdapt<EpiT>, SchedGrouped, PG8_ALIGN, PG8_SP2>(lds, g_, S_, E_, tid_of(wave_s)); } while (0)
#else
#define GEMM_FLAT(EpiT, einit, Aoff, lda_, Boff, ldb_, Mrows, Ncols, K_) do { EpiT e_ einit; naive_gemm(WSP(const bf16_t, Aoff), lda_, WSP(const bf16_t, Boff), ldb_, Mrows, Ncols, K_, e_, tid, nthr); } while (0)
#define GEMM_GROUPED(EpiT, einit, Boff, ldb_, brows_, tn_, K_) do { for (int g__ = 0; g__ < 16; ++g__) { EpiT e_ einit; e_.set_group(g__); \
        naive_gemm(WSP(const bf16_t, WS_ASSM) + (size_t)g__ * NCH * KSS, KSS, WSP(const bf16_t, Boff) + (size_t)g__ * (brows_) * (ldb_), ldb_, NCH, (tn_) * 256, K_, e_, tid, nthr); } } while (0)
#endif

__global__ void __launch_bounds__(NTHREADS, 2) mega_fwd(ParamsH p0) {
    Params p;
#pragma unroll
    for (int i = 0; i < 30; ++i) p.in[i] = (const float GPTR*)p0.in[i];
    p.out = (float GPTR*)p0.out; p.ws = (unsigned char GPTR*)p0.ws;
    extern __shared__ __attribute__((aligned(16))) unsigned char lds_raw[];
    PG8_LAS unsigned char* lds = (PG8_LAS unsigned char*)lds_raw;
    const int wave_s = __builtin_amdgcn_readfirstlane((int)threadIdx.x >> 6);
    if (tid_of(wave_s) < 4) ((volatile LAS unsigned*)(lds + LDS_BAR_OFF))[tid_of(wave_s)] = 0u;
    __syncthreads();
    (void)xcd_barrier_post((unsigned*)(p.ws + WS_CTL), (volatile LAS unsigned*)(lds + LDS_BAR_OFF), tid_of(wave_s));
    long nthr, tid;
#define REFRESH() do { int t_ = tid_of(wave_s); asm volatile("" : "+v"(t_)); int g_ = gridDim.x; asm volatile("" : "+s"(g_)); tid = (long)blockIdx.x * NTHREADS + t_; nthr = (long)g_ * NTHREADS; \
        unsigned char* w_ = p0.ws; asm volatile("" : "+s"(w_)); p.ws = (unsigned char GPTR*)w_; float* o_ = p0.out; asm volatile("" : "+s"(o_)); p.out = (float GPTR*)o_; } while (0)
#define GBAR() do { asm volatile("; PHASE_MARK %0" :: "i"(__LINE__)); { XcdBarrier b_; b_.bar = (unsigned*)(p.ws + WS_CTL); b_.x = xb_xcc_id(); b_.st = (volatile LAS unsigned*)(lds + LDS_BAR_OFF); xcd_barrier(b_, tid_of(wave_s)); } REFRESH(); } while (0)
    REFRESH();
#ifndef DUP_MASK
#define DUP_MASK 0
#endif
#define DUP(bit, stmt) do { stmt; if (DUP_MASK & (1 << (bit))) { stmt; } } while (0)
    if (tid_of(wave_s) == 0) { const unsigned r_ = xb_add((unsigned*)(p.ws + WS_CTL) + 8192 + 64 * xb_xcc_id(), 1u); ((volatile LAS unsigned*)(lds + LDS_BAR_OFF))[4] = r_; }
    DUP(14, fastp::mod_phase(p, lds, wave_s); REFRESH()); ph_mod_small(p, tid, nthr); GBAR();
    fastp::XInfo xinf;
    { unsigned mine = xb_xcc_id(), xi_ = 0, nx_ = 0, nl_ = 1;
#pragma unroll
      for (unsigned j_ = 0; j_ < 16; ++j_) { const unsigned c_ = xb_ld((unsigned*)(p.ws + WS_CTL) + XB_XCNT(j_)); nx_ += c_ > 0u; xi_ += (c_ > 0u && j_ < mine); nl_ = (j_ == mine) ? c_ : nl_; }
      xinf.xi = __builtin_amdgcn_readfirstlane((int)xi_); xinf.nx = __builtin_amdgcn_readfirstlane((int)(nx_ ? nx_ : 1u)); xinf.nloc = __builtin_amdgcn_readfirstlane((int)(nl_ ? nl_ : 1u));
      xinf.rank = __builtin_amdgcn_readfirstlane((int)((volatile LAS unsigned*)(lds + LDS_BAR_OFF))[4]); }
    for (int l = 0; l < DEPTH; ++l) {
        const int nact = (l == 0) ? NR : NRL;
        DUP(0, ph_prep_a(p, l, tid, nthr)); DUP(2, fastp::norm_phase(p, l, 1, NR, l == 0, wave_s); REFRESH()); GBAR();
        DUP(1, ph_prep_b(p, l, tid, nthr));
        { pg8::Gemm g_{WSP(const bf16_t, WS_SKA), WSP(const bf16_t, WS_WQB), 256, 2048, 256}; SchedWsc S_{(int)gridDim.x, (int)blockIdx.x}; EpiAdapt<EpiWsc> E_{EpiWsc{p}};
          pg8::gemm_phase<EpiAdapt<EpiWsc>, SchedWsc, PG8_ALIGN, PG8_SP2>(lds, g_, S_, E_, tid_of(wave_s)); }
        {
          pg8::Gemm g_{(const bf16_t*)(p.ws + WS_H8), (const bf16_t*)(p.ws + WS_WG8), DM / 2, DM / 2, DM / 2};
          SchedFlat S_; S_.init(NR / 256, INW / 256, (int)gridDim.x, (int)blockIdx.x); EpiAdapt<EpiWinG> E_{EpiWinG{p}};
          DUP(3, (pg8::gemm_phase<EpiAdapt<EpiWinG>, SchedFlat, PG8_ALIGN, PG8_SP2, true>(lds, g_, S_, E_, tid_of(wave_s)))); }
        GBAR();
        DUP(1, ph_prep_c(p, l, tid, nthr));
        DUP(4, GEMM_GROUPED(EpiSsm1, ({p, 0}), WS_BT1, 512, 256, 1, 512));
        DUP(5, dattn::diff_phase(p, l, lds, wave_s); REFRESH());
        DUP(6, nattn::na_phase(p, l, lds, wave_s); REFRESH()); GBAR();
        DUP(7, fastp::carry_phase(p, wave_s); REFRESH()); DUP(10, fastp::tables8s_phase(p, l, tid, nthr)); GBAR();
        DUP(8, GEMM_GROUPED(EpiSsm2, ({p, 0}), WS_BT2, KSS, 512, 2, KSS)); GBAR();
        DUP(9, GEMM_FLAT(EpiGlu, {p}, WS_YG, 256, WS_WGLU, 256, nact, 512, 256)); GBAR();
        DUP(9, GEMM_FLAT(EpiMerge, ({p, WS_SGS, false}), WS_YS, 256, WS_WBS, 256, nact, DM, 256)); REFRESH();
        GEMM_FLAT(EpiMerge, ({p, WS_SGD, true}), WS_YD, 512, WS_WBD, 512, nact, DM, 512); REFRESH();
        GEMM_FLAT(EpiMerge, ({p, WS_SGN, true, true}), WS_YN, 256, WS_WBN, 256, nact, DM, 256); GBAR();
        {
          pg8::Gemm g_{(const bf16_t*)(p.ws + WS_MB8), (const bf16_t*)(p.ws + WS_WOUT), DM / 2, DM / 2, DM / 2};
          SchedFlat S_; S_.init(nact / 256, DM / 256, (int)gridDim.x, (int)blockIdx.x); EpiAdapt<EpiWout> E_{EpiWout{p, l}};
          pg8::gemm_phase<EpiAdapt<EpiWout>, SchedFlat, PG8_ALIGN, PG8_SP2, true>(lds, g_, S_, E_, tid_of(wave_s)); }
        GBAR();
        DUP(13, fastp::norm_phase(p, l, 2, nact, false, wave_s); REFRESH()); GBAR();
        DUP(11, GEMM_FLAT(EpiScore, {p}, WS_H, DM, WS_WSC, DM, nact, 2048, DM)); GBAR();
        DUP(12, ph_topk(p, nact, tid, nthr)); GBAR();
        fastp::peer_u_phase(p, nact, xinf, lds, wave_s); REFRESH(); GBAR();
        fastp::peer_comb_phase(p, nact, tid, nthr); GBAR();
        fastp::peer_v_phase(p, l, nact, xinf, lds, wave_s); REFRESH(); GBAR();
    }
    fastp::final_norm_phase(p, wave_s);
#undef GBAR
}

extern "C" void kernel_launch(void* const* d_in, const int* in_sizes, int n_in, void* d_out, int out_size, void* d_ws, size_t ws_size, hipStream_t stream) {
    static int grid = 0;
    if (grid == 0) {
        int dev = 0, cus = 0, per_cu = 0;
        (void)hipGetDevice(&dev);
        (void)hipDeviceGetAttribute(&cus, hipDeviceAttributeMultiprocessorCount, dev);
        (void)hipFuncSetAttribute((const void*)mega_fwd, hipFuncAttributeMaxDynamicSharedMemorySize, LDS_BYTES);
        (void)hipOccupancyMaxActiveBlocksPerMultiprocessor(&per_cu, (const void*)mega_fwd, NTHREADS, LDS_BYTES);
        (void)hipGetLastError();
        if (cus <= 0) cus = 256;
        grid = cus;
        if (n_in != 30 || ws_size < WS_TOTAL) { fprintf(stderr, "kernel_launch: unexpected n_in %d / ws %zu (need %zu)\n", n_in, ws_size, (size_t)WS_TOTAL); }
    }
    (void)hipMemsetAsync((char*)d_ws + WS_CTL, 0, CTL_BYTES, stream);
    ParamsH p{};
    for (int i = 0; i < 30; ++i) p.in[i] = (const float*)d_in[i];
    p.out = (float*)d_out; p.ws = (unsigned char*)d_ws;
    hipLaunchKernelGGL(mega_fwd, dim3(grid), dim3(NTHREADS), LDS_BYTES, stream, p);
}
#endif
```

```cpp
#ifndef HOST_EMU
#include <hip/hip_runtime.h>
#define HD __host__ __device__ __forceinline__
#else
#include <cmath>
#include <cstring>
#include <cstdio>
#include <cstdlib>
#define HD inline
#endif
#include <cstdint>
#include <cstddef>
#ifndef HOST_EMU
#define UNROLL _Pragma("unroll")
#else
#define UNROLL
#endif

#ifndef BATCH
#define BATCH 4
#endif
#ifndef SEQ
#define SEQ 8192
#endif
#ifndef CTX_LEN
#define CTX_LEN 256
#endif
constexpr int B_ = BATCH, L_ = SEQ, C_ = CTX_LEN, DM = 1024, DEPTH = 2;
constexpr int NRL = B_ * L_, NRC = B_ * C_, NR = NRL + NRC;
constexpr int GRW = 64, GRR = L_ / GRW;
constexpr int TCH = 32, NCH = NR / TCH;
constexpr int NCHP = ((NCH + 255) / 256) * 256;
constexpr int LCH = L_ / TCH, CCH = C_ / TCH;
constexpr int INW = 5632, KSS = 768;
constexpr float RMS_EPS = 1e-6f;
constexpr float LOG2E = 1.4426950408889634f;

typedef unsigned short bf16_t;

HD float u2f(unsigned u) { float f; memcpy(&f, &u, 4); return f; }
HD unsigned f2u(float f) { unsigned u; memcpy(&u, &f, 4); return u; }
HD float bf2f(bf16_t v) { return u2f((unsigned)v << 16); }
HD bf16_t f2bf(float f) { unsigned u = f2u(f); return (bf16_t)((u + 0x7fffu + ((u >> 16) & 1u)) >> 16); }
#if defined(__HIP_DEVICE_COMPILE__)
HD float fexp2_(float x) { return __builtin_amdgcn_exp2f(x); }
HD float frcp_(float x) { return __builtin_amdgcn_rcpf(x); }
#else
HD float fexp2_(float x) { return exp2f(x); }
HD float frcp_(float x) { return 1.f / x; }
#endif
HD float sigmoidf_(float x) { return frcp_(1.f + fexp2_(-1.4426950408889634f * x)); }
HD float gelu_tanh(float x) { const float z = 0.7978845608028654f * (x + 0.044715f * x * x * x); return x * (1.f - frcp_(fexp2_(2.885390081777927f * z) + 1.f)); }
HD float siluf_(float x) { return x * sigmoidf_(x); }
struct alignas(16) bf8 { bf16_t v[8]; };
struct alignas(8) bf4 { bf16_t v[4]; };
struct alignas(16) fl4 { float v[4]; };

constexpr size_t al256(size_t x) { return (x + 255) & ~(size_t)255; }
constexpr size_t WS_CTL = 0;
constexpr size_t CTL_BYTES = 65536;
constexpr size_t WS_MOD = WS_CTL + CTL_BYTES;
constexpr size_t WS_ROPE = al256(WS_MOD + (size_t)DEPTH * (B_ + 1) * 6144 * 4);
constexpr size_t WS_LAMD = al256(WS_ROPE + 128 * 16 * 8);
constexpr size_t WS_POW = al256(WS_LAMD + 256);
constexpr size_t WS_BBAR = al256(WS_POW + (size_t)2 * 16 * 64 * 33 * 8);
constexpr size_t WS_KK = al256(WS_BBAR + (size_t)2 * 16 * 64 * 16 * 8);
constexpr size_t WS_XRC = al256(WS_KK + (size_t)2 * 16 * 32 * 256 * 4);
constexpr size_t WS_WIN = al256(WS_XRC + (size_t)NRC * DM * 4);
constexpr size_t WS_WGLU = al256(WS_WIN + (size_t)INW * DM * 2);
constexpr size_t WS_WBS = al256(WS_WGLU + (size_t)512 * 256 * 2);
constexpr size_t WS_WBD = al256(WS_WBS + (size_t)1024 * 256 * 2);
constexpr size_t WS_WBN = al256(WS_WBD + (size_t)1024 * 512 * 2);
constexpr size_t WS_WOUT = al256(WS_WBN + (size_t)1024 * 256 * 2);
constexpr size_t WS_WSC = al256(WS_WOUT + (size_t)1024 * 1024 * 2);
constexpr size_t WS_BT1 = al256(WS_WSC + (size_t)2048 * 1024 * 2);
constexpr size_t WS_BT2 = al256(WS_BT1 + (size_t)16 * 256 * 512 * 2);
constexpr size_t WS_H = al256(WS_BT2 + (size_t)16 * 512 * 768 * 2);
constexpr size_t WS_YD = WS_H;
constexpr size_t WS_YN = WS_YD + (size_t)NR * 512 * 2;
constexpr size_t WS_YS = WS_YN + (size_t)NR * 256 * 2;
constexpr size_t WS_ASSM = al256(WS_H + (size_t)NR * DM * 2);
constexpr size_t WS_EIDX = WS_ASSM;
constexpr size_t WS_SLOC = al256(WS_ASSM + ((size_t)16 * NCH + 256) * KSS * 2);
constexpr size_t WS_WQB = WS_SLOC;
constexpr size_t WS_SKA = WS_WQB + (size_t)1024 * 2048 * 2;
constexpr size_t WS_QD = al256(WS_SLOC + (size_t)16 * NCH * 256 * 4);
constexpr size_t WS_KD = WS_QD + (size_t)NR * 512 * 2;
constexpr size_t WS_VD = WS_KD + (size_t)NR * 512 * 2;
constexpr size_t WS_QN = WS_VD + (size_t)NR * 512 * 2;
constexpr size_t WS_KN = WS_QN + (size_t)NR * 256 * 2;
constexpr size_t WS_VN = WS_KN + (size_t)NR * 256 * 2;
constexpr size_t WS_SGS = WS_VN + (size_t)NR * 256 * 2;
constexpr size_t WS_SGD = WS_SGS + (size_t)NR * DM * 2;
constexpr size_t WS_SGN = WS_SGD + (size_t)NR * DM * 2;
constexpr size_t WS_END1 = WS_SGN + (size_t)NR * DM * 2;
constexpr size_t WS_H8 = WS_H;
constexpr size_t WS_WG8 = WS_WIN;
constexpr size_t WS_VT8 = WS_VD;
constexpr int KVP = C_ + L_;
constexpr size_t WS_GW8 = WS_H;
constexpr size_t WS_MB8 = WS_ASSM;
constexpr size_t WS_MB = WS_QD;
constexpr size_t WS_YG = WS_QN;
#ifdef HOST_EMU
constexpr size_t WS_SC = WS_QD;
constexpr size_t TBL_BYTES = (size_t)16384 * 1024 * 2;
constexpr size_t WS_UT = al256(WS_SC + (size_t)NR * 2048 * 4);
constexpr size_t WS_VT = WS_UT + TBL_BYTES;
constexpr size_t WS_GW = WS_VT + TBL_BYTES;
#else
constexpr size_t TBL_BYTES = (size_t)16384 * 1024;
constexpr size_t WS_UT = WS_VD;
constexpr size_t WS_VT = WS_UT + TBL_BYTES;
static_assert(2 * TBL_BYTES <= (size_t)NR * 512 * 2, "tables fit the V region");
constexpr size_t WS_SC = WS_SGS;
constexpr size_t WS_GW = al256(WS_SC + (size_t)NR * 2048 * 2);
#endif
constexpr size_t WS_H8B = al256(WS_GW + (size_t)NR * 128 * 4);
constexpr size_t WS_END2 = WS_H8B + (size_t)NR * DM;
constexpr size_t WS_TOTAL = WS_END1 > WS_END2 ? WS_END1 : WS_END2;
#if BATCH == 4 && SEQ == 8192 && CTX_LEN == 256
static_assert(WS_TOTAL <= (size_t)512 * 1024 * 1024, "workspace map exceeds 512 MiB");
#endif

#if defined(__HIP_DEVICE_COMPILE__)
#define GPTR __attribute__((address_space(1)))
#else
#define GPTR
#endif
struct ParamsH { const float* in[30]; float* out; unsigned char* ws; };
struct Params {
    const float GPTR* in[30];
    float GPTR* out;
    unsigned char GPTR* ws;
};
enum { I_X = 0, I_C, I_CTX, I_CCTX, I_ADAW, I_ADAB, I_N1G, I_N2G, I_WIN, I_LRE, I_LIM, I_LSTEP, I_BRE, I_BIM, I_CRE, I_CIM, I_SSMD, I_GLUW,
       I_DLAM, I_SUBLN, I_RPB, I_WBS, I_WBD, I_WBN, I_WOUT, I_WQ, I_SUBK, I_PU, I_PV, I_FNG };

#define WSP(T, off) ((T*)(p.ws + (off)))
HD float* xr_row(const Params& p, int row) { return row < NRL ? (float*)(p.out + (size_t)row * DM) : WSP(float, WS_XRC) + (size_t)(row - NRL) * DM; }
HD int row_bb(int row) { return row < NRL ? row / L_ : B_; }
HD const float* mod_ptr(const Params& p, int l, int bb, int seg) { return WSP(const float, WS_MOD) + ((size_t)(l * (B_ + 1) + bb) * 6 + seg) * DM; }

template <class F>
HD void naive_gemm(const bf16_t* A, size_t lda, const bf16_t* Bt, size_t ldb, int M, int N, int K, const F& f, long tid, long nthr) {
    const long per_row = N / 8, items = (long)M * per_row;
    for (long it = tid; it < items; it += nthr) {
        const int row = (int)(it / per_row), cg = (int)(it % per_row), c0 = (cg >> 2) * 32 + (cg & 3) * 4;
        float a[4] = {0.f, 0.f, 0.f, 0.f}, b[4] = {0.f, 0.f, 0.f, 0.f};
        const bf16_t* ar = A + (size_t)row * lda;
        for (int k = 0; k < K; k += 8) {
            const bf8 av = *(const bf8*)(ar + k);
            float af[8];
            for (int e = 0; e < 8; ++e) af[e] = bf2f(av.v[e]);
            for (int j = 0; j < 4; ++j) {
                const bf8 b0 = *(const bf8*)(Bt + (size_t)(c0 + j) * ldb + k), b1 = *(const bf8*)(Bt + (size_t)(c0 + 16 + j) * ldb + k);
                for (int e = 0; e < 8; ++e) { a[j] += af[e] * bf2f(b0.v[e]); b[j] += af[e] * bf2f(b1.v[e]); }
            }
        }
        f(row, c0, a, b);
    }
}

#if defined(__HIP_DEVICE_COMPILE__)
__device__ __forceinline__ void st_bf4(bf16_t* dst, const float* v) {
    typedef float f2c_ __attribute__((ext_vector_type(2))); typedef __bf16 b2c_ __attribute__((ext_vector_type(2)));
    const f2c_ lo = {v[0], v[1]}, hi = {v[2], v[3]};
    *(uint2*)dst = make_uint2(__builtin_bit_cast(unsigned, __builtin_convertvector(lo, b2c_)), __builtin_bit_cast(unsigned, __builtin_convertvector(hi, b2c_)));
}
#else
HD void st_bf4(bf16_t* dst, const float* v) { bf4 o; for (int j = 0; j < 4; ++j) o.v[j] = f2bf(v[j]); *(bf4*)dst = o; }
#endif

struct EpiWin {
    Params p;
    HD void set_group(int) {}
    template <int R = -1> HD void one(int row, int col, const float* v, const float* partner, bool first) const {
#if defined(__HIP_DEVICE_COMPILE__)
        Params p = this->p; { unsigned char GPTR* w_ = p.ws; asm volatile("" : "+s"(w_)); p.ws = w_; }
#endif
        if (R == 0 || (R < 0 && col < 256)) {
            const int g = col >> 4, ch = col & 15, chunk = row / TCH, tk = row % TCH;
            st_bf4(WSP(bf16_t, WS_ASSM) + ((size_t)(g * NCH + chunk)) * KSS + tk * 16 + ch, v);
        } else if (R == 1 || (R < 0 && col < 1280)) {
            const bool isq = col < 768; const int cc = col - (isq ? 256 : 768);
            float o[4];
            if (row < NRL) {
                const int t = row % L_, grp = (cc >> 5) & 1, pos = grp ? (t % GRW) : (t / GRW), i0 = cc & 15;
                const float* cs = WSP(const float, WS_ROPE) + ((size_t)pos * 16 + i0) * 2;
                for (int j = 0; j < 4; ++j) { const float c = cs[2 * j], s = cs[2 * j + 1]; o[j] = first ? (v[j] * c - partner[j] * s) : (v[j] * c + partner[j] * s); }
            } else for (int j = 0; j < 4; ++j) o[j] = v[j];
            if (isq) for (int j = 0; j < 4; ++j) o[j] *= 0.125f * LOG2E;
#ifdef HOST_EMU
            st_bf4(WSP(bf16_t, isq ? WS_QD : WS_KD) + (size_t)row * 512 + cc, o);
#else
            { int pk = 0;
              pk = __builtin_amdgcn_cvt_pk_fp8_f32(fminf(fmaxf(o[0] * 8.f, -448.f), 448.f), fminf(fmaxf(o[1] * 8.f, -448.f), 448.f), pk, false);
              pk = __builtin_amdgcn_cvt_pk_fp8_f32(fminf(fmaxf(o[2] * 8.f, -448.f), 448.f), fminf(fmaxf(o[3] * 8.f, -448.f), 448.f), pk, true);
              *(unsigned GPTR*)(p.ws + (isq ? WS_QD : WS_KD) + (size_t)row * 512 + cc) = (unsigned)pk; }
#endif
        } else if (R == 2 || (R < 0 && col < 1792)) {
#ifdef HOST_EMU
            st_bf4(WSP(bf16_t, WS_VD) + (size_t)row * 512 + (col - 1280), v);
#else
            const int cc = col - 1280, bb = row < NRL ? row / L_ : (row - NRL) / C_, kp = row < NRL ? C_ + row % L_ : (row - NRL) % C_;
            unsigned char GPTR* vt = (unsigned char GPTR*)(p.ws + WS_VT8); const unsigned off = (unsigned)((bb * 512 + cc) * KVP + kp);
            int pk = 0;
            pk = __builtin_amdgcn_cvt_pk_fp8_f32(fminf(fmaxf(v[0], -448.f), 448.f), fminf(fmaxf(v[1], -448.f), 448.f), pk, false);
            pk = __builtin_amdgcn_cvt_pk_fp8_f32(fminf(fmaxf(v[2], -448.f), 448.f), fminf(fmaxf(v[3], -448.f), 448.f), pk, true);
            vt[off] = (unsigned char)(pk & 255); vt[off + KVP] = (unsigned char)((pk >> 8) & 255); vt[off + 2 * KVP] = (unsigned char)((pk >> 16) & 255); vt[off + 3 * KVP] = (unsigned char)((unsigned)pk >> 24);
#endif
        } else if ((R == 3 || R < 0) && col < 2048) { float o[4]; for (int j = 0; j < 4; ++j) o[j] = v[j] * (0.125f * LOG2E); st_bf4(WSP(bf16_t, WS_QN) + (size_t)row * 256 + (col - 1792), o);
        } else if ((R == 3 || R < 0) && col < 2304) { st_bf4(WSP(bf16_t, WS_KN) + (size_t)row * 256 + (col - 2048), v);
        } else if (R == 3 || (R < 0 && col < 2560)) { st_bf4(WSP(bf16_t, WS_VN) + (size_t)row * 256 + (col - 2304), v);
        } else {
            const int gc = col - 2560, which = gc >> 10, c = gc & 1023;
            float o[4]; for (int j = 0; j < 4; ++j) o[j] = sigmoidf_(v[j]);
            st_bf4(WSP(bf16_t, which == 0 ? WS_SGS : which == 1 ? WS_SGD : WS_SGN) + (size_t)row * DM + c, o);
        }
    }
    HD void operator()(int row, int c0, const float* a, const float* b) const { one(row, c0, a, b, true); one(row, c0 + 16, b, a, false); }
#if defined(__HIP_DEVICE_COMPILE__)
    template <int R> __device__ __forceinline__ void wide8(int row, int c0, const float* a, const float* b) const {
        typedef float f2c_ __attribute__((ext_vector_type(2))); typedef __bf16 b2c_ __attribute__((ext_vector_type(2))); typedef unsigned u4c_ __attribute__((ext_vector_type(4)));
        const float sc = (R == 3 && c0 < 2048) ? 0.125f * LOG2E : 1.f;
        const unsigned a0 = __builtin_bit_cast(unsigned, __builtin_convertvector((f2c_){a[0] * sc, a[1] * sc}, b2c_)), a1 = __builtin_bit_cast(unsigned, __builtin_convertvector((f2c_){a[2] * sc, a[3] * sc}, b2c_));
        const unsigned b0 = __builtin_bit_cast(unsigned, __builtin_convertvector((f2c_){b[0] * sc, b[1] * sc}, b2c_)), b1 = __builtin_bit_cast(unsigned, __builtin_convertvector((f2c_){b[2] * sc, b[3] * sc}, b2c_));
        auto r0 = __builtin_amdgcn_permlane16_swap(a0, b0, false, false); auto r1 = __builtin_amdgcn_permlane16_swap(a1, b1, false, false);
        const unsigned col = (unsigned)(c0 + (((c0 >> 2) & 1) ? 12 : 0)), urow = (unsigned)row;
        Params p = this->p; { unsigned char GPTR* w_ = p.ws; asm volatile("" : "+s"(w_)); p.ws = w_; }
        size_t off;
        if (R == 0) { const unsigned g = col >> 4, ch = col & 15u, chunk = urow / (unsigned)TCH, tk = urow % (unsigned)TCH; off = WS_ASSM + (((size_t)(g * NCH + chunk)) * KSS + tk * 16 + ch) * 2; }
        else { const unsigned which = (col - 1792u) >> 8, cc = (col - 1792u) & 255u; off = (which == 0 ? WS_QN : which == 1 ? WS_KN : WS_VN) + ((size_t)urow * 256 + cc) * 2; }
        *(u4c_ GPTR*)(p.ws + off) = (u4c_){r0[0], r1[0], r0[1], r1[1]};
    }
    __device__ __forceinline__ void qk8(int row, int c0, const float* a, const float* b) const {
        typedef float f4c_ __attribute__((ext_vector_type(4)));
        const unsigned urow = (unsigned)row; const bool isq = c0 < 768; const unsigned cc = (unsigned)c0 - (isq ? 256u : 768u);
        Params p = this->p; { unsigned char GPTR* w_ = p.ws; asm volatile("" : "+s"(w_)); p.ws = w_; }
        float oa[4], ob[4];
        if (row < NRL) {
            const unsigned t = urow % (unsigned)L_, pos = ((cc >> 5) & 1u) ? (t % (unsigned)GRW) : (t / (unsigned)GRW), i0 = cc & 15u;
            const float GPTR* cs = (const float GPTR*)(p.ws + WS_ROPE) + (pos * 16u + i0) * 2u;
            const f4c_ q0 = *(const f4c_ GPTR*)cs, q1 = *(const f4c_ GPTR*)(cs + 4);
            oa[0] = a[0] * q0[0] - b[0] * q0[1]; ob[0] = b[0] * q0[0] + a[0] * q0[1]; oa[1] = a[1] * q0[2] - b[1] * q0[3]; ob[1] = b[1] * q0[2] + a[1] * q0[3];
            oa[2] = a[2] * q1[0] - b[2] * q1[1]; ob[2] = b[2] * q1[0] + a[2] * q1[1]; oa[3] = a[3] * q1[2] - b[3] * q1[3]; ob[3] = b[3] * q1[2] + a[3] * q1[3];
        } else { for (int j = 0; j < 4; ++j) { oa[j] = a[j]; ob[j] = b[j]; } }
        const float sc = isq ? 0.125f * LOG2E * 8.f : 8.f;
        int pa = 0, pb = 0;
        pa = __builtin_amdgcn_cvt_pk_fp8_f32(fminf(fmaxf(oa[0] * sc, -448.f), 448.f), fminf(fmaxf(oa[1] * sc, -448.f), 448.f), pa, false);
        pa = __builtin_amdgcn_cvt_pk_fp8_f32(fminf(fmaxf(oa[2] * sc, -448.f), 448.f), fminf(fmaxf(oa[3] * sc, -448.f), 448.f), pa, true);
        pb = __builtin_amdgcn_cvt_pk_fp8_f32(fminf(fmaxf(ob[0] * sc, -448.f), 448.f), fminf(fmaxf(ob[1] * sc, -448.f), 448.f), pb, false);
        pb = __builtin_amdgcn_cvt_pk_fp8_f32(fminf(fmaxf(ob[2] * sc, -448.f), 448.f), fminf(fmaxf(ob[3] * sc, -448.f), 448.f), pb, true);
        auto r = __builtin_amdgcn_permlane16_swap((unsigned)pa, (unsigned)pb, false, false);
        const unsigned ccs = cc + (((c0 >> 2) & 1) ? 12u : 0u);
        *(uint2 GPTR*)(p.ws + (isq ? WS_QD : WS_KD) + (size_t)urow * 512 + ccs) = make_uint2(r[0], r[1]);
    }
    __device__ __forceinline__ unsigned quad_tr(unsigned w, unsigned sel01, unsigned sel23) const {
        const unsigned x0 = (unsigned)__builtin_amdgcn_mov_dpp((int)w, 0x00, 0xf, 0xf, true), x1 = (unsigned)__builtin_amdgcn_mov_dpp((int)w, 0x55, 0xf, 0xf, true),
                       x2 = (unsigned)__builtin_amdgcn_mov_dpp((int)w, 0xaa, 0xf, 0xf, true), x3 = (unsigned)__builtin_amdgcn_mov_dpp((int)w, 0xff, 0xf, 0xf, true);
        const unsigned t01 = __builtin_amdgcn_perm(x1, x0, sel01), t23 = __builtin_amdgcn_perm(x3, x2, sel23);
        return (t01 & 0xffffu) | (t23 & 0xffff0000u);
    }
    __device__ __forceinline__ void v8(int row, int c0, const float* a, const float* b) const {
        const unsigned urow = (unsigned)row, cc = (unsigned)c0 - 1280u;
        Params p = this->p; { unsigned char GPTR* w_ = p.ws; asm volatile("" : "+s"(w_)); p.ws = w_; }
        const bool lat = row < NRL; const unsigned rr = lat ? urow : urow - (unsigned)NRL;
        const unsigned bb = lat ? rr / (unsigned)L_ : rr / (unsigned)C_, kp = lat ? (unsigned)C_ + rr % (unsigned)L_ : rr % (unsigned)C_;
        int pa = 0, pb = 0;
        pa = __builtin_amdgcn_cvt_pk_fp8_f32(fminf(fmaxf(a[0], -448.f), 448.f), fminf(fmaxf(a[1], -448.f), 448.f), pa, false); pa = __builtin_amdgcn_cvt_pk_fp8_f32(fminf(fmaxf(a[2], -448.f), 448.f), fminf(fmaxf(a[3], -448.f), 448.f), pa, true);
        pb = __builtin_amdgcn_cvt_pk_fp8_f32(fminf(fmaxf(b[0], -448.f), 448.f), fminf(fmaxf(b[1], -448.f), 448.f), pb, false); pb = __builtin_amdgcn_cvt_pk_fp8_f32(fminf(fmaxf(b[2], -448.f), 448.f), fminf(fmaxf(b[3], -448.f), 448.f), pb, true);
        const unsigned qi = urow & 3u, sel01 = (qi) | ((4u + qi) << 8), sel23 = ((qi) << 16) | ((4u + qi) << 24);
        const unsigned ta = quad_tr((unsigned)pa, sel01, sel23), tb = quad_tr((unsigned)pb, sel01, sel23);
        unsigned char GPTR* vt = (unsigned char GPTR*)(p.ws + WS_VT8);
        const unsigned offa = (bb * 512u + cc + qi) * (unsigned)KVP + (kp & ~3u);
        *(unsigned GPTR*)(vt + offa) = ta; *(unsigned GPTR*)(vt + offa + 16u * (unsigned)KVP) = tb;
    }
    __device__ __forceinline__ void gates8(int row, int c0, const float* a, const float* b) const {
        typedef float f2c_ __attribute__((ext_vector_type(2))); typedef __bf16 b2c_ __attribute__((ext_vector_type(2))); typedef unsigned u4c_ __attribute__((ext_vector_type(4)));
        float oa[4], ob[4]; for (int j = 0; j < 4; ++j) { oa[j] = sigmoidf_(a[j]); ob[j] = sigmoidf_(b[j]); }
        const unsigned a0 = __builtin_bit_cast(unsigned, __builtin_convertvector((f2c_){oa[0], oa[1]}, b2c_)), a1 = __builtin_bit_cast(unsigned, __builtin_convertvector((f2c_){oa[2], oa[3]}, b2c_));
        const unsigned b0 = __builtin_bit_cast(unsigned, __builtin_convertvector((f2c_){ob[0], ob[1]}, b2c_)), b1 = __builtin_bit_cast(unsigned, __builtin_convertvector((f2c_){ob[2], ob[3]}, b2c_));
        auto r0 = __builtin_amdgcn_permlane16_swap(a0, b0, false, false); auto r1 = __builtin_amdgcn_permlane16_swap(a1, b1, false, false);
        const int odd = (c0 >> 2) & 1, col = c0 + (odd ? 12 : 0), gc = col - 2560, which = gc >> 10, c = gc & 1023;
        Params p = this->p; { unsigned char GPTR* w_ = p.ws; asm volatile("" : "+s"(w_)); p.ws = w_; }
        *(u4c_ GPTR*)(p.ws + (which == 0 ? WS_SGS : which == 1 ? WS_SGD : WS_SGN) + ((size_t)row * DM + c) * 2) = (u4c_){r0[0], r1[0], r0[1], r1[1]};
    }
#endif
};
struct EpiWinG { Params p;
    HD void set_group(int) {}
    HD void operator()(int row, int c0, const float* a, const float* b) const { EpiWin e{p}; e.one(row, c0, a, b, true); e.one(row, c0 + 16, b, a, false); }
    template <int R> HD void tile(int row, int c0, const float* a, const float* b) const { EpiWin e{p};
#if defined(__HIP_DEVICE_COMPILE__)
        if (R == 4) { e.gates8(row, c0, a, b); return; }
        if (R == 3 || R == 0) { e.template wide8<R>(row, c0, a, b); return; }
        if (R == 1) { e.qk8(row, c0, a, b); return; }
        if (R == 2) { e.v8(row, c0, a, b); return; }
#endif
        e.template one<R>(row, c0, a, b, true); e.template one<R>(row, c0 + 16, b, a, false); } };
struct EpiSsm1 { Params p; int g;
    HD void set_group(int g_) { g = g_; }
    HD void operator()(int row, int c0, const float* a, const float* b) const {
        if (row >= NCH) return;
        float* d = WSP(float, WS_SLOC) + ((size_t)(g * NCH + row)) * 256 + c0;
        for (int j = 0; j < 4; ++j) { d[j] = a[j]; d[16 + j] = b[j]; }
    } };
struct EpiSsm2 { Params p; int g;
    HD void set_group(int g_) { g = g_; }
    HD void one(int chunk, int col, const float* v) const {
        const int tk = col >> 4, ch = col & 15; float o[4]; for (int j = 0; j < 4; ++j) o[j] = gelu_tanh(v[j]);
        st_bf4(WSP(bf16_t, WS_YG) + ((size_t)chunk * TCH + tk) * 256 + g * 16 + ch, o);
    }
    HD void operator()(int row, int c0, const float* a, const float* b) const { if (row >= NCH) return; one(row, c0, a); one(row, c0 + 16, b); } };
struct EpiGlu { Params p;
    HD void set_group(int) {}
    HD void one(int row, int col, const float* v) const {
        bf16_t* d = WSP(bf16_t, WS_YS) + (size_t)row * 256 + (col >> 1);
        const unsigned pk = (unsigned)f2bf(v[0] * sigmoidf_(v[1])) | ((unsigned)f2bf(v[2] * sigmoidf_(v[3])) << 16); *(unsigned*)d = pk;
    }
#if defined(__HIP_DEVICE_COMPILE__)
    __device__ __forceinline__ void operator()(int row, int c0, const float* a, const float* b) const {
        typedef float f2c_ __attribute__((ext_vector_type(2))); typedef __bf16 b2c_ __attribute__((ext_vector_type(2)));
        const unsigned pa = __builtin_bit_cast(unsigned, __builtin_convertvector((f2c_){a[0] * sigmoidf_(a[1]), a[2] * sigmoidf_(a[3])}, b2c_));
        const unsigned pb = __builtin_bit_cast(unsigned, __builtin_convertvector((f2c_){b[0] * sigmoidf_(b[1]), b[2] * sigmoidf_(b[3])}, b2c_));
        auto r = __builtin_amdgcn_permlane16_swap(pa, pb, false, false);
        const unsigned oc = ((unsigned)c0 >> 1) + (((c0 >> 2) & 1) ? 6u : 0u);
        *(uint2 GPTR*)(p.ws + WS_YS + ((size_t)(unsigned)row * 256 + oc) * 2) = make_uint2(r[0], r[1]);
    }
#else
    HD void operator()(int row, int c0, const float* a, const float* b) const { one(row, c0, a); one(row, c0 + 16, b); }
#endif
};
struct EpiMerge { Params p; size_t sg_off; bool accum; bool last = false;
    HD void set_group(int) {}
    HD void one(int row, int col, const float* v) const {
        const bf16_t* sg = WSP(const bf16_t, sg_off) + (size_t)row * DM + col; bf16_t* m = WSP(bf16_t, WS_MB) + (size_t)row * DM + col;
        float o[4]; for (int j = 0; j < 4; ++j) o[j] = bf2f(sg[j]) * v[j] + (accum ? bf2f(m[j]) : 0.f);
#ifndef HOST_EMU
        if (last) { int pk = 0;
            pk = __builtin_amdgcn_cvt_pk_fp8_f32(fminf(fmaxf(o[0], -448.f), 448.f), fminf(fmaxf(o[1], -448.f), 448.f), pk, false);
            pk = __builtin_amdgcn_cvt_pk_fp8_f32(fminf(fmaxf(o[2], -448.f), 448.f), fminf(fmaxf(o[3], -448.f), 448.f), pk, true);
            *(unsigned GPTR*)(p.ws + WS_MB8 + (size_t)row * DM + col) = (unsigned)pk; return; }
#endif
        st_bf4(m, o);
    }
#if defined(__HIP_DEVICE_COMPILE__)
    __device__ __forceinline__ void operator()(int row, int c0, const float* a, const float* b) const {
        typedef float f2c_ __attribute__((ext_vector_type(2))); typedef __bf16 b2c_ __attribute__((ext_vector_type(2)));
        const unsigned off = ((unsigned)row * DM + (unsigned)c0) * 2u;
        const unsigned char GPTR* sgb = p.ws + sg_off; unsigned char GPTR* mbb = p.ws + WS_MB;
        const uint2 ga = *(const uint2 GPTR*)(sgb + off), gb = *(const uint2 GPTR*)(sgb + off + 32);
        float oa[4] = {u2f(ga.x << 16) * a[0], u2f(ga.x & 0xffff0000u) * a[1], u2f(ga.y << 16) * a[2], u2f(ga.y & 0xffff0000u) * a[3]};
        float ob[4] = {u2f(gb.x << 16) * b[0], u2f(gb.x & 0xffff0000u) * b[1], u2f(gb.y << 16) * b[2], u2f(gb.y & 0xffff0000u) * b[3]};
        if (accum) { const uint2 ma = *(const uint2 GPTR*)(mbb + off), mb = *(const uint2 GPTR*)(mbb + off + 32);
            oa[0] += u2f(ma.x << 16); oa[1] += u2f(ma.x & 0xffff0000u); oa[2] += u2f(ma.y << 16); oa[3] += u2f(ma.y & 0xffff0000u);
            ob[0] += u2f(mb.x << 16); ob[1] += u2f(mb.x & 0xffff0000u); ob[2] += u2f(mb.y << 16); ob[3] += u2f(mb.y & 0xffff0000u); }
        if (last) { int pa = 0, pb = 0;
            pa = __builtin_amdgcn_cvt_pk_fp8_f32(fminf(fmaxf(oa[0], -448.f), 448.f), fminf(fmaxf(oa[1], -448.f), 448.f), pa, false); pa = __builtin_amdgcn_cvt_pk_fp8_f32(fminf(fmaxf(oa[2], -448.f), 448.f), fminf(fmaxf(oa[3], -448.f), 448.f), pa, true);
            pb = __builtin_amdgcn_cvt_pk_fp8_f32(fminf(fmaxf(ob[0], -448.f), 448.f), fminf(fmaxf(ob[1], -448.f), 448.f), pb, false); pb = __builtin_amdgcn_cvt_pk_fp8_f32(fminf(fmaxf(ob[2], -448.f), 448.f), fminf(fmaxf(ob[3], -448.f), 448.f), pb, true);
            unsigned char GPTR* m8 = p.ws + WS_MB8 + (off >> 1); *(unsigned GPTR*)m8 = (unsigned)pa; *(unsigned GPTR*)(m8 + 16) = (unsigned)pb; }
        else {
            *(uint2 GPTR*)(mbb + off) = make_uint2(__builtin_bit_cast(unsigned, __builtin_convertvector((f2c_){oa[0], oa[1]}, b2c_)), __builtin_bit_cast(unsigned, __builtin_convertvector((f2c_){oa[2], oa[3]}, b2c_)));
            *(uint2 GPTR*)(mbb + off + 32) = make_uint2(__builtin_bit_cast(unsigned, __builtin_convertvector((f2c_){ob[0], ob[1]}, b2c_)), __builtin_bit_cast(unsigned, __builtin_convertvector((f2c_){ob[2], ob[3]}, b2c_))); }
    }
#else
    HD void operator()(int row, int c0, const float* a, const float* b) const { one(row, c0, a); one(row, c0 + 16, b); }
#endif
};
struct EpiWout { Params p; int l;
    HD void set_group(int) {}
    HD void one(int row, int col, const float* v) const {
        float* x = xr_row(p, row) + col; const float* g1 = mod_ptr(p, l, row_bb(row), 2) + col;
        for (int j = 0; j < 4; ++j) x[j] += g1[j] * v[j];
    }
#if defined(__HIP_DEVICE_COMPILE__)
    __device__ __forceinline__ void operator()(int row, int c0, const float* a, const float* b) const {
        typedef float f4c_ __attribute__((ext_vector_type(4)));
        const unsigned urow = (unsigned)row; const bool lat = row < NRL;
        float GPTR* x = (lat ? p.out + (size_t)urow * DM : (float GPTR*)(p.ws + WS_XRC) + (size_t)(urow - (unsigned)NRL) * DM) + c0;
        const unsigned bb = lat ? urow / (unsigned)L_ : (unsigned)B_;
        const float GPTR* g1 = (const float GPTR*)(p.ws + WS_MOD) + ((size_t)(l * (B_ + 1) + bb) * 6 + 2) * DM + c0;
        const f4c_ xa = *(const f4c_ GPTR*)x, xb = *(const f4c_ GPTR*)(x + 16), ga = *(const f4c_ GPTR*)g1, gb = *(const f4c_ GPTR*)(g1 + 16);
        *(f4c_ GPTR*)x = xa + ga * (f4c_){a[0], a[1], a[2], a[3]}; *(f4c_ GPTR*)(x + 16) = xb + gb * (f4c_){b[0], b[1], b[2], b[3]};
    }
#else
    HD void operator()(int row, int c0, const float* a, const float* b) const { one(row, c0, a); one(row, c0 + 16, b); }
#endif
};
struct EpiWsc { Params p;
    HD void set_group(int) {}
    HD void operator()(int row, int c0, const float* a, const float* b) const { st_bf4(WSP(bf16_t, WS_WSC) + (size_t)row * 1024 + c0, a); st_bf4(WSP(bf16_t, WS_WSC) + (size_t)row * 1024 + c0 + 16, b); } };
struct EpiScore { Params p;
    HD void set_group(int) {}
    HD void operator()(int row, int c0, const float* a, const float* b) const {
#if defined(__HIP_DEVICE_COMPILE__)
        typedef float f2c_ __attribute__((ext_vector_type(2))); typedef __bf16 b2c_ __attribute__((ext_vector_type(2))); typedef unsigned u4c_ __attribute__((ext_vector_type(4)));
        const unsigned a0 = __builtin_bit_cast(unsigned, __builtin_convertvector((f2c_){a[0], a[1]}, b2c_)), a1 = __builtin_bit_cast(unsigned, __builtin_convertvector((f2c_){a[2], a[3]}, b2c_));
        const unsigned b0 = __builtin_bit_cast(unsigned, __builtin_convertvector((f2c_){b[0], b[1]}, b2c_)), b1 = __builtin_bit_cast(unsigned, __builtin_convertvector((f2c_){b[2], b[3]}, b2c_));
        auto r0 = __builtin_amdgcn_permlane16_swap(a0, b0, false, false); auto r1 = __builtin_amdgcn_permlane16_swap(a1, b1, false, false);
        const int col = c0 + (((c0 >> 2) & 1) ? 12 : 0);
        *(u4c_ GPTR*)(p.ws + WS_SC + ((((size_t)(row >> 6) * 256 + (col >> 3)) * 64 + (row & 63)) * 8) * 2) = (u4c_){r0[0], r1[0], r0[1], r1[1]};
#else
        bf16_t* d = WSP(bf16_t, WS_SC) + (((size_t)(row >> 6) * 256 + (c0 >> 3)) * 64 + (row & 63)) * 8 + (c0 & 7);
        st_bf4(d, a); st_bf4(d + 2 * 64 * 8, b);
#endif
    } };

HD void ph_copy_x(const Params& p, long tid, long nthr) {
    const long n4 = (long)NR * DM / 4;
    for (long i = tid; i < n4; i += nthr) {
        const int row = (int)(i / (DM / 4)), c = (int)(i % (DM / 4)) * 4;
        const float* src = row < NRL ? p.in[I_X] + (size_t)row * DM + c : p.in[I_CTX] + (size_t)(row - NRL) * DM + c;
        *(fl4*)(xr_row(p, row) + c) = *(const fl4*)src;
    }
}
HD void ph_mod_small(const Params& p, long tid, long nthr) {
    for (long it = tid; it < 128 * 16; it += nthr) {
        const int pos = (int)(it / 16), i = (int)(it % 16);
        const float fr = exp2f(-(float)i * (13.287712379549449f / 16.0f)), ang = (float)pos * fr;
        WSP(float, WS_ROPE)[it * 2] = cosf(ang); WSP(float, WS_ROPE)[it * 2 + 1] = sinf(ang);
    }
    for (long it = tid; it < DEPTH; it += nthr) {
        const float* lq = p.in[I_DLAM] + it * 4 * 64; float s01 = 0.f, s23 = 0.f;
        for (int d = 0; d < 64; ++d) { s01 += lq[d] * lq[64 + d]; s23 += lq[128 + d] * lq[192 + d]; }
        const float lam_init = 0.8f - 0.6f * expf(-0.3f * (float)it);
        WSP(float, WS_LAMD)[it] = expf(s01) - expf(s23) + lam_init; WSP(float, WS_LAMD)[2 + it] = 1.f - lam_init;
    }
}
HD void ph_mod(const Params& p, long tid, long nthr) {
    const long items = (long)DEPTH * 6144;
    for (long it = tid; it < items; it += nthr) {
        const int l = (int)(it / 6144), col = (int)(it % 6144);
        float acc[B_ + 1]; for (int b = 0; b <= B_; ++b) acc[b] = 0.f;
        const float* w = p.in[I_ADAW] + (size_t)l * DM * 6144 + col;
        for (int d = 0; d < DM; ++d) { const float wv = w[(size_t)d * 6144];
            for (int b = 0; b < B_; ++b) acc[b] += siluf_(p.in[I_C][b * DM + d]) * wv;
            acc[B_] += siluf_(p.in[I_CCTX][d]) * wv; }
        const float bias = p.in[I_ADAB][l * 6144 + col];
        for (int b = 0; b <= B_; ++b) WSP(float, WS_MOD)[((size_t)(l * (B_ + 1) + b)) * 6144 + col] = acc[b] + bias;
    }
    for (long it = tid; it < 128 * 16; it += nthr) {
        const int pos = (int)(it / 16), i = (int)(it % 16);
        const float fr = exp2f(-(float)i * (13.287712379549449f / 16.0f)), ang = (float)pos * fr;
        WSP(float, WS_ROPE)[it * 2] = cosf(ang); WSP(float, WS_ROPE)[it * 2 + 1] = sinf(ang);
    }
    for (long it = tid; it < DEPTH; it += nthr) {
        const float* lq = p.in[I_DLAM] + it * 4 * 64; float s01 = 0.f, s23 = 0.f;
        for (int d = 0; d < 64; ++d) { s01 += lq[d] * lq[64 + d]; s23 += lq[128 + d] * lq[192 + d]; }
        const float lam_init = 0.8f - 0.6f * expf(-0.3f * (float)it);
        WSP(float, WS_LAMD)[it] = expf(s01) - expf(s23) + lam_init;
    }
}
HD void tr_item(const float* W, int K, int N, bf16_t* WT, long it) {
    const int n = (int)(it % N), k0 = (int)(it / N) * 8; bf8 o;
    for (int e = 0; e < 8; ++e) o.v[e] = f2bf(W[(size_t)(k0 + e) * N + n]);
    *(bf8*)(WT + (size_t)n * K + k0) = o;
}
HD void ph_prep_a(const Params& p, int l, long tid, long nthr) {
#ifdef HOST_EMU
    for (long it = tid; it < (long)INW * DM / 8; it += nthr) tr_item(p.in[I_WIN] + (size_t)l * DM * INW, DM, INW, WSP(bf16_t, WS_WIN), it);
#else
    for (long it = tid; it < (long)INW * DM / 8; it += nthr) {
        const int n = (int)(it % INW), k0 = (int)(it / INW) * 8; const float* W = p.in[I_WIN] + (size_t)l * DM * INW;
        float v[8]; for (int e = 0; e < 8; ++e) v[e] = fminf(fmaxf(W[(size_t)(k0 + e) * INW + n] * 256.f, -448.f), 448.f);
        int lo = 0, hi = 0; lo = __builtin_amdgcn_cvt_pk_fp8_f32(v[0], v[1], lo, false); lo = __builtin_amdgcn_cvt_pk_fp8_f32(v[2], v[3], lo, true);
        hi = __builtin_amdgcn_cvt_pk_fp8_f32(v[4], v[5], hi, false); hi = __builtin_amdgcn_cvt_pk_fp8_f32(v[6], v[7], hi, true);
        *(uint2*)(p.ws + WS_WG8 + (size_t)n * DM + k0) = make_uint2((unsigned)lo, (unsigned)hi);
    }
#endif
    for (long it = tid; it < (long)512 * 256 / 8; it += nthr) {
        const int n = (int)(it % 512), k0 = (int)(it / 512) * 8, src = (n & 1) ? 256 + (n >> 1) : (n >> 1); bf8 o;
        for (int e = 0; e < 8; ++e) o.v[e] = f2bf(p.in[I_GLUW][(size_t)l * 256 * 512 + (size_t)(k0 + e) * 512 + src]);
        *(bf8*)(WSP(bf16_t, WS_WGLU) + (size_t)n * 256 + k0) = o;
    }
    for (long it = tid; it < (long)1024 * 256 / 8; it += nthr) tr_item(p.in[I_WBS] + (size_t)l * 256 * 1024, 256, 1024, WSP(bf16_t, WS_WBS), it);
    for (long it = tid; it < (long)1024 * 512 / 8; it += nthr) tr_item(p.in[I_WBD] + (size_t)l * 512 * 1024, 512, 1024, WSP(bf16_t, WS_WBD), it);
    for (long it = tid; it < (long)1024 * 256 / 8; it += nthr) tr_item(p.in[I_WBN] + (size_t)l * 256 * 1024, 256, 1024, WSP(bf16_t, WS_WBN), it);
#ifdef HOST_EMU
    for (long it = tid; it < (long)1024 * 1024 / 8; it += nthr) tr_item(p.in[I_WOUT] + (size_t)l * 1024 * 1024, 1024, 1024, WSP(bf16_t, WS_WOUT), it);
#else
    for (long it = tid; it < (long)1024 * 1024 / 8; it += nthr) {
        const int n = (int)(it % 1024), k0 = (int)(it / 1024) * 8; const float* W = p.in[I_WOUT] + (size_t)l * 1024 * 1024;
        float v[8]; for (int e = 0; e < 8; ++e) v[e] = fminf(fmaxf(W[(size_t)(k0 + e) * 1024 + n] * 256.f, -448.f), 448.f);
        int lo = 0, hi = 0; lo = __builtin_amdgcn_cvt_pk_fp8_f32(v[0], v[1], lo, false); lo = __builtin_amdgcn_cvt_pk_fp8_f32(v[2], v[3], lo, true);
        hi = __builtin_amdgcn_cvt_pk_fp8_f32(v[4], v[5], hi, false); hi = __builtin_amdgcn_cvt_pk_fp8_f32(v[6], v[7], hi, true);
        *(uint2*)(p.ws + WS_WOUT + (size_t)n * 1024 + k0) = make_uint2((unsigned)lo, (unsigned)hi);
    }
#endif
#ifdef HOST_EMU
    for (long it = tid; it < (long)2048 * 1024; it += nthr) {
        const int d = (int)(it % 1024), hxn = (int)(it / 1024), hx = hxn >> 7;
        const float* wq = p.in[I_WQ] + (size_t)l * 1024 * 2048 + (size_t)d * 2048 + hx * 128;
        const float* sk = p.in[I_SUBK] + (size_t)l * 2048 * 128 + (size_t)hxn * 128;
        float s = 0.f; for (int j = 0; j < 128; ++j) s += wq[j] * sk[j];
        WSP(bf16_t, WS_WSC)[(size_t)hxn * 1024 + d] = f2bf(s);
    }
#else
    for (long it = tid; it < (long)1024 * 2048 / 8; it += nthr) { const float* src = p.in[I_WQ] + (size_t)l * 1024 * 2048 + it * 8; bf8 o;
        for (int e = 0; e < 8; ++e) o.v[e] = f2bf(src[e]);
        *(bf8*)(WSP(bf16_t, WS_WQB) + it * 8) = o; }
    for (long it = tid; it < (long)2048 * 256 / 8; it += nthr) { const int r = (int)(it >> 5), c0 = (int)(it & 31) * 8, hx = r >> 7, cl = c0 >> 7, j0 = c0 & 127; bf8 o;
        const float* src = p.in[I_SUBK] + (size_t)l * 2048 * 128 + (size_t)r * 128 + j0;
        for (int e = 0; e < 8; ++e) o.v[e] = (cl == (hx & 1)) ? f2bf(src[e]) : (bf16_t)0;
        *(bf8*)(WSP(bf16_t, WS_SKA) + (size_t)r * 256 + c0) = o; }
#endif
    for (long it = tid; it < 2 * 16 * 64; it += nthr) {
        const int dir = (int)(it / 1024), g = (int)(it / 64) % 16;
        const size_t li = (size_t)l * 2048 + it;
        double lre = p.in[I_LRE][li]; if (lre > -1e-4) lre = -1e-4; const double lim = p.in[I_LIM][li];
        const double dt = (double)expf(p.in[I_LSTEP][(size_t)l * 32 + dir * 16 + g]);
        const double are = lre * dt, aim = lim * dt;
        float* pw = WSP(float, WS_POW) + it * 33 * 2;
        for (int k = 0; k <= 32; ++k) { const double x = aim * k, nrev = rint(x * 0.15915494309189535), r = x - nrev * 6.283185307179586; const float m = expf((float)(are * k));
            pw[2 * k] = m * cosf((float)r); pw[2 * k + 1] = m * sinf((float)r); }
        const double bre_ = (double)pw[2] - 1.0, bim_ = (double)pw[3];
        const double den = lre * lre + lim * lim, fre = (bre_ * lre + bim_ * lim) / den, fim = (bim_ * lre - bre_ * lim) / den;
        for (int q = 0; q < 16; ++q) {
            const size_t bi = ((size_t)l * 2048 + it) * 16 + q; const double br = p.in[I_BRE][bi], bm = p.in[I_BIM][bi];
            float* bb = WSP(float, WS_BBAR) + (it * 16 + q) * 2;
            bb[0] = (float)(fre * br - fim * bm); bb[1] = (float)(fre * bm + fim * br);
        }
    }
}
HD void ph_prep_b(const Params& p, int l, long tid, long nthr) {
    const float* POW = WSP(const float, WS_POW); const float* BB = WSP(const float, WS_BBAR);
    for (long it = tid; it < (long)2 * 16 * 32 * 256; it += nthr) {
        const int q = (int)(it & 15), pp = (int)(it >> 4) & 15, lag = (int)(it >> 8) & 31, g = (int)(it >> 13) & 15, dir = (int)(it >> 17);
        float s = 0.f;
        for (int n = 0; n < 64; ++n) {
            const size_t sn = (size_t)(dir * 16 + g) * 64 + n;
            const size_t ci = (((size_t)l * 2 + dir) * 16 + g) * 1024 + (size_t)pp * 64 + n;
            const float cr = p.in[I_CRE][ci], cim = p.in[I_CIM][ci];
            const float pr = POW[(sn * 33 + lag) * 2], pi = POW[(sn * 33 + lag) * 2 + 1];
            const float br = BB[(sn * 16 + q) * 2], bi = BB[(sn * 16 + q) * 2 + 1];
            const float tr = pr * br - pi * bi, ti = pr * bi + pi * br;
            s += cr * tr - cim * ti;
        }
        WSP(float, WS_KK)[it] = s;
    }
    for (long it = tid; it < (long)16 * 256 * 512; it += nthr) {
        const int col = (int)(it % 512), r1 = (int)(it / 512) % 256, g = (int)(it / (512 * 256));
        const int i = col >> 4, q = col & 15, dir = r1 >> 7, n = (r1 >> 1) & 63, reim = r1 & 1, k = dir ? i : (TCH - 1 - i);
        const size_t sn = (size_t)(dir * 16 + g) * 64 + n;
        const float pr = POW[(sn * 33 + k) * 2], pi = POW[(sn * 33 + k) * 2 + 1], br = BB[(sn * 16 + q) * 2], bi = BB[(sn * 16 + q) * 2 + 1];
        WSP(bf16_t, WS_BT1)[it] = f2bf(reim ? (pr * bi + pi * br) : (pr * br - pi * bi));
    }
    for (long it = tid; it < (long)16 * 512 * 256; it += nthr) {
        const int kc = (int)(it % 256), rr = (int)(it / 256) % 512, g = (int)(it / (256 * 512));
        const int j = rr >> 4, pp = rr & 15, dir = kc >> 7, n = (kc >> 1) & 63, reim = kc & 1, k = dir ? (TCH - j) : (j + 1);
        const size_t sn = (size_t)(dir * 16 + g) * 64 + n;
        const size_t ci = (((size_t)l * 2 + dir) * 16 + g) * 1024 + (size_t)pp * 64 + n;
        const float cr = p.in[I_CRE][ci], cim = p.in[I_CIM][ci], pr = POW[(sn * 33 + k) * 2], pi = POW[(sn * 33 + k) * 2 + 1];
        WSP(bf16_t, WS_BT2)[((size_t)g * 512 + rr) * KSS + 512 + kc] = f2bf(reim ? -(cr * pi + cim * pr) : (cr * pr - cim * pi));
    }
}
HD void ph_prep_c(const Params& p, int l, long tid, long nthr) {
    const float* KK = WSP(const float, WS_KK);
    for (long it = tid; it < (long)16 * 512 * 512; it += nthr) {
        const int cc = (int)(it % 512), rr = (int)(it / 512) % 512, g = (int)(it / (512 * 512));
        const int j = rr >> 4, pp = rr & 15, i = cc >> 4, q = cc & 15;
        float v = 0.f;
        if (j >= i) v += KK[((((size_t)0 * 16 + g) * 32 + (j - i)) * 16 + pp) * 16 + q];
        if (i >= j) v += KK[((((size_t)1 * 16 + g) * 32 + (i - j)) * 16 + pp) * 16 + q];
        if (i == j && pp == q) v += p.in[I_SSMD][(size_t)l * 256 + g * 16 + pp];
        WSP(bf16_t, WS_BT2)[((size_t)g * 512 + rr) * KSS + cc] = f2bf(v);
    }
}
HD void norm_row(const Params& p, int l, int row, const float* gain, int seg_sh, int seg_sc) {
    const float* x = xr_row(p, row); float ss = 0.f;
    for (int c = 0; c < DM; ++c) ss += x[c] * x[c];
    const float rinv = 1.f / sqrtf(ss / DM + RMS_EPS);
    const int bb = row_bb(row); const float* sh = mod_ptr(p, l, bb, seg_sh); const float* sc = mod_ptr(p, l, bb, seg_sc);
    bf16_t* h = WSP(bf16_t, WS_H) + (size_t)row * DM;
    for (int c = 0; c < DM; ++c) h[c] = f2bf(x[c] * rinv * gain[c] * (1.f + sc[c]) + sh[c]);
}
HD void ph_norm(const Params& p, int l, int which, int nrows, long tid, long nthr) {
    const float* gain = p.in[which == 1 ? I_N1G : I_N2G] + (size_t)l * DM;
    for (long r = tid; r < nrows; r += nthr) norm_row(p, l, (int)r, gain, which == 1 ? 0 : 3, which == 1 ? 1 : 4);
}
#if defined(HOST_EMU)
HD float q8e_(float x, float sc) { float v = x * sc, ax = fabsf(v); if (ax > 448.f) ax = 448.f; int ex; frexpf(ax, &ex); ex -= 1; if (ex < -6) ex = -6; const float q = ldexpf(1.f, ex - 3); ax = nearbyintf(ax / q) * q; return copysignf(ax, v) / sc; }
#endif
HD void diff_attn_sub(const Params& p, int row, int hh, int ds, int m, int b, int nk, float* o, float& lsum) {
    const bf16_t* Q = WSP(const bf16_t, WS_QD) + (size_t)row * 512 + hh * 128 + m * 64;
    const bf16_t* K = WSP(const bf16_t, WS_KD) + hh * 128 + m * 64; const bf16_t* V = WSP(const bf16_t, WS_VD) + hh * 128 + ds * 16;
    float q[64];
    UNROLL for (int d8 = 0; d8 < 8; ++d8) { const bf8 t = *(const bf8*)(Q + d8 * 8); UNROLL for (int e = 0; e < 8; ++e) q[d8 * 8 + e] = bf2f(t.v[e]); }
#if defined(HOST_EMU) && defined(EMU_FP8QK)
    for (int d = 0; d < 64; ++d) q[d] = q8e_(q[d], 16.f);
#endif
    float mx = -1e30f, ls = 0.f;
    UNROLL for (int j = 0; j < 16; ++j) o[j] = 0.f;
    for (int k = 0; k < nk; ++k) {
        const int kr = k < C_ ? NRL + b * C_ + k : b * L_ + (k - C_);
        const bf16_t* kp = K + (size_t)kr * 512; const bf16_t* vp = V + (size_t)kr * 512;
        float s = 0.f;
        UNROLL for (int d8 = 0; d8 < 8; ++d8) { const bf8 t = *(const bf8*)(kp + d8 * 8); UNROLL for (int e = 0; e < 8; ++e) {
#if defined(HOST_EMU) && defined(EMU_FP8QK)
            s += q[d8 * 8 + e] * q8e_(bf2f(t.v[e]), 4.f);
#else
            s += q[d8 * 8 + e] * bf2f(t.v[e]);
#endif
            } }
        if (s > mx) { const float sc = exp2f(mx - s); ls *= sc; UNROLL for (int j = 0; j < 16; ++j) o[j] *= sc; mx = s; }
        float pr = exp2f(s - mx); ls += pr;
#if defined(HOST_EMU) && defined(EMU_FP8PV)
        pr = q8e_(pr, 256.f);
        UNROLL for (int h8 = 0; h8 < 2; ++h8) { const bf8 t = *(const bf8*)(vp + h8 * 8); UNROLL for (int e = 0; e < 8; ++e) o[h8 * 8 + e] += pr * q8e_(bf2f(t.v[e]), 1.f); }
#else
        UNROLL for (int h8 = 0; h8 < 2; ++h8) { const bf8 t = *(const bf8*)(vp + h8 * 8); UNROLL for (int e = 0; e < 8; ++e) o[h8 * 8 + e] += pr * bf2f(t.v[e]); }
#endif
    }
    lsum = ls;
}
HD void diff_attn_item(const Params& p, int l, int row, int hh, int ds) {
    const bool isctx = row >= NRL; const int b = isctx ? (row - NRL) / C_ : row / L_;
    const int nk = isctx ? C_ : C_ + L_;
    float o0[16], o1[16], l0, l1;
    diff_attn_sub(p, row, hh, ds, 0, b, nk, o0, l0);
    diff_attn_sub(p, row, hh, ds, 1, b, nk, o1, l1);
    const float lam = WSP(const float, WS_LAMD)[l];
    bf16_t* y = WSP(bf16_t, WS_YD) + (size_t)row * 512 + hh * 128 + ds * 16;
    bf8 r0, r1;
    UNROLL for (int j = 0; j < 8; ++j) { r0.v[j] = f2bf(o0[j] / l0 - lam * o1[j] / l1); r1.v[j] = f2bf(o0[8 + j] / l0 - lam * o1[8 + j] / l1); }
    *(bf8*)y = r0; *(bf8*)(y + 8) = r1;
}
HD void diff_norm_item(const Params& p, int l, int row, int hh) {
    bf16_t* y = WSP(bf16_t, WS_YD) + (size_t)row * 512 + hh * 128; float ss = 0.f;
    for (int d = 0; d < 128; ++d) { const float v = bf2f(y[d]); ss += v * v; }
    const float lam_init = 0.8f - 0.6f * expf(-0.3f * (float)l);
    const float rinv = 1.f / sqrtf(ss / 128.f + RMS_EPS) * (1.f - lam_init);
    const float* sg = p.in[I_SUBLN] + (size_t)l * 128;
    for (int d = 0; d < 128; ++d) y[d] = f2bf(bf2f(y[d]) * rinv * sg[d]);
}
HD void na_attn_item(const Params& p, int l, int row, int hh, int ds) {
    const bool isctx = row >= NRL; const int b = isctx ? (row - NRL) / C_ : row / L_;
    const bf16_t* Q = WSP(const bf16_t, WS_QN) + (size_t)row * 256 + hh * 64;
    const bf16_t* K = WSP(const bf16_t, WS_KN); const bf16_t* V = WSP(const bf16_t, WS_VN);
    float q[64];
    UNROLL for (int d8 = 0; d8 < 8; ++d8) { const bf8 t = *(const bf8*)(Q + d8 * 8); UNROLL for (int e = 0; e < 8; ++e) q[d8 * 8 + e] = bf2f(t.v[e]); }
    const int nloc = isctx ? 0 : 128; const int nk = nloc + C_;
    int r = 0, c = 0, rs = 0, cs = 0;
    if (!isctx) { const int t = row % L_; r = t / GRW; c = t % GRW; const int kh = GRR < 8 ? GRR : 8; rs = r - kh / 2; if (rs < 0) rs = 0; if (rs > GRR - kh) rs = GRR - kh; cs = c - 8; if (cs < 0) cs = 0; if (cs > GRW - 16) cs = GRW - 16; }
    const float* rpb = p.in[I_RPB] + ((size_t)l * 4 + hh) * 15 * 31;
    float o[16], mx = -1e30f, ls = 0.f;
    UNROLL for (int j = 0; j < 16; ++j) o[j] = 0.f;
    for (int k = 0; k < nk; ++k) {
        int kr; float bias = 0.f;
        if (k < nloc) { const int krr = rs + (k >> 4), kc = cs + (k & 15); kr = b * L_ + krr * GRW + kc;
            int dc = kc - c + 15; if (dc < 0) dc = 0; if (dc > 30) dc = 30; bias = rpb[(krr - r + 7) * 31 + dc] * LOG2E; }
        else kr = NRL + b * C_ + (k - nloc);
        const bf16_t* kp = K + (size_t)kr * 256 + hh * 64; const bf16_t* vp = V + (size_t)kr * 256 + hh * 64 + ds * 16;
        float s = bias;
        UNROLL for (int d8 = 0; d8 < 8; ++d8) { const bf8 t = *(const bf8*)(kp + d8 * 8); UNROLL for (int e = 0; e < 8; ++e) {
#if defined(HOST_EMU) && defined(EMU_FP8QK)
            s += q[d8 * 8 + e] * q8e_(bf2f(t.v[e]), 4.f);
#else
            s += q[d8 * 8 + e] * bf2f(t.v[e]);
#endif
            } }
        if (s > mx) { const float sc = exp2f(mx - s); ls *= sc; UNROLL for (int j = 0; j < 16; ++j) o[j] *= sc; mx = s; }
        float pr = exp2f(s - mx); ls += pr;
#if defined(HOST_EMU) && defined(EMU_FP8PV)
        pr = q8e_(pr, 256.f);
        UNROLL for (int h8 = 0; h8 < 2; ++h8) { const bf8 t = *(const bf8*)(vp + h8 * 8); UNROLL for (int e = 0; e < 8; ++e) o[h8 * 8 + e] += pr * q8e_(bf2f(t.v[e]), 1.f); }
#else
        UNROLL for (int h8 = 0; h8 < 2; ++h8) { const bf8 t = *(const bf8*)(vp + h8 * 8); UNROLL for (int e = 0; e < 8; ++e) o[h8 * 8 + e] += pr * bf2f(t.v[e]); }
#endif
    }
    bf16_t* y = WSP(bf16_t, WS_YN) + (size_t)row * 256 + hh * 64 + ds * 16;
    bf8 o0, o1;
    UNROLL for (int j = 0; j < 8; ++j) { o0.v[j] = f2bf(o[j] / ls); o1.v[j] = f2bf(o[8 + j] / ls); }
    *(bf8*)y = o0; *(bf8*)(y + 8) = o1;
}
HD void ph_diff_naive(const Params& p, int l, long tid, long nthr) {
    const int nrows = (l == 0) ? NR : NRL;
    for (long it = tid; it < (long)nrows * 32; it += nthr) diff_attn_item(p, l, (int)(it >> 5), (int)(it >> 3) & 3, (int)(it & 7));
}
HD void ph_na_naive(const Params& p, int l, long tid, long nthr) {
    const int nrows = (l == 0) ? NR : NRL;
    for (long it = tid; it < (long)nrows * 16; it += nthr) na_attn_item(p, l, (int)(it >> 4), (int)(it >> 2) & 3, (int)(it & 3));
}
HD void ph_attn_naive(const Params& p, int l, long tid, long nthr) { ph_diff_naive(p, l, tid, nthr); ph_na_naive(p, l, tid, nthr); }
HD void ph_diff_norm(const Params& p, int l, long tid, long nthr) {
    const int nrows = (l == 0) ? NR : NRL;
    for (long it = tid; it < (long)nrows * 4; it += nthr) diff_norm_item(p, l, (int)(it >> 2), (int)(it & 3));
}
HD void ph_ssm1_naive(const Params& p, long tid, long nthr) {
    for (int g = 0; g < 16; ++g) { EpiSsm1 e{p, g};
        naive_gemm(WSP(const bf16_t, WS_ASSM) + (size_t)g * NCH * KSS, KSS, WSP(const bf16_t, WS_BT1) + (size_t)g * 256 * 512, 512, NCH, 256, 512, e, tid, nthr); }
}
HD void ph_ssm_carry(const Params& p, long tid, long nthr) {
    for (long it = tid; it < (long)B_ * 16 * 2 * 64; it += nthr) {
        const int n = (int)(it & 63), dir = (int)(it >> 6) & 1, g = (int)(it >> 7) & 15, b = (int)(it >> 11);
        const size_t sn = (size_t)(dir * 16 + g) * 64 + n;
        const float lr = WSP(const float, WS_POW)[(sn * 33 + 32) * 2], li = WSP(const float, WS_POW)[(sn * 33 + 32) * 2 + 1];
        float sr = 0.f, si = 0.f;
        const int nsteps = CCH + LCH;
        for (int s = 0; s < nsteps; ++s) {
            int chunk;
            if (dir == 0) chunk = s < CCH ? NRL / TCH + b * CCH + s : b * LCH + (s - CCH);
            else chunk = s < CCH ? NRL / TCH + b * CCH + (CCH - 1 - s) : b * LCH + (LCH - 1 - (s - CCH));
            bf16_t* d = WSP(bf16_t, WS_ASSM) + ((size_t)(g * NCH + chunk)) * KSS + 512 + dir * 128 + n * 2;
            d[0] = f2bf(sr); d[1] = f2bf(si);
            const float* sl = WSP(const float, WS_SLOC) + ((size_t)(g * NCH + chunk)) * 256 + dir * 128 + n * 2;
            const float nr = lr * sr - li * si + sl[0], ni = lr * si + li * sr + sl[1];
            sr = nr; si = ni;
        }
    }
}
HD void ph_ssm2_naive(const Params& p, long tid, long nthr) {
    for (int g = 0; g < 16; ++g) { EpiSsm2 e{p, g};
        naive_gemm(WSP(const bf16_t, WS_ASSM) + (size_t)g * NCH * KSS, KSS, WSP(const bf16_t, WS_BT2) + (size_t)g * 512 * KSS, KSS, NCH, 512, KSS, e, tid, nthr); }
}
HD unsigned ord_key(float v) { const unsigned u = f2u(v); return (u & 0x80000000u) ? ~u : (u | 0x80000000u); }
HD float ord_val(unsigned k) { const unsigned u = (k & 0x80000000u) ? (k & 0x7fffffffu) : ~k; return u2f(u); }
#define TK_INSERT(L, x) do { unsigned x_ = (x); UNROLL for (int j_ = 0; j_ < 16; ++j_) { const unsigned hi_ = L[j_] > x_ ? L[j_] : x_; x_ = L[j_] > x_ ? x_ : L[j_]; L[j_] = hi_; } } while (0)
template <int K, int J> HD void bitonic_stage16(unsigned* v) {
    UNROLL for (int i = 0; i < 16; ++i) { const int l = i ^ J; if (l > i) { const bool desc = ((i & K) == 0); const unsigned a = v[i], b = v[l]; const unsigned hi = a > b ? a : b, lo = a > b ? b : a; v[i] = desc ? hi : lo; v[l] = desc ? lo : hi; } }
}
HD void bitonic_sort16(unsigned* v) {
    bitonic_stage16<2, 1>(v);
    bitonic_stage16<4, 2>(v); bitonic_stage16<4, 1>(v);
    bitonic_stage16<8, 4>(v); bitonic_stage16<8, 2>(v); bitonic_stage16<8, 1>(v);
    bitonic_stage16<16, 8>(v); bitonic_stage16<16, 4>(v); bitonic_stage16<16, 2>(v); bitonic_stage16<16, 1>(v);
}
HD void top16_merge(unsigned* R, const unsigned* G) {
    UNROLL for (int i = 0; i < 16; ++i) { const unsigned g = G[15 - i]; R[i] = R[i] > g ? R[i] : g; }
    bitonic_stage16<16, 8>(R); bitonic_stage16<16, 4>(R); bitonic_stage16<16, 2>(R); bitonic_stage16<16, 1>(R);
}
HD void topk_item(const Params& p, int row, int h) {
    float sv[2][16]; unsigned long long ilo[2], ihi[2];
    {
        unsigned L0[16], L1[16];
        const bf16_t* s0 = WSP(const bf16_t, WS_SC) + (((size_t)(row >> 6) * 256 + h * 32) * 64 + (row & 63)) * 8; const bf16_t* s1 = s0 + (size_t)16 * 64 * 8;
        float c0_[16], c1_[16], n0_[16], n1_[16];
#define TK_LD16(dst, src, g) do { struct alignas(16) tkq_ { unsigned x, y, z, w; }; const tkq_ w0_ = *(const tkq_*)((src) + (size_t)(g) * 512), w1_ = *(const tkq_*)((src) + (size_t)((g) + 1) * 512); \
            dst[0] = u2f(w0_.x << 16); dst[1] = u2f(w0_.x & 0xffff0000u); dst[2] = u2f(w0_.y << 16); dst[3] = u2f(w0_.y & 0xffff0000u); dst[4] = u2f(w0_.z << 16); dst[5] = u2f(w0_.z & 0xffff0000u); dst[6] = u2f(w0_.w << 16); dst[7] = u2f(w0_.w & 0xffff0000u); \
            dst[8] = u2f(w1_.x << 16); dst[9] = u2f(w1_.x & 0xffff0000u); dst[10] = u2f(w1_.y << 16); dst[11] = u2f(w1_.y & 0xffff0000u); dst[12] = u2f(w1_.z << 16); dst[13] = u2f(w1_.z & 0xffff0000u); dst[14] = u2f(w1_.w << 16); dst[15] = u2f(w1_.w & 0xffff0000u); } while (0)
        TK_LD16(c0_, s0, 0); TK_LD16(c1_, s1, 0);
        for (int n0 = 0; n0 < 128; n0 += 16) { unsigned G0[16], G1[16];
            if (n0 + 16 < 128) { TK_LD16(n0_, s0, (n0 + 16) >> 3); TK_LD16(n1_, s1, (n0 + 16) >> 3); }
            UNROLL for (int k = 0; k < 16; ++k) { G0[k] = (ord_key(c0_[k]) & ~127u) | (unsigned)(127 - (n0 + k)); G1[k] = (ord_key(c1_[k]) & ~127u) | (unsigned)(127 - (n0 + k)); }
            bitonic_sort16(G0); bitonic_sort16(G1);
            if (n0 == 0) { UNROLL for (int k = 0; k < 16; ++k) { L0[k] = G0[k]; L1[k] = G1[k]; } } else { top16_merge(L0, G0); top16_merge(L1, G1); }
            UNROLL for (int k = 0; k < 16; ++k) { c0_[k] = n0_[k]; c1_[k] = n1_[k]; } }
        unsigned long long lo = 0ull, hi = 0ull;
        UNROLL for (int j = 0; j < 16; ++j) { const unsigned long long id = (unsigned long long)(127u - (L0[j] & 127u)); if (j < 8) lo |= id << (8 * j); else hi |= id << (8 * (j - 8)); sv[0][j] = ord_val(L0[j] & ~127u); }
        ilo[0] = lo; ihi[0] = hi; lo = 0ull; hi = 0ull;
        UNROLL for (int j = 0; j < 16; ++j) { const unsigned long long id = (unsigned long long)(127u - (L1[j] & 127u)); if (j < 8) lo |= id << (8 * j); else hi |= id << (8 * (j - 8)); sv[1][j] = ord_val(L1[j] & ~127u); }
        ilo[1] = lo; ihi[1] = hi;
    }
    unsigned Lc[16];
    { unsigned Gc[16]; int cnt = 0, grp = 0;
      UNROLL for (int a = 0; a < 16; ++a) UNROLL for (int b = 0; b < 16; ++b) if ((a + 1) * (b + 1) <= 16) {
          const unsigned key = (ord_key(sv[0][a] + sv[1][b]) & ~255u) | (unsigned)(255 - (a * 16 + b));
          if (grp < 3) { Gc[cnt] = key; if (++cnt == 16) { bitonic_sort16(Gc); if (grp == 0) { UNROLL for (int k = 0; k < 16; ++k) Lc[k] = Gc[k]; } else top16_merge(Lc, Gc); cnt = 0; ++grp; } }
          else TK_INSERT(Lc, key); } }
    float best[16], mx = -1e30f; unsigned e[16];
    UNROLL for (int j = 0; j < 16; ++j) { best[j] = ord_val(Lc[j] & ~255u); if (best[j] > mx) mx = best[j]; const unsigned pos = 255u - (Lc[j] & 255u), a = pos >> 4, b = pos & 15u;
        const unsigned ia = (unsigned)(((a & 8u) ? ihi[0] : ilo[0]) >> (8u * (a & 7u))) & 0xffu, ib = (unsigned)(((b & 8u) ? ihi[1] : ilo[1]) >> (8u * (b & 7u))) & 0xffu;
        e[j] = ia * 128u + ib; }
    float sum = 0.f; UNROLL for (int j = 0; j < 16; ++j) { best[j] = expf(best[j] - mx); sum += best[j]; }
    { const float rs_ = 1.f / sum;
      UNROLL for (int j = 0; j < 8; ++j) { const size_t o_ = (size_t)row * 128 + j * 16 + 2 * h;
        *(unsigned*)(WSP(unsigned short, WS_EIDX) + o_) = (e[j] & 0xffffu) | (e[j + 8] << 16);
        float* gw_ = WSP(float, WS_GW) + o_; gw_[0] = best[j] * rs_; gw_[1] = best[j + 8] * rs_; } }
}
HD void ph_topk(const Params& p, int nrows, long tid, long nthr) { for (long it = tid; it < (long)nrows * 8; it += nthr) topk_item(p, (int)(it % nrows), (int)(it / nrows)); }
HD void ph_tables(const Params& p, int l, long tid, long nthr) {
    const long n8 = (long)16384 * 1024 / 8;
    for (long it = tid; it < 2 * n8; it += nthr) {
        const int w = it >= n8; const long i = it - (w ? n8 : 0);
        const float* src = p.in[w ? I_PV : I_PU] + (size_t)l * 16384 * 1024 + i * 8; bf8 o;
#ifdef EMU_FP8
        for (int e = 0; e < 8; ++e) { const float sc = w ? 16.f : 256.f; float x = src[e] * sc, ax = fabsf(x); if (ax > 448.f) ax = 448.f;
            int ex; frexpf(ax, &ex); ex -= 1; if (ex < -6) ex = -6; const float q = ldexpf(1.f, ex - 3); ax = nearbyintf(ax / q) * q; o.v[e] = f2bf(copysignf(ax, x) / sc); }
#else
        for (int e = 0; e < 8; ++e) o.v[e] = f2bf(src[e]);
#endif
        *(bf8*)(WSP(bf16_t, w ? WS_VT : WS_UT) + i * 8) = o;
    }
}
HD void ph_peer_act_naive(const Params& p, int nrows, long tid, long nthr) {
    for (long it = tid; it < (long)nrows * 128; it += nthr) {
        const int row = (int)(it >> 7); const int e = WSP(const unsigned short, WS_EIDX)[it];
        const bf16_t* u = WSP(const bf16_t, WS_UT) + (size_t)e * 1024; const bf16_t* h = WSP(const bf16_t, WS_H) + (size_t)row * DM;
        float s = 0.f; for (int d = 0; d < DM; ++d) s += bf2f(u[d]) * bf2f(h[d]);
        WSP(float, WS_GW)[it] *= gelu_tanh(s);
    }
}
HD void ph_peer_out_naive(const Params& p, int l, int nrows, long tid, long nthr) {
    for (long it = tid; it < (long)nrows * 256; it += nthr) {
        const int row = (int)(it >> 8), c = (int)(it & 255) * 4; float o[4] = {0.f, 0.f, 0.f, 0.f};
        for (int hk = 0; hk < 128; ++hk) { const int e = WSP(const unsigned short, WS_EIDX)[(size_t)row * 128 + hk]; const float w = WSP(const float, WS_GW)[(size_t)row * 128 + hk];
            const bf16_t* v = WSP(const bf16_t, WS_VT) + (size_t)e * 1024 + c; for (int j = 0; j < 4; ++j) o[j] += w * bf2f(v[j]); }
        float* x = xr_row(p, row) + c; const float* g2 = mod_ptr(p, l, row_bb(row), 5) + c;
        for (int j = 0; j < 4; ++j) x[j] += g2[j] * o[j];
    }
}
HD void ph_final_norm(const Params& p, long tid, long nthr) {
    for (long r = tid; r < NRL; r += nthr) { float* x = p.out + (size_t)r * DM; float ss = 0.f; for (int c = 0; c < DM; ++c) ss += x[c] * x[c];
        const float rinv = 1.f / sqrtf(ss / DM + RMS_EPS); for (int c = 0; c < DM; ++c) x[c] = x[c] * rinv * p.in[I_FNG][c]; }
}


#if defined(HOST_EMU) && defined(EMU_FP8G)
HD float q8_(float x, float sc) { float v = x * sc, ax = fabsf(v); if (ax > 448.f) ax = 448.f; int ex; frexpf(ax, &ex); ex -= 1; if (ex < -6) ex = -6; const float q = ldexpf(1.f, ex - 3); ax = nearbyintf(ax / q) * q; return copysignf(ax, v) / sc; }
#ifndef EMU_QCOL
#define EMU_QCOL(c) ((c) >= 2560)
#endif
struct EpiWinGE { Params p; const bf16_t* Hq;
    HD void operator()(int row, int c0, const float* a, const float* b) const { EpiWin e{p}; if (EMU_QCOL(c0)) e.one(row, c0, a, b, true); if (EMU_QCOL(c0 + 16)) e.one(row, c0 + 16, b, a, false); } };
static bf16_t* g_emu_tmp = nullptr;
#define EMU_FP8G_STEP
#define EMU_FP8G_AFTER(BAR) { bf16_t* Hq = g_emu_tmp; bf16_t* Wq = g_emu_tmp + (size_t)NR * DM; \
        for (long i = tid; i < (long)NR * DM; i += nthr) Hq[i] = f2bf(q8_(bf2f(WSP(const bf16_t, WS_H)[i]), 1.f)); \
        for (long i = tid; i < (long)INW * DM; i += nthr) Wq[i] = f2bf(q8_(bf2f(WSP(const bf16_t, WS_WIN)[i]), 256.f)); \
        BAR(); \
        { EpiWinGE e{p, Hq}; naive_gemm(Hq, DM, Wq, DM, NR, INW, DM, e, tid, nthr); } BAR(); }
#else
#define EMU_FP8G_STEP
#define EMU_FP8G_AFTER(BAR)
#endif
#if defined(HOST_EMU) && defined(EMU_FP8WO)
#define EMU_FP8WO_STEP(BAR) { for (long i = tid; i < (long)nact * DM; i += nthr) WSP(bf16_t, WS_MB)[i] = f2bf(q8e_(bf2f(WSP(const bf16_t, WS_MB)[i]), 4.f)); \
        for (long i = tid; i < (long)DM * DM; i += nthr) WSP(bf16_t, WS_WOUT)[i] = f2bf(q8e_(bf2f(WSP(const bf16_t, WS_WOUT)[i]), 256.f)); BAR(); }
#else
#define EMU_FP8WO_STEP(BAR)
#endif
#define NAIVE_PROGRAM(BAR) \
    ph_copy_x(p, tid, nthr); ph_mod(p, tid, nthr); BAR(); \
    for (int l = 0; l < DEPTH; ++l) { \
        const int nact = (l == 0) ? NR : NRL; \
        ph_prep_a(p, l, tid, nthr); ph_norm(p, l, 1, NR, tid, nthr); BAR(); \
        ph_prep_b(p, l, tid, nthr); BAR(); \
        ph_prep_c(p, l, tid, nthr); \
        EMU_FP8G_STEP \
        { EpiWin e{p}; naive_gemm(WSP(const bf16_t, WS_H), DM, WSP(const bf16_t, WS_WIN), DM, NR, INW, DM, e, tid, nthr); } BAR(); \
        EMU_FP8G_AFTER(BAR) \
        ph_ssm1_naive(p, tid, nthr); ph_attn_naive(p, l, tid, nthr); BAR(); \
        ph_ssm_carry(p, tid, nthr); ph_diff_norm(p, l, tid, nthr); BAR(); \
        ph_ssm2_naive(p, tid, nthr); BAR(); \
        { EpiGlu e{p}; naive_gemm(WSP(const bf16_t, WS_YG), 256, WSP(const bf16_t, WS_WGLU), 256, nact, 512, 256, e, tid, nthr); } BAR(); \
        { EpiMerge e{p, WS_SGS, false}; naive_gemm(WSP(const bf16_t, WS_YS), 256, WSP(const bf16_t, WS_WBS), 256, nact, DM, 256, e, tid, nthr); } BAR(); \
        { EpiMerge e{p, WS_SGD, true}; naive_gemm(WSP(const bf16_t, WS_YD), 512, WSP(const bf16_t, WS_WBD), 512, nact, DM, 512, e, tid, nthr); } BAR(); \
        { EpiMerge e{p, WS_SGN, true}; naive_gemm(WSP(const bf16_t, WS_YN), 256, WSP(const bf16_t, WS_WBN), 256, nact, DM, 256, e, tid, nthr); } BAR(); \
        EMU_FP8WO_STEP(BAR) \
        { EpiWout e{p, l}; naive_gemm(WSP(const bf16_t, WS_MB), DM, WSP(const bf16_t, WS_WOUT), DM, nact, DM, DM, e, tid, nthr); } BAR(); \
        ph_norm(p, l, 2, nact, tid, nthr); ph_tables(p, l, tid, nthr); BAR(); \
        { EpiScore e{p}; naive_gemm(WSP(const bf16_t, WS_H), DM, WSP(const bf16_t, WS_WSC), DM, nact, 2048, DM, e, tid, nthr); } BAR(); \
        ph_topk(p, nact, tid, nthr); BAR(); \
        ph_peer_act_naive(p, nact, tid, nthr); BAR(); \
        ph_peer_out_naive(p, l, nact, tid, nthr); BAR(); \
    } \
    ph_final_norm(p, tid, nthr);

#ifndef HOST_EMU
#define XB_TMO      128
#define XB_XCNT(j)  (256  + 64 * (j))
#define XB_XSUB(j)  (1280 + 64 * (j))
#define XB_XGEN(j)  (2304 + 64 * (j))
#define XB_TOP      3328
#define XB_TOPGEN   3392
#define XCD_BAR_WORDS 3456
#define XB_SPIN_CAP (1u << 26)
#define LAS __attribute__((address_space(3)))
__device__ __forceinline__ unsigned xb_ld(unsigned* p)              { return __hip_atomic_load(p, __ATOMIC_RELAXED, __HIP_MEMORY_SCOPE_AGENT); }
__device__ __forceinline__ unsigned xb_add(unsigned* p, unsigned v) { return __hip_atomic_fetch_add(p, v, __ATOMIC_RELAXED, __HIP_MEMORY_SCOPE_AGENT); }
__device__ __forceinline__ unsigned xb_xcc_id() { return (unsigned)__builtin_amdgcn_s_getreg((3 << 11) | 20) & 0xFu; }
#define XB_SPIN(cond, bar) do { unsigned _sp = 0; while (cond) { __builtin_amdgcn_s_sleep(1); \
    if ((++_sp & 255u) == 0u) { if (xb_ld(&(bar)[XB_TMO])) break; if (_sp > XB_SPIN_CAP) { atomicAdd(&(bar)[XB_TMO], 1u); break; } } } } while (0)
struct XcdBarrier { unsigned* bar; unsigned x; volatile LAS unsigned* st; };
__device__ __forceinline__ float shx(float v, int mask, int lane) { return __int_as_float(__builtin_amdgcn_ds_bpermute((lane ^ mask) << 2, __float_as_int(v))); }
__device__ __forceinline__ int tid_of(int wave_s) { int l_; asm volatile("v_mbcnt_lo_u32_b32 %0, -1, 0\n\tv_mbcnt_hi_u32_b32 %0, -1, %0" : "=v"(l_)); return wave_s * 64 + l_; }
__device__ __forceinline__ XcdBarrier xcd_barrier_post(unsigned* bar, volatile LAS unsigned* st, int tid0) {
    XcdBarrier b; b.bar = bar; b.x = xb_xcc_id(); b.st = st;
    if (tid0 == 0) (void)xb_add(&bar[XB_XCNT(b.x)], 1u);
    return b;
}
__device__ __forceinline__ void xcd_barrier_complete(unsigned* bar, unsigned x, unsigned& nloc, unsigned& nx) {
    const unsigned G = gridDim.x * gridDim.y * gridDim.z;
    unsigned sum, cnt, mine, sp = 0u;
    for (;;) {
        sum = 0u; cnt = 0u; mine = 0u;
#pragma unroll
        for (unsigned j = 0; j < 16; ++j) { const unsigned c = xb_ld(&bar[XB_XCNT(j)]); sum += c; cnt += (c > 0u) ? 1u : 0u; mine = (j == x) ? c : mine; }
        if (sum == G) break;
        __builtin_amdgcn_s_sleep(1);
        if ((++sp & 255u) == 0u) { if (xb_ld(&bar[XB_TMO])) break; if (sp > XB_SPIN_CAP) { atomicAdd(&bar[XB_TMO], 1u); break; } }
    }
    nloc = mine > 0u ? mine : 1u; nx = cnt > 0u ? cnt : 1u;
}
__device__ __forceinline__ void xcd_barrier(const XcdBarrier& b, int tid0) {
    asm volatile("s_waitcnt vmcnt(0)" ::: "memory");
    __syncthreads();
    if (tid0 == 0) {
        unsigned* bar = b.bar;
        __builtin_amdgcn_s_waitcnt(0);
        unsigned nloc = b.st[0], nx = b.st[1];
        if (nloc == 0u) { xcd_barrier_complete(bar, b.x, nloc, nx); b.st[0] = nloc; b.st[1] = nx; }
        const unsigned old = xb_add(&bar[XB_XSUB(b.x)], 1u);
        const unsigned gen = old / nloc;
        if (old + 1u == (gen + 1u) * nloc) {
            __builtin_amdgcn_fence(__ATOMIC_RELEASE, "agent");
            asm volatile("s_waitcnt vmcnt(0)" ::: "memory");
            const unsigned og = xb_add(&bar[XB_TOP], 1u);
            const unsigned tg = og / nx;
            if (og + 1u == (tg + 1u) * nx) xb_add(&bar[XB_TOPGEN], 1u);
            else XB_SPIN(xb_ld(&bar[XB_TOPGEN]) == tg, bar);
            __builtin_amdgcn_fence(__ATOMIC_ACQUIRE, "agent");
            xb_add(&bar[XB_XGEN(b.x)], 1u);
            asm volatile("s_waitcnt vmcnt(0)" ::: "memory");
        } else {
            XB_SPIN(xb_ld(&bar[XB_XGEN(b.x)]) == gen, bar);
            __builtin_amdgcn_fence(__ATOMIC_ACQUIRE, "agent");
            asm volatile("s_waitcnt vmcnt(0)" ::: "memory");
        }
    }
    __syncthreads();
}


namespace pg8 {
#define PG8_LAS __attribute__((address_space(3)))
typedef unsigned short bf16_t;
typedef short bf16x8 __attribute__((ext_vector_type(8)));
typedef float f32x4 __attribute__((ext_vector_type(4)));
typedef unsigned u32x4 __attribute__((ext_vector_type(4)));
constexpr int BM = 256, BK = 64, HALF = 128, HTB = HALF * BK * 2  , STAGE_BYTES = 8 * HTB, NXCD = 8, WGM = 8;

__host__ __device__ __forceinline__ int lds_byte(int r, int c) { const int st = (r >> 4) * 2 + (c >> 5), rr = r & 15, cc = c & 31, ob = rr * 64 + cc * 2; return st * 1024 + (ob ^ (((ob >> 9) & 1) << 5)); }
__host__ __device__ __forceinline__ void stage_rc(int b, int& R, int& C) { const int st = b / 1024, sb = b % 1024, swz = sb ^ (((sb >> 9) & 1) << 5); R = (st >> 1) * 16 + swz / 64; C = (st & 1) * 32 + (swz % 64) / 2; }
__host__ __device__ __forceinline__ int perm32(int rho) { const int n = rho >> 4, i = rho & 15; return 8 * (i >> 2) + 4 * n + (i & 3); }

struct Unit { int pm, pn, g; long arow, brow, bcol; };
struct Gemm { const bf16_t* A; const bf16_t* Bt; int lda, ldb, K; };

template <class Epi, class Sched, bool ALIGN_EPI = false, bool SP2 = false, bool FP8 = false>
__device__ __forceinline__ void gemm_phase(PG8_LAS unsigned char* lds, const Gemm g, const Sched& S, const Epi& E, int tid_in) {
    int tid_ = tid_in; asm volatile("" : "+v"(tid_));
    const int tid = tid_, wid = __builtin_amdgcn_readfirstlane(tid >> 6), lane = tid & 63, wr = wid >> 2, wc = wid & 3, fr = lane & 15, fq = lane >> 4;
    const int K = g.K, nt = K / BK;
    struct VOff { unsigned v; size_t step; } voffA, voffB;
    { int R, C; stage_rc(tid * 16, R, C); const int Rb = Epi::PERM ? ((R & ~31) + perm32(R & 31)) : R;
      voffA.v = (unsigned)(R * g.lda + C) * 2u; voffB.v = (unsigned)(Rb * g.ldb + C) * 2u; voffA.step = (size_t)64 * g.lda * 2; voffB.step = (size_t)64 * g.ldb * 2; }
    const size_t kstep = (size_t)(BK * 2);
    const size_t hstepA = (size_t)HALF * g.lda * 2, hstepB = (size_t)HALF * g.ldb * 2;
    const unsigned ldsw = (unsigned)wid * 1024u;
    const int aoff = lds_byte(wr * 64 + fr, fq * 8), boff = lds_byte(wc * 32 + fr, fq * 8);
#define PG8_SA(b, h) (((b) * 2 + (h)) * HTB)
#define PG8_SB(b, h) ((4 + (b) * 2 + (h)) * HTB)
#define PG8_STAGE(bufoff, gbase, voff) do { _Pragma("unroll") for (int _i = 0; _i < 2; ++_i) \
        __builtin_amdgcn_global_load_lds((const unsigned*)((const char*)(gbase) + _i * (voff).step + (voff).v), (PG8_LAS unsigned*)(lds + (bufoff) + ldsw + _i * 8192), 16, 0, 0); } while (0)
#define PG8_LDA(dst, b, h) do { _Pragma("unroll") for (int m = 0; m < 4; ++m) _Pragma("unroll") for (int k = 0; k < 2; ++k) dst[m][k] = *(const PG8_LAS bf16x8*)(lds + PG8_SA(b, h) + aoff + m * 2048 + k * 1024); } while (0)
#define PG8_LDB(dst, b, h) do { _Pragma("unroll") for (int n = 0; n < 2; ++n) _Pragma("unroll") for (int k = 0; k < 2; ++k) dst[n][k] = *(const PG8_LAS bf16x8*)(lds + PG8_SB(b, h) + boff + n * 2048 + k * 1024); } while (0)
#define PG8_MMA(ai, bj, At, Bt) do { __builtin_amdgcn_s_setprio(1); \
        if constexpr (FP8) { _Pragma("unroll") for (int m = 0; m < 4; ++m) _Pragma("unroll") for (int n = 0; n < 2; ++n) { \
            typedef int i32x8_ __attribute__((ext_vector_type(8))); typedef int i32x4_ __attribute__((ext_vector_type(4))); \
            const i32x8_ fa_ = __builtin_shufflevector(__builtin_bit_cast(i32x4_, Bt[n][0]), __builtin_bit_cast(i32x4_, Bt[n][1]), 0, 1, 2, 3, 4, 5, 6, 7); \
            const i32x8_ fb_ = __builtin_shufflevector(__builtin_bit_cast(i32x4_, At[m][0]), __builtin_bit_cast(i32x4_, At[m][1]), 0, 1, 2, 3, 4, 5, 6, 7); \
            acc[ai][bj][m][n] = __builtin_amdgcn_mfma_scale_f32_16x16x128_f8f6f4(fa_, fb_, acc[ai][bj][m][n], 0, 0, 0, 0x7b7b7b7b, 0, 0x7b7b7b7b); } } \
        else { _Pragma("unroll") for (int m = 0; m < 4; ++m) _Pragma("unroll") for (int n = 0; n < 2; ++n) _Pragma("unroll") for (int k = 0; k < 2; ++k) \
            acc[ai][bj][m][n] = __builtin_amdgcn_mfma_f32_16x16x32_bf16(Bt[n][k], At[m][k], acc[ai][bj][m][n], 0, 0, 0); } \
        __builtin_amdgcn_s_setprio(0); } while (0)
#define PG8_WAIT_V(n) asm volatile("s_waitcnt vmcnt(" #n ")" ::: "memory")
#define PG8_WAIT_L(n) asm volatile("s_waitcnt lgkmcnt(" #n ")" ::: "memory")
#define PG8_BAR __builtin_amdgcn_s_barrier()
#define PG8_SCHED __builtin_amdgcn_sched_barrier(0)
    Unit cur, nxt; int ui = 0;
    if (!S.next(0, cur)) return;
    f32x4 acc[2][2][4][2];
#pragma unroll
    for (int a = 0; a < 2; ++a)
#pragma unroll
        for (int b = 0; b < 2; ++b)
#pragma unroll
            for (int m = 0; m < 4; ++m)
#pragma unroll
                for (int n = 0; n < 2; ++n) acc[a][b][m][n] = (f32x4){0.f, 0.f, 0.f, 0.f};
    bf16x8 At[4][2], B0[2][2], B1[2][2];
    const char* cA = (const char*)g.A + (size_t)cur.arow * g.lda * 2; const char* cB = (const char*)g.Bt + ((size_t)cur.brow * g.ldb + cur.bcol) * 2;
    S.a_ready(cur);
    if constexpr (SP2) {
        PG8_STAGE(PG8_SB(0, 0), cB, voffB); PG8_STAGE(PG8_SB(0, 1), cB + hstepB, voffB); PG8_STAGE(PG8_SA(0, 0), cA, voffA); PG8_STAGE(PG8_SA(0, 1), cA + hstepA, voffA);
        if (wr == 1) PG8_BAR;
        PG8_WAIT_V(2); PG8_BAR;
        PG8_STAGE(PG8_SB(1, 0), cB + kstep, voffB); PG8_STAGE(PG8_SA(1, 0), cA + kstep, voffA); PG8_STAGE(PG8_SB(1, 1), cB + hstepB + kstep, voffB);
        PG8_WAIT_V(6); PG8_BAR;
    } else {
        PG8_STAGE(PG8_SB(0, 0), cB, voffB); PG8_STAGE(PG8_SA(0, 0), cA, voffA); PG8_STAGE(PG8_SB(0, 1), cB + hstepB, voffB); PG8_STAGE(PG8_SA(0, 1), cA + hstepA, voffA);
        if (wr == 1) PG8_BAR;
        PG8_WAIT_V(4); PG8_BAR;
        PG8_STAGE(PG8_SB(1, 0), cB + kstep, voffB); PG8_STAGE(PG8_SA(1, 0), cA + kstep, voffA); PG8_STAGE(PG8_SB(1, 1), cB + hstepB + kstep, voffB);
        PG8_WAIT_V(6); PG8_BAR;
    }
    for (;;) {
        const bool has_next = S.next(ui + 1, nxt);
        const char* nA = has_next ? (const char*)g.A + (size_t)nxt.arow * g.lda * 2 : cA; const char* nB = has_next ? (const char*)g.Bt + ((size_t)nxt.brow * g.ldb + nxt.bcol) * 2 : cB;
#pragma nounroll
        for (int t = 0; t < nt; t += 2) {
            const bool last = (t == nt - 2);
            const char* a1 = cA + (size_t)(t + 1) * kstep;
            const char* a2 = last ? nA : cA + (size_t)(t + 2) * kstep; const char* b2 = last ? nB : cB + (size_t)(t + 2) * kstep;
            const char* a3 = a2 + kstep; const char* b3 = b2 + kstep;
            if (last && has_next) S.a_ready(nxt);
            if constexpr (SP2) {
            PG8_LDB(B0, 0, 0); PG8_LDB(B1, 0, 1); PG8_SCHED; PG8_LDA(At, 0, 0); PG8_STAGE(PG8_SA(1, 1), a1 + hstepA, voffA);
            PG8_WAIT_V(8); PG8_WAIT_L(0); PG8_BAR; PG8_MMA(0, 0, At, B0); PG8_MMA(0, 1, At, B1); PG8_BAR; PG8_SCHED;
            PG8_LDA(At, 0, 1); PG8_STAGE(PG8_SB(0, 0), b2, voffB); PG8_STAGE(PG8_SB(0, 1), b2 + hstepB, voffB); PG8_STAGE(PG8_SA(0, 0), a2, voffA);
            PG8_WAIT_V(8); PG8_WAIT_L(0); PG8_BAR; PG8_MMA(1, 0, At, B0); PG8_MMA(1, 1, At, B1); PG8_BAR; PG8_SCHED;
            PG8_LDB(B0, 1, 0); PG8_LDB(B1, 1, 1); PG8_SCHED; PG8_LDA(At, 1, 0); PG8_STAGE(PG8_SA(0, 1), a2 + hstepA, voffA);
            PG8_WAIT_V(8); PG8_WAIT_L(0); PG8_BAR; PG8_MMA(0, 0, At, B0); PG8_MMA(0, 1, At, B1); PG8_BAR; PG8_SCHED;
            PG8_LDA(At, 1, 1); PG8_STAGE(PG8_SB(1, 0), b3, voffB); PG8_STAGE(PG8_SB(1, 1), b3 + hstepB, voffB); PG8_STAGE(PG8_SA(1, 0), a3, voffA);
            PG8_WAIT_V(8); PG8_WAIT_L(0); PG8_BAR; PG8_MMA(1, 0, At, B0); PG8_MMA(1, 1, At, B1); PG8_BAR; PG8_SCHED;
            } else {
            PG8_LDB(B0, 0, 0); PG8_SCHED; PG8_LDA(At, 0, 0); PG8_STAGE(PG8_SA(1, 1), a1 + hstepA, voffA);
            PG8_WAIT_L(8); PG8_BAR; PG8_WAIT_L(0); PG8_MMA(0, 0, At, B0); PG8_BAR; PG8_SCHED;
            PG8_LDB(B1, 0, 1); PG8_STAGE(PG8_SB(0, 0), b2, voffB);
            PG8_BAR; PG8_WAIT_L(0); PG8_MMA(0, 1, At, B1); PG8_BAR;
            PG8_LDA(At, 0, 1); PG8_STAGE(PG8_SA(0, 0), a2, voffA);
            PG8_BAR; PG8_WAIT_L(0); PG8_MMA(1, 0, At, B0); PG8_BAR; PG8_SCHED;
            PG8_STAGE(PG8_SB(0, 1), b2 + hstepB, voffB);
            PG8_WAIT_V(6); PG8_BAR; PG8_MMA(1, 1, At, B1); PG8_BAR;
            PG8_LDB(B0, 1, 0); PG8_SCHED; PG8_LDA(At, 1, 0); PG8_STAGE(PG8_SA(0, 1), a2 + hstepA, voffA);
            PG8_WAIT_L(8); PG8_BAR; PG8_WAIT_L(0); PG8_MMA(0, 0, At, B0); PG8_BAR; PG8_SCHED;
            PG8_LDB(B1, 1, 1); PG8_STAGE(PG8_SB(1, 0), b3, voffB);
            PG8_BAR; PG8_WAIT_L(0); PG8_MMA(0, 1, At, B1); PG8_BAR;
            PG8_LDA(At, 1, 1); PG8_STAGE(PG8_SA(1, 0), a3, voffA);
            PG8_BAR; PG8_WAIT_L(0); PG8_MMA(1, 0, At, B0); PG8_BAR; PG8_SCHED;
            PG8_STAGE(PG8_SB(1, 1), b3 + hstepB, voffB);
            PG8_WAIT_V(6); PG8_BAR; PG8_MMA(1, 1, At, B1); PG8_BAR;
            }
        }
        if constexpr (ALIGN_EPI) { if (wr == 0) PG8_BAR; }
        if constexpr (!Epi::AFTER_DRAIN) { E(acc, cur, wr, wc, fr, fq); S.done(cur); }
        if (!has_next) break;
#pragma unroll
        for (int a = 0; a < 2; ++a)
#pragma unroll
            for (int b = 0; b < 2; ++b)
#pragma unroll
                for (int m = 0; m < 4; ++m)
#pragma unroll
                    for (int n = 0; n < 2; ++n) acc[a][b][m][n] = (f32x4){0.f, 0.f, 0.f, 0.f};
        cur = nxt; cA = nA; cB = nB; ++ui;
        if constexpr (ALIGN_EPI) { if (wr == 1) PG8_BAR; }
    }
    PG8_WAIT_V(0);
    if constexpr (!ALIGN_EPI) { if (wr == 0) PG8_BAR; }
    PG8_BAR;
    if constexpr (Epi::AFTER_DRAIN) { E.fused(acc, cur, wr, wc, fr, fq, lds, wid, lane); S.done(cur); }
#undef PG8_SA
#undef PG8_SB
#undef PG8_STAGE
#undef PG8_LDA
#undef PG8_LDB
#undef PG8_MMA
#undef PG8_WAIT_V
#undef PG8_WAIT_L
#undef PG8_BAR
#undef PG8_SCHED
}
}

#define PG8_SP2 true
#define PG8_ALIGN true
typedef pg8::f32x4 f32x4;
struct SchedFlat {
    int nM, nN, nwg, G, c;
    __device__ __forceinline__ void init(int nM_, int nN_, int G_, int c_) { nM = nM_; nN = nN_; nwg = nM * nN; G = G_; c = c_; }
    __device__ __forceinline__ bool next(int i, pg8::Unit& u) const {
        const long L = (long)i * G + c; if (L >= nwg) return false;
        int wgid = (int)L; { const int q = nwg / 8, r = nwg % 8, xcd = wgid % 8, off = wgid / 8; wgid = (xcd < r ? xcd * (q + 1) : r * (q + 1) + (xcd - r) * q) + off; }
        const int nig = 8 * nN, gid = wgid / nig, fm = gid * 8, gsz = (nM - fm) < 8 ? (nM - fm) : 8;
        u.pm = fm + ((wgid % nig) % gsz); u.pn = (wgid % nig) / gsz; u.g = 0; u.arow = (long)u.pm * 256; u.brow = (long)u.pn * 256; u.bcol = 0; return true;
    }
    __device__ __forceinline__ void a_ready(const pg8::Unit&) const {}
    __device__ __forceinline__ void done(const pg8::Unit&) const {}
};
struct SchedGrouped {
    int tm, tn, arows, brows, G, c;
    __device__ __forceinline__ bool next(int i, pg8::Unit& u) const {
        const int L = i * G + c; if (L >= 16 * tm * tn) return false;
        const int g = L / (tm * tn), rem = L % (tm * tn);
        u.g = g; u.pm = rem % tm; u.pn = rem / tm; u.arow = (long)g * arows + u.pm * 256; u.brow = (long)g * brows + u.pn * 256; u.bcol = 0; return true;
    }
    __device__ __forceinline__ void a_ready(const pg8::Unit&) const {}
    __device__ __forceinline__ void done(const pg8::Unit&) const {}
};
struct SchedWsc {
    int G, c;
    __device__ __forceinline__ bool next(int i, pg8::Unit& u) const {
        const int L = i * G + c; if (L >= 32) return false;
        u.g = 0; u.pm = L & 7; u.pn = L >> 3; u.arow = (long)u.pm * 256; u.brow = (long)u.pn * 256; u.bcol = (long)u.pm * 256; return true;
    }
    __device__ __forceinline__ void a_ready(const pg8::Unit&) const {}
    __device__ __forceinline__ void done(const pg8::Unit&) const {}
};
template <class F> struct EpiNoFence { static constexpr bool value = true; };
template <> struct EpiNoFence<EpiMerge> { static constexpr bool value = true; };
template <> struct EpiNoFence<EpiWout> { static constexpr bool value = true; };
template <class F> struct EpiAdapt {
    static constexpr bool PERM = false, AFTER_DRAIN = false;
    F f;
    __device__ __forceinline__ void operator()(const f32x4 (&acc)[2][2][4][2], const pg8::Unit& u, int wr, int wc, int fr_, int fq_) const {
        int l2_; asm volatile("v_mbcnt_lo_u32_b32 %0, -1, 0\n\tv_mbcnt_hi_u32_b32 %0, -1, %0" : "=v"(l2_)); (void)fr_; (void)fq_;
        const int fr = l2_ & 15, fq = l2_ >> 4;
        F ff = f; ff.set_group(u.g);
#pragma unroll
        for (int bj = 0; bj < 2; ++bj) { const int c0 = u.pn * 256 + bj * 128 + wc * 32 + 4 * fq;
#pragma unroll
            for (int ai = 0; ai < 2; ++ai)
#pragma unroll
                for (int m = 0; m < 4; ++m) { int row = u.pm * 256 + ai * 128 + wr * 64 + m * 16 + fr; asm volatile("" : "+v"(row));
                    const f32x4 v0 = acc[ai][bj][m][0], v1 = acc[ai][bj][m][1];
                    const float a[4] = {v0[0], v0[1], v0[2], v0[3]}, b[4] = {v1[0], v1[1], v1[2], v1[3]};
                    ff(row, c0, a, b); if constexpr (!EpiNoFence<F>::value) asm volatile("" ::: "memory"); } }
    }
};


template <> struct EpiAdapt<EpiWinG> {
    static constexpr bool PERM = false, AFTER_DRAIN = false;
    EpiWinG f;
    template <int R> __device__ __forceinline__ void run(const f32x4 (&acc)[2][2][4][2], const pg8::Unit& u, int wr, int wc) const {
        int l2_; asm volatile("v_mbcnt_lo_u32_b32 %0, -1, 0\n\tv_mbcnt_hi_u32_b32 %0, -1, %0" : "=v"(l2_));
        const int fr = l2_ & 15, fq = l2_ >> 4;
#pragma unroll
        for (int bj = 0; bj < 2; ++bj) { const int c0 = u.pn * 256 + bj * 128 + wc * 32 + 4 * fq;
#pragma unroll
            for (int ai = 0; ai < 2; ++ai)
#pragma unroll
                for (int m = 0; m < 4; ++m) { int row = u.pm * 256 + ai * 128 + wr * 64 + m * 16 + fr; asm volatile("" : "+v"(row));
                    const f32x4 v0 = acc[ai][bj][m][0], v1 = acc[ai][bj][m][1];
                    const float a[4] = {v0[0], v0[1], v0[2], v0[3]}, b[4] = {v1[0], v1[1], v1[2], v1[3]};
                    f.template tile<R>(row, c0, a, b); asm volatile("" ::: "memory"); } }
    }
    __device__ __forceinline__ void operator()(const f32x4 (&acc)[2][2][4][2], const pg8::Unit& u, int wr, int wc, int, int) const {
        const int pn = __builtin_amdgcn_readfirstlane(u.pn);
        if (pn == 0) run<0>(acc, u, wr, wc); else if (pn < 5) run<1>(acc, u, wr, wc); else if (pn < 7) run<2>(acc, u, wr, wc); else if (pn < 10) run<3>(acc, u, wr, wc); else run<4>(acc, u, wr, wc);
    }
};

namespace dattn {
typedef short bf16x8 __attribute__((ext_vector_type(8)));
typedef short s16x4 __attribute__((ext_vector_type(4)));
typedef float f32x16 __attribute__((ext_vector_type(16)));
typedef unsigned u32x4 __attribute__((ext_vector_type(4)));
typedef float f32x2_t __attribute__((ext_vector_type(2))); typedef __bf16 bf16x2_t __attribute__((ext_vector_type(2)));
constexpr int KP = 272, VDT = 4160, KBYTES = 64 * KP, VBYTES = 4 * VDT, STAGE = KBYTES + VBYTES;
static_assert(3 * KBYTES + 2 * VBYTES <= 131072 && 4 * 128 * 32 * 4 <= 131072, "attention LDS");
__device__ __forceinline__ unsigned cvtpk(float lo, float hi) { f32x2_t v = {lo, hi}; bf16x2_t b = __builtin_convertvector(v, bf16x2_t); return __builtin_bit_cast(unsigned, b); }
__device__ __forceinline__ int crow(int reg, int h) { return (reg & 3) + 8 * (reg >> 2) + 4 * h; }
__device__ __forceinline__ float max3f(float a, float b, float c) { float r; asm("v_max3_f32 %0, %1, %2, %3" : "=v"(r) : "v"(a), "v"(b), "v"(c)); return r; }
__device__ __forceinline__ float max2f(float a, float b) { float r; asm("v_max_f32_e32 %0, %1, %2" : "=v"(r) : "v"(a), "v"(b)); return r; }
__device__ __forceinline__ float tile_max(f32x16& pA, f32x16& pB) {
    asm volatile("s_nop 15\n\ts_nop 7" : "+v"(pA), "+v"(pB));
    float a = max3f(pA[0], pA[1], pB[0]), b = max3f(pA[2], pA[3], pB[1]); a = max3f(a, pB[2], pB[3]);
#pragma unroll
    for (int r = 4; r < 16; r += 4) { a = max3f(a, pA[r], pA[r + 1]); b = max3f(b, pA[r + 2], pA[r + 3]); a = max3f(a, pB[r], pB[r + 1]); b = max3f(b, pB[r + 2], pB[r + 3]); }
    const float m = max2f(a, b);
    const unsigned tu = __float_as_uint(m); auto rr = __builtin_amdgcn_permlane32_swap(tu, tu, false, false);
    return max2f(__uint_as_float(rr[0]), __uint_as_float(rr[1]));
}
__device__ __forceinline__ float tile_max_old(const f32x16& pA, const f32x16& pB) {
    float a, b;
    asm volatile("v_max3_f32 %0, %1, %2, %3\n\tv_max3_f32 %0, %0, %4, %5\n\tv_max3_f32 %0, %0, %6, %7\n\tv_max3_f32 %0, %0, %8, %9\n\tv_max3_f32 %0, %0, %10, %11\n\tv_max3_f32 %0, %0, %12, %13\n\tv_max3_f32 %0, %0, %14, %15\n\tv_max_f32 %0, %0, %16"
        : "=&v"(a) : "v"(pA[0]), "v"(pA[1]), "v"(pA[2]), "v"(pA[3]), "v"(pA[4]), "v"(pA[5]), "v"(pA[6]), "v"(pA[7]), "v"(pA[8]), "v"(pA[9]), "v"(pA[10]), "v"(pA[11]), "v"(pA[12]), "v"(pA[13]), "v"(pA[14]), "v"(pA[15]));
    asm volatile("v_max3_f32 %0, %1, %2, %3\n\tv_max3_f32 %0, %0, %4, %5\n\tv_max3_f32 %0, %0, %6, %7\n\tv_max3_f32 %0, %0, %8, %9\n\tv_max3_f32 %0, %0, %10, %11\n\tv_max3_f32 %0, %0, %12, %13\n\tv_max3_f32 %0, %0, %14, %15\n\tv_max_f32 %0, %0, %16"
        : "=&v"(b) : "v"(pB[0]), "v"(pB[1]), "v"(pB[2]), "v"(pB[3]), "v"(pB[4]), "v"(pB[5]), "v"(pB[6]), "v"(pB[7]), "v"(pB[8]), "v"(pB[9]), "v"(pB[10]), "v"(pB[11]), "v"(pB[12]), "v"(pB[13]), "v"(pB[14]), "v"(pB[15]));
    const float m = max2f(a, b);
    const unsigned tu = __float_as_uint(m); auto rr = __builtin_amdgcn_permlane32_swap(tu, tu, false, false);
    return max2f(__uint_as_float(rr[0]), __uint_as_float(rr[1]));
}
#define DA_PACK(x, s) __builtin_bit_cast(bf16x8, (u32x4){cvtpk(x[8 * (s)], x[8 * (s) + 1]), cvtpk(x[8 * (s) + 2], x[8 * (s) + 3]), cvtpk(x[8 * (s) + 4], x[8 * (s) + 5]), cvtpk(x[8 * (s) + 6], x[8 * (s) + 7])})
typedef int i32x8 __attribute__((ext_vector_type(8))); typedef int i32x4 __attribute__((ext_vector_type(4)));
__device__ __forceinline__ int pk4f8(float a, float b, float c, float d) { int w = 0; w = __builtin_amdgcn_cvt_pk_fp8_f32(a, b, w, false); return __builtin_amdgcn_cvt_pk_fp8_f32(c, d, w, true); }
#define DA_RP1(w, a, b, c, d) do { w = __builtin_amdgcn_cvt_pk_fp8_f32(a, b, w, false); w = __builtin_amdgcn_cvt_pk_fp8_f32(c, d, w, true); } while (0)
#define DA_REPACK8(pf, x, y) do { DA_RP1(pf[0], x[0], x[1], x[2], x[3]); DA_RP1(pf[1], x[4], x[5], x[6], x[7]); DA_RP1(pf[2], x[8], x[9], x[10], x[11]); DA_RP1(pf[3], x[12], x[13], x[14], x[15]); \
        DA_RP1(pf[4], y[0], y[1], y[2], y[3]); DA_RP1(pf[5], y[4], y[5], y[6], y[7]); DA_RP1(pf[6], y[8], y[9], y[10], y[11]); DA_RP1(pf[7], y[12], y[13], y[14], y[15]); } while (0)
#define DA_PACK8(x, y) (i32x8){pk4f8(x[0], x[1], x[2], x[3]), pk4f8(x[4], x[5], x[6], x[7]), pk4f8(x[8], x[9], x[10], x[11]), pk4f8(x[12], x[13], x[14], x[15]), \
                               pk4f8(y[0], y[1], y[2], y[3]), pk4f8(y[4], y[5], y[6], y[7]), pk4f8(y[8], y[9], y[10], y[11]), pk4f8(y[12], y[13], y[14], y[15])}
typedef short v4i16_t __attribute__((ext_vector_type(4)));
__device__ __forceinline__ s16x4 vtr(const PG8_LAS unsigned char* q) { return __builtin_bit_cast(s16x4, __builtin_amdgcn_ds_read_tr16_b64_v4i16((PG8_LAS v4i16_t*)q)); }

__device__ __forceinline__ void diff_unit(const Params& p, int l, PG8_LAS unsigned char* lds, int b, int hh, int qrow0, bool isctx, int wave_s) {
    int tid_ = tid_of(wave_s); asm volatile("" : "+v"(tid_));
    const int tid = tid_, lane = tid & 63, wid = __builtin_amdgcn_readfirstlane(tid >> 6), m = wid >> 2, qt = wid & 3, r = lane & 31, h = lane >> 5;
    const int nkt = isctx ? C_ / 64 : (C_ + L_) / 64;
    i32x8 qf8;
    { const unsigned char GPTR* qp = (const unsigned char GPTR*)(p.ws + WS_QD) + (size_t)(qrow0 + qt * 32 + r) * 512 + hh * 128 + m * 64 + h * 32;
      qf8 = __builtin_shufflevector(*(const i32x4 GPTR*)qp, *(const i32x4 GPTR*)(qp + 16), 0, 1, 2, 3, 4, 5, 6, 7); }
    f32x16 o[4];
#pragma unroll
    for (int dt = 0; dt < 4; ++dt)
#pragma unroll
        for (int i = 0; i < 16; ++i) o[dt][i] = 0.f;
    float mrun = 0.f;
    i32x8 onesA; { const int on_ = (((lane & 15) == 0 && ((lane >> 4) & 1) == 0) || ((lane & 15) == 1 && ((lane >> 4) & 1) == 1)) ? 0x38383838 : 0;
#pragma unroll
      for (int i = 0; i < 8; ++i) onesA[i] = on_; }
    f32x4 lacc = {0.f, 0.f, 0.f, 0.f};
    constexpr int KPD = 128, KBYTES = 64 * KPD;
    const unsigned char GPTR* K8g = (const unsigned char GPTR*)(p.ws + WS_KD); const unsigned char GPTR* VTg = (const unsigned char GPTR*)(p.ws + WS_VT8);
    unsigned kgo;
    { const int row = 8 * wid + (lane >> 3), lc = (lane & 7) ^ ((row >> 1) & 7);
      const int kap = 32 * ((row >> 2) & 1) + (row & 3) + 4 * ((row & 31) >> 3) + 16 * (row >> 5); kgo = (unsigned)(kap * 512 + hh * 128 + lc * 16); }
    unsigned vgo; { const int d = 16 * wid + (lane >> 2), lc = (lane & 3) ^ ((d >> 2) & 3); vgo = (unsigned)(((b * 4 + hh) * 128 + d) * KVP + lc * 16); }
#define DA_ROW0(t) ((isctx || (t) < C_ / 64) ? (NRL + b * C_ + (t) * 64) : (b * L_ + ((t) - C_ / 64) * 64))
    const unsigned kro = (unsigned)(r * KPD + (((m * 4 + 2 * h) ^ ((r >> 1) & 7)) * 16));
    const unsigned vro0 = (unsigned)(r * 64 + (((2 * h) ^ ((r >> 2) & 3)) * 16)), vro1 = (unsigned)(r * 64 + (((2 * h + 1) ^ ((r >> 2) & 3)) * 16));
    PG8_LAS unsigned char* const KB0 = lds; PG8_LAS unsigned char* const VB0 = lds + 4 * KBYTES;
    constexpr int V8BYTES = 128 * 64;
    int scq_ = 0x7c7c7c7c; asm volatile("" : "+v"(scq_));
    int sc1_ = 0x7f7f7f7f; asm volatile("" : "+v"(sc1_));
#define DA_DMAK(t, boff) __builtin_amdgcn_global_load_lds((const unsigned GPTR*)(K8g + (size_t)DA_ROW0(t) * 512 + kgo), (PG8_LAS unsigned*)(KB0 + (boff) + wid * 1024), 16, 0, 0)
#define DA_DMAV(t, boff) __builtin_amdgcn_global_load_lds((const unsigned GPTR*)(VTg + vgo + (t) * 64), (PG8_LAS unsigned*)(VB0 + (boff) + wid * 1024), 16, 0, 0)
#define DA_LDK(off) __builtin_shufflevector(*(const PG8_LAS i32x4*)(Kb_ + (off)), *(const PG8_LAS i32x4*)(Kb_ + ((off) ^ 16)), 0, 1, 2, 3, 4, 5, 6, 7)
    const bf16x8 onesK = __builtin_bit_cast(bf16x8, (u32x4){h == 0 ? 0x3f80u : 0u, 0u, 0u, 0u});
    u32x4 negmB = {0u, 0u, 0u, 0u};
    const f32x16 zero16 = {0.f, 0.f, 0.f, 0.f, 0.f, 0.f, 0.f, 0.f, 0.f, 0.f, 0.f, 0.f, 0.f, 0.f, 0.f, 0.f};
#define DA_SETM() do { negmB[0] = h == 0 ? ((__float_as_uint(mrun) ^ 0x80000000u) >> 16) : 0u; } while (0)
#define DA_BFR(x) __uint_as_float((__float_as_uint(x) + 0x7fffu + ((__float_as_uint(x) >> 16) & 1u)) & 0xffff0000u)
#define DA_QK(PA, PB, boff) do { const PG8_LAS unsigned char* Kb_ = KB0 + (boff); \
        const f32x16 negm = __builtin_amdgcn_mfma_f32_32x32x16_bf16(onesK, __builtin_bit_cast(bf16x8, negmB), zero16, 0, 0, 0); \
        const i32x8 kfa_ = DA_LDK(kro), kfb_ = DA_LDK(kro + 32 * KPD); \
        __builtin_amdgcn_sched_barrier(0); \
        PA = __builtin_amdgcn_mfma_scale_f32_32x32x64_f8f6f4(kfa_, qf8, negm, 0, 0, 0, scq_, 0, scq_); \
        PB = __builtin_amdgcn_mfma_scale_f32_32x32x64_f8f6f4(kfb_, qf8, negm, 0, 0, 0, scq_, 0, scq_); } while (0)
    DA_DMAK(0, 0); DA_DMAK(1, KBYTES); DA_DMAV(0, 0); DA_DMAK(2, 2 * KBYTES); DA_DMAV(1, V8BYTES); DA_DMAK(3, 3 * KBYTES);
    asm volatile("s_waitcnt vmcnt(0)" ::: "memory"); __syncthreads();
    f32x16 pA, pB, nA, nB;
    DA_QK(pA, pB, 0);
    DA_QK(nA, nB, KBYTES);
    i32x8 pf8;
    { const float tm = DA_BFR(tile_max(pA, pB));
      mrun = tm; DA_SETM();
#pragma unroll
      for (int i = 0; i < 16; ++i) { pA[i] = __builtin_amdgcn_exp2f(pA[i] - tm); pB[i] = __builtin_amdgcn_exp2f(pB[i] - tm); nA[i] -= tm; nB[i] -= tm; }
      pf8 = DA_PACK8(pA, pB); }
    __syncthreads();
    if (wid >= 4) __builtin_amdgcn_s_setprio(1);
    int b0 = 0, b1 = 1, b2 = 2;
#define DA_LDV(dst, dt) dst = __builtin_shufflevector(*(const PG8_LAS i32x4*)(Vb + vro0 + (dt) * 2048), *(const PG8_LAS i32x4*)(Vb + vro1 + (dt) * 2048), 0, 1, 2, 3, 4, 5, 6, 7)
#define DA_PV(dt, src) o[dt] = __builtin_amdgcn_mfma_scale_f32_32x32x64_f8f6f4(src, pf8, o[dt], 0, 0, 0, sc1_, 0, sc1_)
#define DA_EXP8(XA, XB, k) do { float e0_ = __builtin_amdgcn_exp2f(XA[4 * (k)]), e1_ = __builtin_amdgcn_exp2f(XA[4 * (k) + 1]), e2_ = __builtin_amdgcn_exp2f(XA[4 * (k) + 2]), e3_ = __builtin_amdgcn_exp2f(XA[4 * (k) + 3]), \
            e4_ = __builtin_amdgcn_exp2f(XB[4 * (k)]), e5_ = __builtin_amdgcn_exp2f(XB[4 * (k) + 1]), e6_ = __builtin_amdgcn_exp2f(XB[4 * (k) + 2]), e7_ = __builtin_amdgcn_exp2f(XB[4 * (k) + 3]); \
        asm volatile("" : "+v"(e0_), "+v"(e1_), "+v"(e2_), "+v"(e3_), "+v"(e4_), "+v"(e5_), "+v"(e6_), "+v"(e7_));        \
        XA[4 * (k)] = e0_; XA[4 * (k) + 1] = e1_; XA[4 * (k) + 2] = e2_; XA[4 * (k) + 3] = e3_; XB[4 * (k)] = e4_; XB[4 * (k) + 1] = e5_; XB[4 * (k) + 2] = e6_; XB[4 * (k) + 3] = e7_; } while (0)
#define DA_SB __builtin_amdgcn_sched_barrier(0)
#define DA_ITER(XA, XB, YA, YB) do { \
        const bool more1 = (t + 1 < nkt), more2 = (t + 2 < nkt), more4 = (t + 4 < nkt); \
        if (more4) DA_DMAK(t + 4, (t & 3) * KBYTES);         \
        if (more2) DA_DMAV(t + 2, b2 * V8BYTES); \
        if (more2) DA_QK(YA, YB, ((t + 2) & 3) * KBYTES); \
        DA_SB; \
        const PG8_LAS unsigned char* Vb = VB0 + b0 * V8BYTES; \
        float alpha = 1.f; bool resc = false; \
        { const float tm = tile_max_old(XA, XB);        \
            const bool need = more1 && tm > 8.0f; \
            if (__builtin_amdgcn_ballot_w64(need) != 0ull) { const float mn_ = need ? DA_BFR(mrun + tm) : mrun, dl = mn_ - mrun; alpha = __builtin_amdgcn_exp2f(-dl); resc = true; mrun = mn_; DA_SETM(); \
                _Pragma("unroll") for (int i = 0; i < 16; ++i) { XA[i] -= dl; XB[i] -= dl; } \
                if (more2) { _Pragma("unroll") for (int i = 0; i < 16; ++i) { YA[i] -= dl; YB[i] -= dl; } } } } \
        i32x8 vfa, vfb; \
        DA_SB; DA_LDV(vfa, 0); DA_LDV(vfb, 1); \
        DA_SB; DA_PV(0, vfa); DA_SB; DA_EXP8(XA, XB, 0); DA_LDV(vfa, 2); \
        DA_SB; DA_PV(1, vfb); DA_SB; DA_EXP8(XA, XB, 1); DA_LDV(vfb, 3); \
        DA_SB; DA_PV(2, vfa); DA_SB; DA_EXP8(XA, XB, 2); \
        DA_SB; DA_PV(3, vfb); DA_SB; DA_EXP8(XA, XB, 3); \
        DA_SB; lacc = __builtin_amdgcn_mfma_scale_f32_16x16x128_f8f6f4(onesA, pf8, lacc, 0, 0, 0, sc1_, 0, sc1_); DA_SB; \
        if (resc) { lacc[0] *= alpha; lacc[1] *= shx(alpha, 16, lane); \
            _Pragma("unroll") for (int dt = 0; dt < 4; ++dt) _Pragma("unroll") for (int i = 0; i < 16; ++i) o[dt][i] *= alpha; } \
        DA_REPACK8(pf8, XA, XB); \
        if (more4) asm volatile("s_waitcnt vmcnt(2)" ::: "memory"); else asm volatile("s_waitcnt vmcnt(0)" ::: "memory");     \
        asm volatile("s_waitcnt lgkmcnt(0)" ::: "memory"); __builtin_amdgcn_s_barrier(); asm volatile("" ::: "memory");        \
        { const int r_ = b0; b0 = b1; b1 = b2; b2 = r_; } } while (0)
    for (int t = 0; t < nkt; ++t) {
        DA_ITER(nA, nB, pA, pB);
        ++t;
        DA_ITER(pA, pB, nA, nB);
    }
#undef DA_ITER
#undef DA_SB
#undef DA_EXP8
#undef DA_LDV
#undef DA_PV
#undef DA_DMAK
#undef DA_DMAV
#undef DA_QK
#undef DA_ROW0
    __builtin_amdgcn_s_setprio(0);
    const float l0_ = __int_as_float(__builtin_amdgcn_ds_bpermute((lane & 15) << 2, __float_as_int(lacc[0]))), l1_ = __int_as_float(__builtin_amdgcn_ds_bpermute((lane & 15) << 2, __float_as_int(lacc[1])));
    const float inv = 1.f / ((lane & 16) ? l1_ : l0_);
    PG8_LAS float* X = (PG8_LAS float*)lds;
    if (m == 1) {
#pragma unroll
        for (int dt = 0; dt < 4; ++dt)
#pragma unroll
            for (int i = 0; i < 16; ++i) X[(qt * 128 + dt * 32 + crow(i, h)) * 32 + r] = o[dt][i] * inv;
    }
    __syncthreads();
    if (m == 0) {
        const float lam = WSP(const float, WS_LAMD)[l], oml = WSP(const float, WS_LAMD)[2 + l];
        float ss = 0.f;
#pragma unroll
        for (int dt = 0; dt < 4; ++dt)
#pragma unroll
            for (int i = 0; i < 16; ++i) { const float v = o[dt][i] * inv - lam * X[(qt * 128 + dt * 32 + crow(i, h)) * 32 + r]; o[dt][i] = v; ss += v * v; }
        ss += shx(ss, 32, lane);
        const float rinv = oml / sqrtf(ss * (1.f / 128.f) + RMS_EPS);
        const float* sg = p.in[I_SUBLN] + (size_t)l * 128;
        bf16_t* y = WSP(bf16_t, WS_YD) + (size_t)(qrow0 + qt * 32 + r) * 512 + hh * 128;
#pragma unroll
        for (int dt = 0; dt < 4; ++dt)
#pragma unroll
            for (int g4 = 0; g4 < 4; ++g4) { const int d = dt * 32 + 8 * g4 + 4 * h;
                const unsigned w0 = cvtpk(o[dt][4 * g4] * rinv * sg[d], o[dt][4 * g4 + 1] * rinv * sg[d + 1]), w1 = cvtpk(o[dt][4 * g4 + 2] * rinv * sg[d + 2], o[dt][4 * g4 + 3] * rinv * sg[d + 3]);
                *(uint2*)(y + d) = make_uint2(w0, w1); }
    }
    __syncthreads();
}
__device__ __forceinline__ void diff_phase(const Params& p, int l, PG8_LAS unsigned char* lds, int wave_s) {
    const int G = gridDim.x, bid = blockIdx.x;
    constexpr int NQB = L_ / 128, NU = B_ * 4 * NQB;
    if (G % 8 == 0 && (16 % (G / 8) == 0 || (G / 8) % 16 == 0 || true)) {
        const int xcd = bid % 8, slot = bid / 8, per = G / 8;
        for (int combo = xcd; combo < B_ * 4; combo += 8)
            for (int qb = slot; qb < NQB; qb += per) diff_unit(p, l, lds, combo >> 2, combo & 3, (combo >> 2) * L_ + qb * 128, false, wave_s);
    } else {
        for (int u = bid; u < NU; u += G) { const int combo = u / NQB, qb = u % NQB; diff_unit(p, l, lds, combo >> 2, combo & 3, (combo >> 2) * L_ + qb * 128, false, wave_s); }
    }
    if (l == 0) { constexpr int NCU = B_ * 4 * (C_ / 128);
        for (int u = bid; u < NCU; u += G) { const int combo = u / (C_ / 128), qb = u % (C_ / 128); diff_unit(p, l, lds, combo >> 2, combo & 3, NRL + (combo >> 2) * C_ + qb * 128, true, wave_s); } }
}
}


namespace nattn {
#define DA_BFR_(x) __uint_as_float((__float_as_uint(x) + 0x7fffu + ((__float_as_uint(x) >> 16) & 1u)) & 0xffff0000u)
using dattn::bf16x8; using dattn::s16x4; using dattn::f32x16; using dattn::u32x4; using dattn::cvtpk; using dattn::crow; using dattn::vtr;
constexpr int KP = 144, VDT = 4160, KBYTES = 64 * KP, VBYTES = 2 * VDT, STAGE = KBYTES + VBYTES, BIAS_OFF = 2 * STAGE;
static_assert(C_ % 64 == 0 && (C_ == 256), "context-query units assume 256 context rows");
__device__ __forceinline__ int rs_of(int r) { int v = r - 4; v = v < 0 ? 0 : v; return v > GRR - 8 ? GRR - 8 : v; }
__device__ __forceinline__ void na_unit(const Params& p, int l, PG8_LAS unsigned char* lds, int b, int hh, int r0, bool isctx, int wave_s) {
    int tid_ = tid_of(wave_s); asm volatile("" : "+v"(tid_));
    const int tid = tid_, lane = tid & 63, wid = __builtin_amdgcn_readfirstlane(tid >> 6), r = lane & 31, h = lane >> 5;
    const bf16_t* QN = WSP(const bf16_t, WS_QN); const bf16_t* KN = WSP(const bf16_t, WS_KN); const bf16_t* VN = WSP(const bf16_t, WS_VN);
    const int rq = r0 + (wid >> 1), cq = (wid & 1) * 32 + r;
    const int qrow = isctx ? NRL + b * C_ + wid * 32 + r : b * L_ + rq * GRW + cq;
    const int rsq = rs_of(rq); int csq = cq - 8; csq = csq < 0 ? 0 : (csq > GRW - 16 ? GRW - 16 : csq);
    const int kr_lo = rs_of(r0), kr_hi = rs_of(r0 + 3) + 8;
    const int nct = C_ / 64, nkt = isctx ? nct : nct + (kr_hi - kr_lo);
    PG8_LAS float* BT = (PG8_LAS float*)(lds + BIAS_OFF);
    if (tid < 15 * 32) BT[tid] = (tid & 31) < 31 ? p.in[I_RPB][((size_t)l * 4 + hh) * 465 + (tid >> 5) * 31 + (tid & 31)] * LOG2E : -1e30f;
    bf16x8 qf[4];
    { const bf16_t* qp = QN + (size_t)qrow * 256 + hh * 64 + h * 8;
#pragma unroll
      for (int d0 = 0; d0 < 4; ++d0) qf[d0] = *(const bf16x8*)(qp + d0 * 16); }
    f32x16 o[2];
#pragma unroll
    for (int dt = 0; dt < 2; ++dt)
#pragma unroll
        for (int i = 0; i < 16; ++i) o[dt][i] = 0.f;
    float mrun = 0.f, lrun = 0.f;
    unsigned coA[16], coB[16];
#pragma unroll
    for (int i = 0; i < 16; ++i) { const int kcA = crow(i, h), kcB = 32 + kcA;
        coA[i] = (unsigned)(((unsigned)(kcA - csq) < 16u ? 15 - cq + kcA : 31) * 4); coB[i] = (unsigned)(((unsigned)(kcB - csq) < 16u ? 15 - cq + kcB : 31) * 4); }
    const bf16x8 onesK = __builtin_bit_cast(bf16x8, (u32x4){h == 0 ? 0x3f80u : 0u, 0u, 0u, 0u});
    u32x4 negmB = {0u, 0u, 0u, 0u};
    const f32x16 zero16 = {0.f, 0.f, 0.f, 0.f, 0.f, 0.f, 0.f, 0.f, 0.f, 0.f, 0.f, 0.f, 0.f, 0.f, 0.f, 0.f};
    const int srow = tid >> 3, sc8 = tid & 7;
    const unsigned kw = (unsigned)(srow * KP + sc8 * 16), vw = (unsigned)(KBYTES + (sc8 >> 2) * VDT + srow * 64 + (sc8 & 3) * 16);
    const size_t goff = (size_t)srow * 256 + hh * 64 + sc8 * 8;
    u32x4 kreg, vreg;
#define NA_ROW0(t) ((t) < nct ? (NRL + b * C_ + (t) * 64) : (b * L_ + (kr_lo + (t) - nct) * GRW))
#define NA_LOAD(t) do { const size_t g0 = (size_t)NA_ROW0(t) * 256 + goff; kreg = *(const u32x4*)(KN + g0); vreg = *(const u32x4*)(VN + g0); } while (0)
#define NA_WRITE(buf) do { PG8_LAS unsigned char* sb = lds + (buf) * STAGE; *(PG8_LAS u32x4*)(sb + kw) = kreg; *(PG8_LAS u32x4*)(sb + vw) = vreg; } while (0)
    const unsigned kro = (unsigned)(r * KP + h * 16);
    const unsigned vro = (unsigned)((4 * h + ((lane & 15) >> 2)) * 64 + ((lane >> 4) & 1) * 32 + (lane & 3) * 8);
    NA_LOAD(0); NA_WRITE(0); __syncthreads();
    for (int t = 0; t < nkt; ++t) {
        const bool more = (t + 1 < nkt);
        if (more) NA_LOAD(t + 1);
        const int kr = kr_lo + t - nct;
        const bool local = t >= nct;
        if (!local || (kr >= rsq && kr < rsq + 8)) {
            const PG8_LAS unsigned char* Kb = lds + (t & 1) * STAGE; const PG8_LAS unsigned char* Vb = Kb + KBYTES;
            f32x16 pA = __builtin_amdgcn_mfma_f32_32x32x16_bf16(onesK, __builtin_bit_cast(bf16x8, negmB), zero16, 0, 0, 0), pB = pA;
#pragma unroll
            for (int d0 = 0; d0 < 4; ++d0) {
                const bf16x8 ka = *(const PG8_LAS bf16x8*)(Kb + kro + d0 * 32), kb = *(const PG8_LAS bf16x8*)(Kb + kro + 32 * KP + d0 * 32);
                pA = __builtin_amdgcn_mfma_f32_32x32x16_bf16(ka, qf[d0], pA, 0, 0, 0);
                pB = __builtin_amdgcn_mfma_f32_32x32x16_bf16(kb, qf[d0], pB, 0, 0, 0);
            }
            if (local) {
                const PG8_LAS unsigned char* brow = (const PG8_LAS unsigned char*)BT + (kr - rq + 7) * 128;
#pragma unroll
                for (int i = 0; i < 16; ++i) { pA[i] += *(const PG8_LAS float*)(brow + coA[i]); pB[i] += *(const PG8_LAS float*)(brow + coB[i]); }
            }
            const float tm = dattn::tile_max(pA, pB);
            const bool need = (t == 0) || (tm > 8.0f);
            if (__builtin_amdgcn_ballot_w64(need) != 0ull) {
                const float mn_ = need ? DA_BFR_(mrun + tm) : mrun, dl = mn_ - mrun, alpha = (t == 0) ? 0.f : __builtin_amdgcn_exp2f(-dl);
                mrun = mn_; lrun *= alpha; negmB[0] = h == 0 ? ((__float_as_uint(mrun) ^ 0x80000000u) >> 16) : 0u;
#pragma unroll
                for (int i = 0; i < 16; ++i) { pA[i] -= dl; pB[i] -= dl; }
#pragma unroll
                for (int dt = 0; dt < 2; ++dt)
#pragma unroll
                    for (int i = 0; i < 16; ++i) o[dt][i] *= alpha;
            }
            float ps = 0.f;
#pragma unroll
            for (int i = 0; i < 16; ++i) { pA[i] = __builtin_amdgcn_exp2f(pA[i]); pB[i] = __builtin_amdgcn_exp2f(pB[i]); ps += pA[i] + pB[i]; }
            lrun += ps;
            const bf16x8 pf00 = DA_PACK(pA, 0), pf01 = DA_PACK(pA, 1), pf10 = DA_PACK(pB, 0), pf11 = DA_PACK(pB, 1);
#pragma unroll
            for (int dt = 0; dt < 2; ++dt) {
                const PG8_LAS unsigned char* vb = Vb + vro + dt * VDT;
#define NA_VF(kvh, st) __builtin_shufflevector(vtr(vb + ((kvh) * 32 + 16 * (st)) * 64), vtr(vb + ((kvh) * 32 + 16 * (st) + 8) * 64), 0, 1, 2, 3, 4, 5, 6, 7)
                o[dt] = __builtin_amdgcn_mfma_f32_32x32x16_bf16(NA_VF(0, 0), pf00, o[dt], 0, 0, 0);
                o[dt] = __builtin_amdgcn_mfma_f32_32x32x16_bf16(NA_VF(0, 1), pf01, o[dt], 0, 0, 0);
                o[dt] = __builtin_amdgcn_mfma_f32_32x32x16_bf16(NA_VF(1, 0), pf10, o[dt], 0, 0, 0);
                o[dt] = __builtin_amdgcn_mfma_f32_32x32x16_bf16(NA_VF(1, 1), pf11, o[dt], 0, 0, 0);
#undef NA_VF
            }
        }
        if (more) NA_WRITE((t + 1) & 1);
        __syncthreads();
    }
#undef NA_LOAD
#undef NA_WRITE
#undef NA_ROW0
    lrun += shx(lrun, 32, lane);
    const float inv = 1.f / lrun;
    bf16_t* y = WSP(bf16_t, WS_YN) + (size_t)qrow * 256 + hh * 64;
#pragma unroll
    for (int dt = 0; dt < 2; ++dt)
#pragma unroll
        for (int g4 = 0; g4 < 4; ++g4) { const int d = dt * 32 + 8 * g4 + 4 * h;
            *(uint2*)(y + d) = make_uint2(cvtpk(o[dt][4 * g4] * inv, o[dt][4 * g4 + 1] * inv), cvtpk(o[dt][4 * g4 + 2] * inv, o[dt][4 * g4 + 3] * inv)); }
}
__device__ __forceinline__ void na_phase(const Params& p, int l, PG8_LAS unsigned char* lds, int wave_s) {
    const int G = gridDim.x, bid = blockIdx.x;
    constexpr int NRG = GRR / 4, NU = B_ * 4 * NRG;
    for (int u = bid; u < NU; u += G) { const int combo = u / NRG, rg = u % NRG; na_unit(p, l, lds, combo >> 2, combo & 3, rg * 4, false, wave_s); }
    if (l == 0) for (int u = bid; u < B_ * 4; u += G) na_unit(p, l, lds, u >> 2, u & 3, 0, true, wave_s);
}
}

constexpr int NTHREADS = 512;

namespace fastp {
typedef float f32x4v __attribute__((ext_vector_type(4)));
typedef unsigned u32x4 __attribute__((ext_vector_type(4)));
typedef __bf16 bf16x2_t __attribute__((ext_vector_type(2)));
__device__ __forceinline__ float wave_sum(float v, int lane) {
#pragma unroll
    for (int o = 1; o < 64; o <<= 1) v += shx(v, o, lane);
    return v;
}
__device__ __forceinline__ unsigned pk2(float lo, float hi) { return dattn::cvtpk(lo, hi); }
__device__ __forceinline__ void norm_phase(const Params& p, int l, int which, int nrows, bool from_inputs, int wave_s) {
    int tid_ = tid_of(wave_s); asm volatile("" : "+v"(tid_));
    const int lane = tid_ & 63, wid = tid_ >> 6;
    const float* gain = p.in[which == 1 ? I_N1G : I_N2G] + (size_t)l * DM;
    const int seg_sh = which == 1 ? 0 : 3, seg_sc = which == 1 ? 1 : 4;
    f32x4v gv[4];
#pragma unroll
    for (int j = 0; j < 4; ++j) gv[j] = *(const f32x4v*)(gain + j * 256 + lane * 4);
#define NP_SRC(r_) (from_inputs ? ((r_) < NRL ? p.in[I_X] + (size_t)(r_) * DM : p.in[I_CTX] + (size_t)((r_) - NRL) * DM) : xr_row(p, (r_)))
    const int rstep = gridDim.x * 8; int row = blockIdx.x * 8 + wid;
    f32x4v nv[4];
#pragma unroll
    for (int j = 0; j < 4; ++j) nv[j] = (f32x4v){0.f, 0.f, 0.f, 0.f};
    if (row < nrows) { const float* src = NP_SRC(row);
#pragma unroll
        for (int j = 0; j < 4; ++j) nv[j] = *(const f32x4v*)(src + j * 256 + lane * 4); }
    for (; row < nrows; row += rstep) {
        f32x4v v[4], scv[4], shv[4]; float ss = 0.f;
        const int bb = row_bb(row); const float* sh = mod_ptr(p, l, bb, seg_sh); const float* sc = mod_ptr(p, l, bb, seg_sc);
#pragma unroll
        for (int j = 0; j < 4; ++j) { v[j] = nv[j]; scv[j] = *(const f32x4v*)(sc + j * 256 + lane * 4); shv[j] = *(const f32x4v*)(sh + j * 256 + lane * 4); }
        if (row + rstep < nrows) { const float* src = NP_SRC(row + rstep);
#pragma unroll
            for (int j = 0; j < 4; ++j) nv[j] = *(const f32x4v*)(src + j * 256 + lane * 4); }
#pragma unroll
        for (int j = 0; j < 4; ++j) ss += v[j][0] * v[j][0] + v[j][1] * v[j][1] + v[j][2] * v[j][2] + v[j][3] * v[j][3];
        ss = wave_sum(ss, lane);
        const float rinv = 1.f / sqrtf(ss * (1.f / DM) + RMS_EPS);
        if (from_inputs) { float* xr = xr_row(p, row);
#pragma unroll
            for (int j = 0; j < 4; ++j) *(f32x4v*)(xr + j * 256 + lane * 4) = v[j]; }
        bf16_t* h = WSP(bf16_t, WS_H) + (size_t)row * DM;
#pragma unroll
        for (int j = 0; j < 4; ++j) { const int c = j * 256 + lane * 4;
            float o[4];
#pragma unroll
            for (int e = 0; e < 4; ++e) o[e] = v[j][e] * rinv * gv[j][e] * (1.f + scv[j][e]) + shv[j][e];
            if (which != 1) *(uint2*)(h + c) = make_uint2(pk2(o[0], o[1]), pk2(o[2], o[3]));
            { int pk = 0;
                pk = __builtin_amdgcn_cvt_pk_fp8_f32(fminf(fmaxf(o[0], -448.f), 448.f), fminf(fmaxf(o[1], -448.f), 448.f), pk, false);
                pk = __builtin_amdgcn_cvt_pk_fp8_f32(fminf(fmaxf(o[2], -448.f), 448.f), fminf(fmaxf(o[3], -448.f), 448.f), pk, true);
                *(unsigned*)(p.ws + (which == 1 ? WS_H8 : WS_H8B) + (size_t)row * DM + c) = (unsigned)pk; } }
    }
#undef NP_SRC
}
__device__ __forceinline__ void mod_phase(const Params& p, PG8_LAS unsigned char* lds, int wave_s) {
    int tid_ = tid_of(wave_s); asm volatile("" : "+v"(tid_));
    const int lane = tid_ & 63, wid = tid_ >> 6;
    PG8_LAS float* sl = (PG8_LAS float*)lds;
    PG8_LAS float* red = (PG8_LAS float*)(lds + 32768);
    { float cv[(B_ + 1) * DM / NTHREADS];
#pragma unroll
      for (int k = 0; k < (B_ + 1) * DM / NTHREADS; ++k) { const unsigned i = (unsigned)tid_ + (unsigned)k * NTHREADS, b = i / (unsigned)DM, d = i % (unsigned)DM; cv[k] = b < (unsigned)B_ ? p.in[I_C][b * DM + d] : p.in[I_CCTX][d]; }
#pragma unroll
      for (int k = 0; k < (B_ + 1) * DM / NTHREADS; ++k) sl[tid_ + k * NTHREADS] = siluf_(cv[k]); }
    __syncthreads();
    const int c4 = lane & 15, ds = lane >> 4;
    for (int it = blockIdx.x; it < DEPTH * 96; it += gridDim.x) {
        const int l = it / 96, colb = (it % 96) * 64;
        const float* w = p.in[I_ADAW] + (size_t)l * DM * 6144 + colb + 4 * c4;
        f32x4v acc[B_ + 1];
#pragma unroll
        for (int b = 0; b <= B_; ++b) acc[b] = (f32x4v){0.f, 0.f, 0.f, 0.f};
#pragma unroll 8
        for (int s_ = 0; s_ < 32; ++s_) { const int d = wid * 128 + s_ * 4 + ds; const f32x4v w4 = *(const f32x4v*)(w + (size_t)d * 6144);
#pragma unroll
            for (int b = 0; b <= B_; ++b) { const float sv = sl[b * DM + d]; acc[b] += (f32x4v){sv, sv, sv, sv} * w4; } }
#pragma unroll
        for (int b = 0; b <= B_; ++b) *(PG8_LAS f32x4v*)(red + (((wid * 4 + ds) * (B_ + 1) + b) * 64 + 4 * c4)) = acc[b];
        __syncthreads();
        if (tid_ < (B_ + 1) * 64) { const int b = tid_ / 64, c = tid_ % 64; float sm = 0.f;
#pragma unroll
            for (int k = 0; k < 32; ++k) sm += red[(k * (B_ + 1) + b) * 64 + c];
            const int cc = colb + c;
            WSP(float, WS_MOD)[((size_t)(l * (B_ + 1) + b)) * 6144 + cc] = sm + p.in[I_ADAB][l * 6144 + cc]; }
        __syncthreads();
    }
}
__device__ __forceinline__ void peer_phase(const Params& p, int l, int nrows, PG8_LAS unsigned char* lds, bool last, int wave_s) {
    int tid_ = tid_of(wave_s); asm volatile("" : "+v"(tid_));
    const int lane = tid_ & 63, wid = __builtin_amdgcn_readfirstlane(tid_ >> 6), j = lane & 7, g = lane >> 3;
    PG8_LAS float* wb = (PG8_LAS float*)(lds + wid * 1024); PG8_LAS int* eb = (PG8_LAS int*)(lds + wid * 1024 + 512);
    const bf16_t* UT = WSP(const bf16_t, WS_UT); const bf16_t* VT = WSP(const bf16_t, WS_VT); const bf16_t* H2 = WSP(const bf16_t, WS_H);
    const unsigned short* EI = WSP(const unsigned short, WS_EIDX); const float* GWp = WSP(const float, WS_GW);
    for (int row = blockIdx.x * 8 + wid; row < nrows; row += gridDim.x * 8) {
        u32x4 hq[16];
        { const bf16_t* hp = H2 + (size_t)row * DM + j * 8;
#pragma unroll
          for (int i = 0; i < 16; ++i) hq[i] = *(const u32x4*)(hp + i * 64); }
        for (int bt = 0; bt < 16; ++bt) {
            const int e = EI[(size_t)row * 128 + bt * 8 + g];
            const bf16_t* up = UT + (size_t)e * 1024 + j * 8;
            u32x4 uu[16];
#pragma unroll
            for (int i = 0; i < 16; ++i) uu[i] = *(const u32x4*)(up + i * 64);
            float a0 = 0.f, a1 = 0.f;
#pragma unroll
            for (int i = 0; i < 16; ++i)
#pragma unroll
                for (int c = 0; c < 4; ++c) { a0 += u2f(uu[i][c] << 16) * u2f(hq[i][c] << 16); a1 += u2f(uu[i][c] & 0xffff0000u) * u2f(hq[i][c] & 0xffff0000u); }
            float acc = a0 + a1;
            acc += shx(acc, 1, lane); acc += shx(acc, 2, lane); acc += shx(acc, 4, lane);
            const float w = GWp[(size_t)row * 128 + bt * 8 + g] * gelu_tanh(acc);
            if (j == 0) { wb[bt * 8 + g] = w; eb[bt * 8 + g] = e; }
        }
        asm volatile("s_waitcnt lgkmcnt(0)" ::: "memory");
        float out[16];
#pragma unroll
        for (int i = 0; i < 16; ++i) out[i] = 0.f;
        for (int bt = 0; bt < 16; ++bt) {
            u32x4 v0[8], v1[8]; float wk[8];
#pragma unroll
            for (int k = 0; k < 8; ++k) { const int e = __builtin_amdgcn_readfirstlane(eb[bt * 8 + k]); wk[k] = wb[bt * 8 + k];
                const bf16_t* vp = VT + (size_t)e * 1024 + lane * 16; v0[k] = *(const u32x4*)vp; v1[k] = *(const u32x4*)(vp + 8); }
#pragma unroll
            for (int k = 0; k < 8; ++k)
#pragma unroll
                for (int c = 0; c < 4; ++c) {
                    out[2 * c] += wk[k] * u2f(v0[k][c] << 16); out[2 * c + 1] += wk[k] * u2f(v0[k][c] & 0xffff0000u);
                    out[8 + 2 * c] += wk[k] * u2f(v1[k][c] << 16); out[8 + 2 * c + 1] += wk[k] * u2f(v1[k][c] & 0xffff0000u); }
        }
        asm volatile("" ::: "memory");
        float* x = xr_row(p, row) + lane * 16; const float* g2 = mod_ptr(p, l, row_bb(row), 5) + lane * 16;
        f32x4v xv[4]; float ss = 0.f;
#pragma unroll
        for (int q = 0; q < 4; ++q) { xv[q] = *(const f32x4v*)(x + q * 4); const f32x4v gv = *(const f32x4v*)(g2 + q * 4);
#pragma unroll
            for (int e = 0; e < 4; ++e) { xv[q][e] += gv[e] * out[q * 4 + e]; ss += xv[q][e] * xv[q][e]; } }
        if (last) { ss = wave_sum(ss, lane); const float rinv = 1.f / sqrtf(ss * (1.f / DM) + RMS_EPS); const float* fg = p.in[I_FNG] + lane * 16;
#pragma unroll
            for (int q = 0; q < 4; ++q) { const f32x4v gv = *(const f32x4v*)(fg + q * 4);
#pragma unroll
                for (int e = 0; e < 4; ++e) xv[q][e] = xv[q][e] * rinv * gv[e]; } }
#pragma unroll
        for (int q = 0; q < 4; ++q) *(f32x4v*)(x + q * 4) = xv[q];
    }
}

typedef float f2v __attribute__((ext_vector_type(2)));
__device__ __forceinline__ void tables8_phase(const Params& p, int l, long tid, long nthr) {
    const long n16 = (long)16384 * 1024 / 16;
    for (long it = tid; it < 2 * n16; it += nthr) {
        const int w = it >= n16; const long i = it - (w ? n16 : 0);
        const float* src = p.in[w ? I_PV : I_PU] + (size_t)l * 16384 * 1024 + i * 16; const float sc = w ? 16.f : 256.f;
        u32x4 o;
#pragma unroll
        for (int c = 0; c < 4; ++c) { const f32x4v v = *(const f32x4v*)(src + c * 4); int pk = 0;
            pk = __builtin_amdgcn_cvt_pk_fp8_f32(fminf(fmaxf(v[0] * sc, -448.f), 448.f), fminf(fmaxf(v[1] * sc, -448.f), 448.f), pk, false);
            pk = __builtin_amdgcn_cvt_pk_fp8_f32(fminf(fmaxf(v[2] * sc, -448.f), 448.f), fminf(fmaxf(v[3] * sc, -448.f), 448.f), pk, true);
            o[c] = (unsigned)pk; }
        *(u32x4*)(p.ws + (w ? WS_VT : WS_UT) + i * 16) = o;
    }
}
__device__ __forceinline__ void peer8_phase(const Params& p, int l, int nrows, PG8_LAS unsigned char* lds, bool last, int wave_s) {
    int tid_ = tid_of(wave_s); asm volatile("" : "+v"(tid_));
    const int lane = tid_ & 63, wid = __builtin_amdgcn_readfirstlane(tid_ >> 6), j = lane & 7, g = lane >> 3;
    PG8_LAS float* wb = (PG8_LAS float*)(lds + wid * 1024); PG8_LAS int* eb = (PG8_LAS int*)(lds + wid * 1024 + 512);
    const unsigned char* UT8 = p.ws + WS_UT; const unsigned char* VT8 = p.ws + WS_VT; const bf16_t* H2 = WSP(const bf16_t, WS_H);
    const unsigned short* EI = WSP(const unsigned short, WS_EIDX); const float* GWp = WSP(const float, WS_GW);
    for (int row = blockIdx.x * 8 + wid; row < nrows; row += gridDim.x * 8) {
        f2v hf[64];
        { const bf16_t* hp = H2 + (size_t)row * DM + j * 16;
#pragma unroll
          for (int i = 0; i < 8; ++i) { const u32x4 t0 = *(const u32x4*)(hp + i * 128), t1 = *(const u32x4*)(hp + i * 128 + 8);
#pragma unroll
              for (int c = 0; c < 4; ++c) { hf[i * 8 + c] = (f2v){u2f(t0[c] << 16), u2f(t0[c] & 0xffff0000u)}; hf[i * 8 + 4 + c] = (f2v){u2f(t1[c] << 16), u2f(t1[c] & 0xffff0000u)}; } } }
        for (int bt = 0; bt < 8; ++bt) {
            const int e0 = EI[(size_t)row * 128 + bt * 16 + g], e1 = EI[(size_t)row * 128 + bt * 16 + 8 + g];
            const unsigned char* u0 = UT8 + (size_t)e0 * 1024 + j * 16; const unsigned char* u1 = UT8 + (size_t)e1 * 1024 + j * 16;
            u32x4 ua[8], ub[8];
#pragma unroll
            for (int i = 0; i < 8; ++i) { ua[i] = *(const u32x4*)(u0 + i * 128); ub[i] = *(const u32x4*)(u1 + i * 128); }
            f2v acc0 = {0.f, 0.f}, acc1 = {0.f, 0.f};
#pragma unroll
            for (int i = 0; i < 8; ++i)
#pragma unroll
                for (int c = 0; c < 4; ++c) {
                    acc0 += __builtin_amdgcn_cvt_pk_f32_fp8((int)ua[i][c], false) * hf[i * 8 + 2 * c]; acc0 += __builtin_amdgcn_cvt_pk_f32_fp8((int)ua[i][c], true) * hf[i * 8 + 2 * c + 1];
                    acc1 += __builtin_amdgcn_cvt_pk_f32_fp8((int)ub[i][c], false) * hf[i * 8 + 2 * c]; acc1 += __builtin_amdgcn_cvt_pk_f32_fp8((int)ub[i][c], true) * hf[i * 8 + 2 * c + 1]; }
            float d0 = acc0[0] + acc0[1], d1 = acc1[0] + acc1[1];
            d0 += shx(d0, 1, lane); d1 += shx(d1, 1, lane); d0 += shx(d0, 2, lane); d1 += shx(d1, 2, lane); d0 += shx(d0, 4, lane); d1 += shx(d1, 4, lane);
            const float w0 = GWp[(size_t)row * 128 + bt * 16 + g] * gelu_tanh(d0 * (1.f / 256.f)), w1 = GWp[(size_t)row * 128 + bt * 16 + 8 + g] * gelu_tanh(d1 * (1.f / 256.f));
            if (j == 0) { wb[bt * 16 + g] = w0; eb[bt * 16 + g] = e0; wb[bt * 16 + 8 + g] = w1; eb[bt * 16 + 8 + g] = e1; }
        }
        asm volatile("s_waitcnt lgkmcnt(0)" ::: "memory");
        f2v out2[8];
#pragma unroll
        for (int q = 0; q < 8; ++q) out2[q] = (f2v){0.f, 0.f};
        for (int bt = 0; bt < 8; ++bt) {
            u32x4 vv[16]; float wk[16];
#pragma unroll
            for (int k = 0; k < 16; ++k) { const int e = __builtin_amdgcn_readfirstlane(eb[bt * 16 + k]); wk[k] = wb[bt * 16 + k]; vv[k] = *(const u32x4*)(VT8 + (size_t)e * 1024 + lane * 16); }
#pragma unroll
            for (int k = 0; k < 16; ++k) { const f2v w2 = {wk[k], wk[k]};
#pragma unroll
                for (int c = 0; c < 4; ++c) { out2[2 * c] += w2 * __builtin_amdgcn_cvt_pk_f32_fp8((int)vv[k][c], false); out2[2 * c + 1] += w2 * __builtin_amdgcn_cvt_pk_f32_fp8((int)vv[k][c], true); } }
        }
        asm volatile("" ::: "memory");
        float* x = xr_row(p, row) + lane * 16; const float* g2 = mod_ptr(p, l, row_bb(row), 5) + lane * 16;
        f32x4v xv[4]; float ss = 0.f;
#pragma unroll
        for (int q = 0; q < 4; ++q) { xv[q] = *(const f32x4v*)(x + q * 4); const f32x4v gv = *(const f32x4v*)(g2 + q * 4);
            xv[q][0] += gv[0] * out2[2 * q][0] * (1.f / 16.f); xv[q][1] += gv[1] * out2[2 * q][1] * (1.f / 16.f); xv[q][2] += gv[2] * out2[2 * q + 1][0] * (1.f / 16.f); xv[q][3] += gv[3] * out2[2 * q + 1][1] * (1.f / 16.f);
#pragma unroll
            for (int e = 0; e < 4; ++e) ss += xv[q][e] * xv[q][e]; }
        if (last) { ss = wave_sum(ss, lane); const float rinv = 1.f / sqrtf(ss * (1.f / DM) + RMS_EPS); const float* fg = p.in[I_FNG] + lane * 16;
#pragma unroll
            for (int q = 0; q < 4; ++q) { const f32x4v gv = *(const f32x4v*)(fg + q * 4);
#pragma unroll
                for (int e = 0; e < 4; ++e) xv[q][e] = xv[q][e] * rinv * gv[e]; } }
#pragma unroll
        for (int q = 0; q < 4; ++q) *(f32x4v*)(x + q * 4) = xv[q];
    }
}

constexpr int NSL = 8;
constexpr size_t WS_PART = WS_SC;
static_assert((size_t)NSL * NR * 128 * 4 <= (size_t)NR * 2048 * 2, "PART fits the score buffer");
struct XInfo { int xi, nx, rank, nloc; };
__device__ __forceinline__ void tables8s_phase(const Params& p, int l, long tid, long nthr) {
    const long n16 = (long)16384 * 1024 / 16;
    for (long it = tid; it < 2 * n16; it += nthr) {
        const int w = it >= n16; const long i = it - (w ? n16 : 0);
        const float GPTR* src = p.in[w ? I_PV : I_PU] + (size_t)l * 16384 * 1024 + i * 16; const float sc = w ? 16.f : 256.f;
        u32x4 o;
#pragma unroll
        for (int c = 0; c < 4; ++c) { const f32x4v v = *(const f32x4v GPTR*)(src + c * 4); int pk = 0;
            pk = __builtin_amdgcn_cvt_pk_fp8_f32(fminf(fmaxf(v[0] * sc, -448.f), 448.f), fminf(fmaxf(v[1] * sc, -448.f), 448.f), pk, false);
            pk = __builtin_amdgcn_cvt_pk_fp8_f32(fminf(fmaxf(v[2] * sc, -448.f), 448.f), fminf(fmaxf(v[3] * sc, -448.f), 448.f), pk, true);
            o[c] = (unsigned)pk; }
        const long e = i >> 6; const int ch = (int)(i & 63), sl = ch >> 3, within = (ch & 7) * 16;
        *(u32x4 GPTR*)(p.ws + (w ? WS_VT : WS_UT) + ((size_t)sl * 16384 + e) * 128 + within) = o;
    }
}
#define XR_STEP(v, n, bit, msk) _Pragma("unroll") for (int k_ = 0; k_ < (n); ++k_) { const float send_ = (bit) ? v[k_] : v[(n) + k_]; const float keep_ = (bit) ? v[(n) + k_] : v[k_]; v[k_] = keep_ + shx(send_, msk, lane); }
__device__ __forceinline__ void peer_u_phase(const Params& p, int nrows, const XInfo xi, PG8_LAS unsigned char* lds, int wave_s) {
    typedef int i32x8 __attribute__((ext_vector_type(8))); typedef int i32x4 __attribute__((ext_vector_type(4))); typedef float f32x4m __attribute__((ext_vector_type(4)));
    int tid_ = tid_of(wave_s); asm volatile("" : "+v"(tid_));
    const int lane = tid_ & 63, wid = __builtin_amdgcn_readfirstlane(tid_ >> 6), q = lane >> 3, pc = lane & 7, m = lane & 15, kg = lane >> 4;
    const unsigned short GPTR* EI = (const unsigned short GPTR*)(p.ws + WS_EIDX); const unsigned char GPTR* H8 = (const unsigned char GPTR*)(p.ws + WS_H8B);
    int sc_ = 0x7f7f7f7f; asm volatile("" : "+v"(sc_));
    const int gq = ((q >> 1) & 1) + ((q >> 2) & 1) * 4, gm = ((m >> 1) & 1) + ((m >> 2) & 1) * 4;
    PG8_LAS unsigned char* const wl = lds + wid * 16384;
    const unsigned rbase = (unsigned)((m & 7) * 128 + (m >> 3) * 8192), ro0 = rbase + (unsigned)(((2 * kg) ^ gm) * 16), ro1 = rbase + (unsigned)(((2 * kg + 1) ^ gm) * 16);
    for (int sl = xi.xi; sl < NSL; sl += xi.nx) {
        const unsigned char GPTR* UT = p.ws + WS_UT + (size_t)sl * 16384 * 128 + (pc ^ gq) * 16;
        float GPTR* PART = (float GPTR*)(p.ws + WS_PART) + (size_t)sl * NR * 128;
        for (int row = xi.rank * 8 + wid; row < nrows; row += xi.nloc * 8) {
            const u32x4 ev0 = *(const u32x4 GPTR*)(EI + (size_t)row * 128 + q * 16), ev1 = *(const u32x4 GPTR*)(EI + (size_t)row * 128 + q * 16 + 8);
            const unsigned char GPTR* hp = H8 + (size_t)row * DM + sl * 128 + kg * 32;
            const i32x8 hb = __builtin_shufflevector(*(const i32x4 GPTR*)hp, *(const i32x4 GPTR*)(hp + 16), 0, 1, 2, 3, 4, 5, 6, 7);
#pragma unroll
            for (int i = 0; i < 16; ++i) { const unsigned wrd = i < 8 ? ev0[i >> 1] : ev1[(i - 8) >> 1]; const unsigned e = (i & 1) ? (wrd >> 16) : (wrd & 0xffffu);
                __builtin_amdgcn_global_load_lds((const unsigned GPTR*)(UT + (size_t)e * 128), (PG8_LAS unsigned*)(wl + i * 1024), 16, 0, 0); }
            asm volatile("s_waitcnt vmcnt(0)" ::: "memory");
            f32x4m acc[8];
#pragma unroll
            for (int G = 0; G < 8; ++G) { const i32x8 ua = __builtin_shufflevector(*(const PG8_LAS i32x4*)(wl + G * 1024 + ro0), *(const PG8_LAS i32x4*)(wl + G * 1024 + ro1), 0, 1, 2, 3, 4, 5, 6, 7);
                acc[G] = __builtin_amdgcn_mfma_scale_f32_16x16x128_f8f6f4(ua, hb, (f32x4m){0.f, 0.f, 0.f, 0.f}, 0, 0, 0, sc_, 0, sc_); }
            if (m == 0) {
#pragma unroll
                for (int i = 0; i < 4; ++i) { const int mm = 4 * kg + i; float GPTR* d = PART + (size_t)row * 128 + (mm & 7) * 16 + (mm >> 3) * 8;
                    *(f32x4m GPTR*)d = (f32x4m){acc[0][i], acc[1][i], acc[2][i], acc[3][i]}; *(f32x4m GPTR*)(d + 4) = (f32x4m){acc[4][i], acc[5][i], acc[6][i], acc[7][i]}; } }
            asm volatile("s_waitcnt lgkmcnt(0)" ::: "memory");
        }
    }
}
__device__ __forceinline__ void peer_comb_phase(const Params& p, int nrows, long tid, long nthr) {
    const float GPTR* PART = (const float GPTR*)(p.ws + WS_PART); float GPTR* GWp = (float GPTR*)(p.ws + WS_GW);
    for (long it = tid; it < (long)nrows * 32; it += nthr) {
        f32x4v a = *(const f32x4v GPTR*)(PART + it * 4);
#pragma unroll
        for (int sl = 1; sl < NSL; ++sl) a += *(const f32x4v GPTR*)(PART + (size_t)sl * NR * 128 + it * 4);
        f32x4v gw = *(const f32x4v GPTR*)(GWp + it * 4);
#pragma unroll
        for (int e = 0; e < 4; ++e) gw[e] *= gelu_tanh(a[e] * (1.f / 256.f));
        int pk = 0;
        pk = __builtin_amdgcn_cvt_pk_fp8_f32(fminf(fmaxf(gw[0] * 64.f, -448.f), 448.f), fminf(fmaxf(gw[1] * 64.f, -448.f), 448.f), pk, false);
        pk = __builtin_amdgcn_cvt_pk_fp8_f32(fminf(fmaxf(gw[2] * 64.f, -448.f), 448.f), fminf(fmaxf(gw[3] * 64.f, -448.f), 448.f), pk, true);
        const long row = it >> 5; const int s0 = (int)(it & 31) * 4, q = s0 >> 4, i0 = s0 & 15;
        unsigned char GPTR* d = (unsigned char GPTR*)(p.ws + WS_GW8) + row * 128 + 8 * i0 + q;
        d[0] = (unsigned char)(pk & 255); d[8] = (unsigned char)((pk >> 8) & 255); d[16] = (unsigned char)((pk >> 16) & 255); d[24] = (unsigned char)((unsigned)pk >> 24);
    }
}
__device__ __forceinline__ void peer_v_phase(const Params& p, int l, int nrows, const XInfo xi, PG8_LAS unsigned char* lds, int wave_s) {
    typedef int i32x8 __attribute__((ext_vector_type(8))); typedef int i32x4 __attribute__((ext_vector_type(4))); typedef int i32x2 __attribute__((ext_vector_type(2))); typedef float f32x4m __attribute__((ext_vector_type(4)));
    int tid_ = tid_of(wave_s); asm volatile("" : "+v"(tid_));
    const int lane = tid_ & 63, wid = __builtin_amdgcn_readfirstlane(tid_ >> 6), q = lane >> 3, pc = lane & 7, m = lane & 15, kg = lane >> 4, r = m >> 1, cc = m & 1, n7 = m & 7;
    const unsigned short GPTR* EI = (const unsigned short GPTR*)(p.ws + WS_EIDX); const unsigned char GPTR* W8 = (const unsigned char GPTR*)(p.ws + WS_GW8);
    int sca_ = 0x7b7b7b7b, scb_ = 0x79797979; asm volatile("" : "+v"(sca_), "+v"(scb_));
    const int gq = ((q >> 1) & 1) + ((q >> 2) & 1) * 4, gr = ((r >> 1) & 1) + ((r >> 2) & 1) * 4;
    PG8_LAS unsigned char* const wl = lds + wid * 16384;
    const unsigned tro = (unsigned)((32 * kg + r) * 128 + 8 * cc);
    for (int sl = xi.xi; sl < NSL; sl += xi.nx) {
        const unsigned char GPTR* VT = p.ws + WS_VT + (size_t)sl * 16384 * 128 + (pc ^ gq) * 16;
        for (int row = xi.rank * 8 + wid; row < nrows; row += xi.nloc * 8) {
            const u32x4 ev0 = *(const u32x4 GPTR*)(EI + (size_t)row * 128 + q * 16), ev1 = *(const u32x4 GPTR*)(EI + (size_t)row * 128 + q * 16 + 8);
            const unsigned char GPTR* wp = W8 + (size_t)row * 128 + kg * 32;
            const i32x8 wb = __builtin_shufflevector(*(const i32x4 GPTR*)wp, *(const i32x4 GPTR*)(wp + 16), 0, 1, 2, 3, 4, 5, 6, 7);
            const int col = sl * 128 + 16 * n7 + 4 * kg;
            float* x = xr_row(p, row) + col; const float* g2 = mod_ptr(p, l, row_bb(row), 5) + col;
            const f32x4m xv = *(const f32x4m*)x, gv = *(const f32x4m*)g2;
#pragma unroll
            for (int i = 0; i < 16; ++i) { const unsigned wrd = i < 8 ? ev0[i >> 1] : ev1[(i - 8) >> 1]; const unsigned e = (i & 1) ? (wrd >> 16) : (wrd & 0xffffu);
                __builtin_amdgcn_global_load_lds((const unsigned GPTR*)(VT + (size_t)e * 128), (PG8_LAS unsigned*)(wl + i * 1024), 16, 0, 0); }
            asm volatile("s_waitcnt vmcnt(0)" ::: "memory");
            f32x4m acc[8];
#pragma unroll
            for (int c = 0; c < 8; ++c) { const PG8_LAS unsigned char* ap = wl + tro + ((c ^ gr) * 16);
                const i32x2 a0 = __builtin_amdgcn_ds_read_tr8_b64_v2i32((PG8_LAS i32x2*)(ap)), a1 = __builtin_amdgcn_ds_read_tr8_b64_v2i32((PG8_LAS i32x2*)(ap + 1024)),
                            a2 = __builtin_amdgcn_ds_read_tr8_b64_v2i32((PG8_LAS i32x2*)(ap + 2048)), a3 = __builtin_amdgcn_ds_read_tr8_b64_v2i32((PG8_LAS i32x2*)(ap + 3072));
                const i32x8 va = {a0[0], a0[1], a1[0], a1[1], a2[0], a2[1], a3[0], a3[1]};
                acc[c] = __builtin_amdgcn_mfma_scale_f32_16x16x128_f8f6f4(va, wb, (f32x4m){0.f, 0.f, 0.f, 0.f}, 0, 0, 0, sca_, 0, scb_); }
            f32x4m sel = acc[0];
#pragma unroll
            for (int c = 1; c < 8; ++c) { const bool t_ = (n7 == c);
#pragma unroll
                for (int i = 0; i < 4; ++i) sel[i] = t_ ? acc[c][i] : sel[i]; }
            if (m < 8) *(f32x4m*)x = xv + gv * sel;
            asm volatile("s_waitcnt lgkmcnt(0)" ::: "memory");
        }
    }
}
__device__ __forceinline__ void final_norm_phase(const Params& p, int wave_s) {
    int tid_ = tid_of(wave_s); asm volatile("" : "+v"(tid_));
    const int lane = tid_ & 63, wid = tid_ >> 6;
    f32x4v gv[4], nv[4];
#pragma unroll
    for (int q = 0; q < 4; ++q) { gv[q] = *(const f32x4v GPTR*)(p.in[I_FNG] + q * 256 + lane * 4); nv[q] = (f32x4v){0.f, 0.f, 0.f, 0.f}; }
    const int rstep = gridDim.x * 8; int row = blockIdx.x * 8 + wid;
    if (row < NRL) {
#pragma unroll
        for (int q = 0; q < 4; ++q) nv[q] = *(const f32x4v GPTR*)(p.out + (size_t)row * DM + q * 256 + lane * 4); }
    for (; row < NRL; row += rstep) {
        float GPTR* x = p.out + (size_t)row * DM; f32x4v v[4]; float ss = 0.f;
#pragma unroll
        for (int q = 0; q < 4; ++q) v[q] = nv[q];
        if (row + rstep < NRL) {
#pragma unroll
            for (int q = 0; q < 4; ++q) nv[q] = *(const f32x4v GPTR*)(p.out + (size_t)(row + rstep) * DM + q * 256 + lane * 4); }
#pragma unroll
        for (int q = 0; q < 4; ++q) ss += v[q][0] * v[q][0] + v[q][1] * v[q][1] + v[q][2] * v[q][2] + v[q][3] * v[q][3];
        ss = wave_sum(ss, lane); const float rinv = 1.f / sqrtf(ss * (1.f / DM) + RMS_EPS);
#pragma unroll
        for (int q = 0; q < 4; ++q) {
#pragma unroll
            for (int e = 0; e < 4; ++e) v[q][e] = v[q][e] * rinv * gv[q][e];
            *(f32x4v GPTR*)(x + q * 256 + lane * 4) = v[q]; }
    }
}
__device__ __forceinline__ void carry_phase(const Params& p, int wave_s) {
    int tid_ = tid_of(wave_s); asm volatile("" : "+v"(tid_));
    if (tid_ >= 64) return;
    for (int wv = blockIdx.x; wv < B_ * 16 * 2; wv += gridDim.x) {
        const int n = tid_, dir = wv & 1, g = (wv >> 1) & 15, b = wv >> 5;
        const size_t sn = (size_t)(dir * 16 + g) * 64 + n;
        const float lr = WSP(const float, WS_POW)[(sn * 33 + 32) * 2], li = WSP(const float, WS_POW)[(sn * 33 + 32) * 2 + 1];
        float sr = 0.f, si = 0.f;
        constexpr int nsteps = CCH + LCH;
        constexpr int CB = (nsteps % 24 == 0) ? 24 : 8;
        static_assert(nsteps % CB == 0, "carry unroll");
        for (int s0 = 0; s0 < nsteps; s0 += CB) {
            float2 sl[CB]; int ch[CB];
#pragma unroll
            for (int k = 0; k < CB; ++k) { const int s = s0 + k;
                ch[k] = dir == 0 ? (s < CCH ? NRL / TCH + b * CCH + s : b * LCH + (s - CCH)) : (s < CCH ? NRL / TCH + b * CCH + (CCH - 1 - s) : b * LCH + (LCH - 1 - (s - CCH)));
                sl[k] = *(const float2*)(WSP(const float, WS_SLOC) + ((size_t)(g * NCH + ch[k])) * 256 + dir * 128 + n * 2); }
#pragma unroll
            for (int k = 0; k < CB; ++k) {
                *(unsigned*)(WSP(bf16_t, WS_ASSM) + ((size_t)(g * NCH + ch[k])) * KSS + 512 + dir * 128 + n * 2) = pk2(sr, si);
                const float nr = lr * sr - li * si + sl[k].x, ni = lr * si + li * sr + sl[k].y; sr = nr; si = ni; }
        }
    }
}
}

constexpr int LDS_BYTES = 147456, LDS_BAR_OFF = 131072;
#ifndef USE_MFMA_GEMM
#define USE_MFMA_GEMM 1
#endif
#ifndef USE_FAST_PEER
#define USE_FAST_PEER 1
#endif
#if USE_MFMA_GEMM
#define GEMM_FLAT(EpiT, einit, Aoff, lda_, Boff, ldb_, Mrows, Ncols, K_) do { pg8::Gemm g_{WSP(const bf16_t, Aoff), WSP(const bf16_t, Boff), (int)(lda_), (int)(ldb_), (int)(K_)}; \
        SchedFlat S_; S_.init((Mrows) / 256, (Ncols) / 256, (int)gridDim.x, (int)blockIdx.x); EpiAdapt<EpiT> E_{EpiT einit}; \
        pg8::gemm_phase<EpiAdapt<EpiT>, SchedFlat, PG8_ALIGN, PG8_SP2>(lds, g_, S_, E_, tid_of(wave_s)); } while (0)
#define GEMM_GROUPED(EpiT, einit, Boff, ldb_, brows_, tn_, K_) do { pg8::Gemm g_{WSP(const bf16_t, WS_ASSM), WSP(const bf16_t, Boff), KSS, (int)(ldb_), (int)(K_)}; \
        SchedGrouped S_{NCHP / 256, (tn_), NCH, (brows_), (int)gridDim.x, (int)blockIdx.x}; EpiAdapt<EpiT> E_{EpiT einit}; \
        pg8::gemm_phase<EpiAdapt<EpiT>, SchedGrouped, PG8_ALIGN, PG8_SP2>(lds, g_, S_, E_, tid_of(wave_s)); } while (0)
#else
#define GEMM_FLAT(EpiT, einit, Aoff, lda_, Boff, ldb_, Mrows, Ncols, K_) do { EpiT e_ einit; naive_gemm(WSP(const bf16_t, Aoff), lda_, WSP(const bf16_t, Boff), ldb_, Mrows, Ncols, K_, e_, tid, nthr); } while (0)
#define GEMM_GROUPED(EpiT, einit, Boff, ldb_, brows_, tn_, K_) do { for (int g__ = 0; g__ < 16; ++g__) { EpiT e_ einit; e_.set_group(g__); \
        naive_gemm(WSP(const bf16_t, WS_ASSM) + (size_t)g__ * NCH * KSS, KSS, WSP(const bf16_t, Boff) + (size_t)g__ * (brows_) * (ldb_), ldb_, NCH, (tn_) * 256, K_, e_, tid, nthr); } } while (0)
#endif

__global__ void __launch_bounds__(NTHREADS, 2) mega_fwd(ParamsH p0) {
    Params p;
#pragma unroll
    for (int i = 0; i < 30; ++i) p.in[i] = (const float GPTR*)p0.in[i];
    p.out = (float GPTR*)p0.out; p.ws = (unsigned char GPTR*)p0.ws;
    extern __shared__ __attribute__((aligned(16))) unsigned char lds_raw[];
    PG8_LAS unsigned char* lds = (PG8_LAS unsigned char*)lds_raw;
    const int wave_s = __builtin_amdgcn_readfirstlane((int)threadIdx.x >> 6);
    if (tid_of(wave_s) < 4) ((volatile LAS unsigned*)(lds + LDS_BAR_OFF))[tid_of(wave_s)] = 0u;
    __syncthreads();
    (void)xcd_barrier_post((unsigned*)(p.ws + WS_CTL), (volatile LAS unsigned*)(lds + LDS_BAR_OFF), tid_of(wave_s));
    long nthr, tid;
#define REFRESH() do { int t_ = tid_of(wave_s); asm volatile("" : "+v"(t_)); int g_ = gridDim.x; asm volatile("" : "+s"(g_)); tid = (long)blockIdx.x * NTHREADS + t_; nthr = (long)g_ * NTHREADS; \
        unsigned char* w_ = p0.ws; asm volatile("" : "+s"(w_)); p.ws = (unsigned char GPTR*)w_; float* o_ = p0.out; asm volatile("" : "+s"(o_)); p.out = (float GPTR*)o_; } while (0)
#define GBAR() do { asm volatile("; PHASE_MARK %0" :: "i"(__LINE__)); { XcdBarrier b_; b_.bar = (unsigned*)(p.ws + WS_CTL); b_.x = xb_xcc_id(); b_.st = (volatile LAS unsigned*)(lds + LDS_BAR_OFF); xcd_barrier(b_, tid_of(wave_s)); } REFRESH(); } while (0)
    REFRESH();
#ifndef DUP_MASK
#define DUP_MASK 0
#endif
#define DUP(bit, stmt) do { stmt; if (DUP_MASK & (1 << (bit))) { stmt; } } while (0)
    if (tid_of(wave_s) == 0) { const unsigned r_ = xb_add((unsigned*)(p.ws + WS_CTL) + 8192 + 64 * xb_xcc_id(), 1u); ((volatile LAS unsigned*)(lds + LDS_BAR_OFF))[4] = r_; }
    DUP(14, fastp::mod_phase(p, lds, wave_s); REFRESH()); ph_mod_small(p, tid, nthr); GBAR();
    fastp::XInfo xinf;
    { unsigned mine = xb_xcc_id(), xi_ = 0, nx_ = 0, nl_ = 1;
#pragma unroll
      for (unsigned j_ = 0; j_ < 16; ++j_) { const unsigned c_ = xb_ld((unsigned*)(p.ws + WS_CTL) + XB_XCNT(j_)); nx_ += c_ > 0u; xi_ += (c_ > 0u && j_ < mine); nl_ = (j_ == mine) ? c_ : nl_; }
      xinf.xi = __builtin_amdgcn_readfirstlane((int)xi_); xinf.nx = __builtin_amdgcn_readfirstlane((int)(nx_ ? nx_ : 1u)); xinf.nloc = __builtin_amdgcn_readfirstlane((int)(nl_ ? nl_ : 1u));
      xinf.rank = __builtin_amdgcn_readfirstlane((int)((volatile LAS unsigned*)(lds + LDS_BAR_OFF))[4]); }
    for (int l = 0; l < DEPTH; ++l) {
        const int nact = (l == 0) ? NR : NRL;
        DUP(0, ph_prep_a(p, l, tid, nthr)); DUP(2, fastp::norm_phase(p, l, 1, NR, l == 0, wave_s); REFRESH()); GBAR();
        DUP(1, ph_prep_b(p, l, tid, nthr));
        { pg8::Gemm g_{WSP(const bf16_t, WS_SKA), WSP(const bf16_t, WS_WQB), 256, 2048, 256}; SchedWsc S_{(int)gridDim.x, (int)((blockIdx.x + 32u) % gridDim.x)};        EpiAdapt<EpiWsc> E_{EpiWsc{p}};
          pg8::gemm_phase<EpiAdapt<EpiWsc>, SchedWsc, PG8_ALIGN, PG8_SP2>(lds, g_, S_, E_, tid_of(wave_s)); }
        {
          pg8::Gemm g_{(const bf16_t*)(p.ws + WS_H8), (const bf16_t*)(p.ws + WS_WG8), DM / 2, DM / 2, DM / 2};
          SchedFlat S_; S_.init(NR / 256, INW / 256, (int)gridDim.x, (int)blockIdx.x); EpiAdapt<EpiWinG> E_{EpiWinG{p}};
          DUP(3, (pg8::gemm_phase<EpiAdapt<EpiWinG>, SchedFlat, PG8_ALIGN, PG8_SP2, true>(lds, g_, S_, E_, tid_of(wave_s)))); }
        GBAR();
        DUP(1, ph_prep_c(p, l, tid, nthr));
        DUP(4, GEMM_GROUPED(EpiSsm1, ({p, 0}), WS_BT1, 512, 256, 1, 512));
        DUP(5, dattn::diff_phase(p, l, lds, wave_s); REFRESH());
        DUP(6, nattn::na_phase(p, l, lds, wave_s); REFRESH()); GBAR();
        DUP(7, fastp::carry_phase(p, wave_s); REFRESH()); DUP(10, fastp::tables8s_phase(p, l, tid, nthr)); GBAR();
        DUP(8, GEMM_GROUPED(EpiSsm2, ({p, 0}), WS_BT2, KSS, 512, 2, KSS)); GBAR();
        DUP(9, GEMM_FLAT(EpiGlu, {p}, WS_YG, 256, WS_WGLU, 256, nact, 512, 256)); GBAR();
        DUP(9, GEMM_FLAT(EpiMerge, ({p, WS_SGS, false}), WS_YS, 256, WS_WBS, 256, nact, DM, 256)); REFRESH();
        GEMM_FLAT(EpiMerge, ({p, WS_SGD, true}), WS_YD, 512, WS_WBD, 512, nact, DM, 512); REFRESH();
        GEMM_FLAT(EpiMerge, ({p, WS_SGN, true, true}), WS_YN, 256, WS_WBN, 256, nact, DM, 256); GBAR();
        {
          pg8::Gemm g_{(const bf16_t*)(p.ws + WS_MB8), (const bf16_t*)(p.ws + WS_WOUT), DM / 2, DM / 2, DM / 2};
          SchedFlat S_; S_.init(nact / 256, DM / 256, (int)gridDim.x, (int)blockIdx.x); EpiAdapt<EpiWout> E_{EpiWout{p, l}};
          pg8::gemm_phase<EpiAdapt<EpiWout>, SchedFlat, PG8_ALIGN, PG8_SP2, true>(lds, g_, S_, E_, tid_of(wave_s)); }
        GBAR();
        DUP(13, fastp::norm_phase(p, l, 2, nact, false, wave_s); REFRESH()); GBAR();
        DUP(11, GEMM_FLAT(EpiScore, {p}, WS_H, DM, WS_WSC, DM, nact, 2048, DM)); GBAR();
        DUP(12, ph_topk(p, nact, tid, nthr)); GBAR();
        fastp::peer_u_phase(p, nact, xinf, lds, wave_s); REFRESH(); GBAR();
        fastp::peer_comb_phase(p, nact, tid, nthr); GBAR();
        fastp::peer_v_phase(p, l, nact, xinf, lds, wave_s); REFRESH(); GBAR();
    }
    fastp::final_norm_phase(p, wave_s);
#undef GBAR
}

extern "C" void kernel_launch(void* const* d_in, const int* in_sizes, int n_in, void* d_out, int out_size, void* d_ws, size_t ws_size, hipStream_t stream) {
    static int grid = 0;
    if (grid == 0) {
        int dev = 0, cus = 0, per_cu = 0;
        (void)hipGetDevice(&dev);
        (void)hipDeviceGetAttribute(&cus, hipDeviceAttributeMultiprocessorCount, dev);
        (void)hipFuncSetAttribute((const void*)mega_fwd, hipFuncAttributeMaxDynamicSharedMemorySize, LDS_BYTES);
        (void)hipOccupancyMaxActiveBlocksPerMultiprocessor(&per_cu, (const void*)mega_fwd, NTHREADS, LDS_BYTES);
        (void)hipGetLastError();
        if (cus <= 0) cus = 256;
        grid = cus;
        if (n_in != 30 || ws_size < WS_TOTAL) { fprintf(stderr, "kernel_launch: unexpected n_in %d / ws %zu (need %zu)\n", n_in, ws_size, (size_t)WS_TOTAL); }
    }
    (void)hipMemsetAsync((char*)d_ws + WS_CTL, 0, CTL_BYTES, stream);
    ParamsH p{};
    for (int i = 0; i < 30; ++i) p.in[i] = (const float*)d_in[i];
    p.out = (float*)d_out; p.ws = (unsigned char*)d_ws;
    hipLaunchKernelGGL(mega_fwd, dim3(grid), dim3(NTHREADS), LDS_BYTES, stream, p);
}
#endif
```
